# Optimizing an MI355X kernel written in HIP

```python
import jax, jax.numpy as jnp
from jax import lax
import numpy as np

D_MODEL = 1024
BATCH = 2
SEQ = 8192
DEPTH = 2

EXPAND = 2
D_INNER = EXPAND * D_MODEL
N_MIXERS = 4
D_BRANCH = D_INNER // N_MIXERS
EPS = 1e-6
NEG_BIG = -1e30

GLA_HEADS = 4
GLA_DV = D_BRANCH // GLA_HEADS
GLA_DK = GLA_DV // 2
GLA_GATE_RANK = 16
GLA_GATE_NORM = 16.0
GLA_CHUNK = 64

MLSTM_HEADS = 4
MLSTM_DH = D_BRANCH // MLSTM_HEADS
MLSTM_CONV = 4
MLSTM_CHUNK = 64

HGRN_HEADS = 4
HGRN_DK = 128
HGRN_DV = D_BRANCH // HGRN_HEADS
HGRN_CHUNK = 64

SSD_HEAD_DIM = 64
SSD_HEADS = D_BRANCH // SSD_HEAD_DIM
SSD_GROUPS = 2
SSD_STATE = 128
SSD_CONV = 4
SSD_CHUNK = 128

GLA_QK = GLA_HEADS * GLA_DK
HGRN_QF = HGRN_HEADS * HGRN_DK
SSD_BC = SSD_GROUPS * SSD_STATE
PROJ_SIZES = (
    GLA_QK, GLA_QK, D_BRANCH, GLA_GATE_RANK, D_BRANCH,
    D_BRANCH, D_BRANCH, D_BRANCH, MLSTM_HEADS, MLSTM_HEADS, D_BRANCH, D_BRANCH,
    HGRN_QF, HGRN_QF, D_BRANCH, D_BRANCH,
    D_BRANCH, SSD_BC, SSD_BC, SSD_HEADS, D_BRANCH,
)
D_PROJ = sum(PROJ_SIZES)

kernel_name = "hymba_gla_mlstm_hgrn2_ssd_hybrid"


def rmsnorm(x, w):
    xf = x.astype(jnp.float32)
    y = xf * lax.rsqrt(jnp.mean(xf * xf, axis=-1, keepdims=True) + EPS)
    return (y * w.astype(jnp.float32)).astype(x.dtype)


def grouped_rmsnorm(x, w, n_groups):
    shp = x.shape
    xg = x.reshape(shp[:-1] + (n_groups, shp[-1] // n_groups))
    return rmsnorm(xg, w.reshape(n_groups, -1)).reshape(shp)


def causal_dwconv(x, w, b):
    K = w.shape[0]
    y = lax.conv_general_dilated(x, w[:, None, :].astype(x.dtype), window_strides=(1,),
                                 padding=[(K - 1, 0)], dimension_numbers=('NWC', 'WIO', 'NWC'),
                                 feature_group_count=x.shape[-1])
    return y + b.astype(x.dtype)


def masked_exp(logw, mask):
    return jnp.where(mask, jnp.exp(jnp.where(mask, logw, 0.0)), 0.0)


def to_chunks(t, c):
    Bsz, S = t.shape[:2]
    t = t.reshape((Bsz, S // c, c) + t.shape[2:])
    if t.ndim == 5:
        return t.transpose(1, 0, 3, 2, 4)
    return t.transpose(1, 0, 3, 2)


def from_chunks(o):
    NC, Bsz, H, c, d = o.shape
    return o.transpose(1, 0, 3, 2, 4).reshape(Bsz, NC * c, H * d)


def chunk_gated_linear_attention(q, k, v, log_g, chunk):
    Bsz, S, H, dk = q.shape
    dv = v.shape[-1]
    causal = jnp.tril(jnp.ones((chunk, chunk), bool))[:, :, None]

    def step(state, inp):
        qb, kb, vb, gb = inp
        G = jnp.cumsum(gb, axis=2)
        diff = G[:, :, :, None, :] - G[:, :, None, :, :]
        decay = masked_exp(diff, causal)
        scores = jnp.einsum('bhid,bhjd,bhijd->bhij', qb, kb, decay)
        out = (jnp.einsum('bhij,bhje->bhie', scores, vb)
               + jnp.einsum('bhid,bhde->bhie', qb * jnp.exp(G), state))
        G_last = G[:, :, -1]
        k_dec = kb * jnp.exp(G_last[:, :, None, :] - G)
        state = jnp.exp(G_last)[..., None] * state + jnp.einsum('bhcd,bhce->bhde', k_dec, vb)
        return state, out

    state0 = jnp.zeros((Bsz, H, dk, dv), q.dtype)
    _, out = lax.scan(step, state0, (to_chunks(q, chunk), to_chunks(k, chunk),
                                     to_chunks(v, chunk), to_chunks(log_g, chunk)))
    return from_chunks(out)


def chunk_mlstm(q, k, v, i_pre, log_f, chunk):
    Bsz, S, H, dk = q.shape
    dv = v.shape[-1]
    causal = jnp.tril(jnp.ones((chunk, chunk), bool))

    def step(carry, inp):
        C, n, m = carry
        qb, kb, vb, ib, fb = inp
        b = jnp.cumsum(fb, axis=-1)
        logw = jnp.where(causal, b[..., :, None] - b[..., None, :] + ib[..., None, :], NEG_BIG)
        m_inter = b + m[..., None]
        m_row = jnp.maximum(jnp.max(logw, axis=-1), m_inter)
        s = jnp.einsum('bhid,bhjd->bhij', qb, kb) * masked_exp(logw - m_row[..., None], causal)
        inter = jnp.exp(m_inter - m_row)
        num = (jnp.einsum('bhij,bhje->bhie', s, vb)
               + inter[..., None] * jnp.einsum('bhid,bhde->bhie', qb, C))
        den = jnp.sum(s, axis=-1) + inter * jnp.einsum('bhid,bhd->bhi', qb, n)
        h = num / jnp.maximum(jnp.abs(den), jnp.exp(-m_row))[..., None]
        b_last = b[..., -1]
        logw_end = b_last[..., None] - b + ib
        m_new = jnp.maximum(b_last + m, jnp.max(logw_end, axis=-1))
        carry_decay = jnp.exp(b_last + m - m_new)
        k_w = kb * jnp.exp(logw_end - m_new[..., None])[..., None]
        C = carry_decay[..., None, None] * C + jnp.einsum('bhcd,bhce->bhde', k_w, vb)
        n = carry_decay[..., None] * n + jnp.sum(k_w, axis=2)
        return (C, n, m_new), h

    carry0 = (jnp.zeros((Bsz, H, dk, dv), q.dtype), jnp.zeros((Bsz, H, dk), q.dtype),
              jnp.zeros((Bsz, H), q.dtype))
    _, out = lax.scan(step, carry0, (to_chunks(q, chunk), to_chunks(k, chunk), to_chunks(v, chunk),
                                     to_chunks(i_pre, chunk), to_chunks(log_f, chunk)))
    return from_chunks(out)


def segsum_exp(a):
    T = a.shape[-1]
    rep = jnp.broadcast_to(a[..., :, None], a.shape + (T,))
    rep = jnp.where(jnp.tril(jnp.ones((T, T), bool), -1), rep, 0.0)
    ss = jnp.cumsum(rep, axis=-2)
    return masked_exp(ss, jnp.tril(jnp.ones((T, T), bool)))


def ssd_chunked(x, a, Bm, Cm, chunk):
    Bsz, S, H, P = x.shape
    G, N = Bm.shape[2], Bm.shape[3]
    R = H // G
    NC = S // chunk
    x = x.reshape(Bsz, NC, chunk, G, R, P)
    Bm = Bm.reshape(Bsz, NC, chunk, G, N)
    Cm = Cm.reshape(Bsz, NC, chunk, G, N)
    a = a.reshape(Bsz, NC, chunk, G, R).transpose(0, 3, 4, 1, 2)
    a_cs = jnp.cumsum(a, axis=-1)
    L = segsum_exp(a)
    CB = jnp.einsum('bclgn,bcsgn->bgcls', Cm, Bm)
    y_diag = jnp.einsum('bgrcls,bcsgrp->bclgrp', CB[:, :, None] * L, x)
    decay_states = jnp.exp(a_cs[..., -1:] - a_cs)
    states = jnp.einsum('bclgn,bgrcl,bclgrp->bcgrpn', Bm, decay_states, x)
    states = jnp.concatenate([jnp.zeros_like(states[:, :1]), states], axis=1)
    chunk_a = jnp.pad(a_cs[..., -1], ((0, 0), (0, 0), (0, 0), (1, 0)))
    decay_chunk = segsum_exp(chunk_a)
    states = jnp.einsum('bgrzc,bcgrpn->bzgrpn', decay_chunk, states)[:, :-1]
    y_off = jnp.einsum('bclgn,bcgrpn,bgrcl->bclgrp', Cm, states, jnp.exp(a_cs))
    return (y_diag + y_off).reshape(Bsz, S, H, P)


def gla_branch(q_raw, k_raw, v_raw, gr, z, gate_w, gate_b, norm_w):
    Bsz, S = q_raw.shape[:2]
    q = q_raw.reshape(Bsz, S, GLA_HEADS, GLA_DK) * (GLA_DK ** -0.5)
    k = k_raw.reshape(Bsz, S, GLA_HEADS, GLA_DK)
    v = v_raw.reshape(Bsz, S, GLA_HEADS, GLA_DV)
    log_g = jax.nn.log_sigmoid(gr @ gate_w + gate_b) / GLA_GATE_NORM
    log_g = log_g.reshape(Bsz, S, GLA_HEADS, GLA_DK)
    o = chunk_gated_linear_attention(q, k, v, log_g, GLA_CHUNK)
    return grouped_rmsnorm(o, norm_w, GLA_HEADS) * jax.nn.silu(z)


def mlstm_branch(q_raw, k_raw, v_raw, i_raw, f_raw, o_raw, z, conv_w, conv_b, i_b, f_b, norm_w):
    Bsz, S = q_raw.shape[:2]
    qk = jax.nn.silu(causal_dwconv(jnp.concatenate([q_raw, k_raw], axis=-1), conv_w, conv_b))
    q = qk[..., :D_BRANCH].reshape(Bsz, S, MLSTM_HEADS, MLSTM_DH)
    k = qk[..., D_BRANCH:].reshape(Bsz, S, MLSTM_HEADS, MLSTM_DH) * (MLSTM_DH ** -0.5)
    v = v_raw.reshape(Bsz, S, MLSTM_HEADS, MLSTM_DH)
    i_pre = i_raw + i_b
    log_f = jax.nn.log_sigmoid(f_raw + f_b)
    h = chunk_mlstm(q, k, v, i_pre, log_f, MLSTM_CHUNK)
    h = jax.nn.sigmoid(o_raw) * h
    return grouped_rmsnorm(h, norm_w, MLSTM_HEADS) * jax.nn.silu(z)


def hgrn2_branch(q_raw, f_raw, i_raw, z, lb, norm_w):
    Bsz, S = q_raw.shape[:2]
    lb = lb.reshape(HGRN_HEADS, HGRN_DK)
    fr = f_raw.reshape(Bsz, S, HGRN_HEADS, HGRN_DK)
    f = lb + (1.0 - lb) * jax.nn.sigmoid(fr)
    log_f = jnp.log(jnp.maximum(f, 1e-30))
    k = (1.0 - lb) * jax.nn.sigmoid(-fr)
    q = q_raw.reshape(Bsz, S, HGRN_HEADS, HGRN_DK) * (HGRN_DK ** -0.5)
    v = i_raw.reshape(Bsz, S, HGRN_HEADS, HGRN_DV)
    o = chunk_gated_linear_attention(q, k, v, log_f, HGRN_CHUNK)
    return grouped_rmsnorm(o, norm_w, HGRN_HEADS) * jax.nn.silu(z)


def ssd_branch(x_raw, B_raw, C_raw, dt_raw, z, conv_w, conv_b, dt_bias, A_log, D, norm_w):
    Bsz, S = x_raw.shape[:2]
    xbc = jax.nn.silu(causal_dwconv(jnp.concatenate([x_raw, B_raw, C_raw], axis=-1), conv_w, conv_b))
    xs = xbc[..., :D_BRANCH].reshape(Bsz, S, SSD_HEADS, SSD_HEAD_DIM)
    Bm = xbc[..., D_BRANCH:D_BRANCH + SSD_BC].reshape(Bsz, S, SSD_GROUPS, SSD_STATE)
    Cm = xbc[..., D_BRANCH + SSD_BC:].reshape(Bsz, S, SSD_GROUPS, SSD_STATE)
    dt = jax.nn.softplus(dt_raw + dt_bias)
    A = -jnp.exp(A_log)
    y = ssd_chunked(xs * dt[..., None], dt * A, Bm, Cm, SSD_CHUNK)
    y = (y + D[:, None] * xs).reshape(Bsz, S, D_BRANCH)
    return grouped_rmsnorm(y * jax.nn.silu(z), norm_w, SSD_GROUPS)


def setup_inputs(seed: int = 0) -> dict:
    key = jax.random.key(seed)
    ks = jax.random.split(key, 24)
    f32 = jnp.float32
    nrm = lambda k, shape, s: s * jax.random.normal(k, shape, f32)
    dt0 = jnp.exp(jax.random.uniform(ks[15], (DEPTH, SSD_HEADS), f32, np.log(1e-3), np.log(1e-1)))
    return {
        "x": jax.random.normal(ks[0], (BATCH, SEQ, D_MODEL), f32),
        "norm_w": 1.0 + nrm(ks[1], (DEPTH, D_MODEL), 0.02),
        "w_in": nrm(ks[2], (DEPTH, D_MODEL, D_PROJ), D_MODEL ** -0.5),
        "gla_gate_w": nrm(ks[3], (DEPTH, GLA_GATE_RANK, GLA_QK), GLA_GATE_RANK ** -0.5),
        "gla_gate_b": nrm(ks[4], (DEPTH, GLA_QK), 0.1),
        "gla_norm_w": 1.0 + nrm(ks[5], (DEPTH, D_BRANCH), 0.02),
        "ml_conv_w": nrm(ks[6], (DEPTH, MLSTM_CONV, 2 * D_BRANCH), MLSTM_CONV ** -0.5),
        "ml_conv_b": nrm(ks[7], (DEPTH, 2 * D_BRANCH), 0.02),
        "ml_i_b": nrm(ks[8], (DEPTH, MLSTM_HEADS), 0.1),
        "ml_f_b": jnp.linspace(3.0, 6.0, MLSTM_HEADS, dtype=f32)[None] + nrm(ks[9], (DEPTH, MLSTM_HEADS), 0.1),
        "ml_norm_w": 1.0 + nrm(ks[10], (DEPTH, D_BRANCH), 0.02),
        "hg_lb_logits": nrm(ks[11], (DEPTH, HGRN_QF), 0.1),
        "hg_norm_w": 1.0 + nrm(ks[12], (DEPTH, D_BRANCH), 0.02),
        "ssd_conv_w": nrm(ks[13], (DEPTH, SSD_CONV, D_BRANCH + 2 * SSD_BC), SSD_CONV ** -0.5),
        "ssd_conv_b": nrm(ks[14], (DEPTH, D_BRANCH + 2 * SSD_BC), 0.02),
        "ssd_dt_bias": dt0 + jnp.log(-jnp.expm1(-dt0)),
        "ssd_A_log": jnp.log(jax.random.uniform(ks[16], (DEPTH, SSD_HEADS), f32, 1.0, 16.0)),
        "ssd_D": 1.0 + nrm(ks[17], (DEPTH, SSD_HEADS), 0.02),
        "ssd_norm_w": 1.0 + nrm(ks[18], (DEPTH, D_BRANCH), 0.02),
        "w_out": nrm(ks[19], (DEPTH, D_INNER, D_MODEL), D_INNER ** -0.5),
        "final_norm_w": 1.0 + nrm(ks[20], (D_MODEL,), 0.02),
    }


def reference(x, norm_w, w_in, gla_gate_w, gla_gate_b, gla_norm_w, ml_conv_w, ml_conv_b, ml_i_b,
              ml_f_b, ml_norm_w, hg_lb_logits, hg_norm_w, ssd_conv_w, ssd_conv_b, ssd_dt_bias,
              ssd_A_log, ssd_D, ssd_norm_w, w_out, final_norm_w):
    f32 = jnp.float32
    split_at = [int(s) for s in np.cumsum(PROJ_SIZES)[:-1]]
    p = jax.nn.softmax(hg_lb_logits.astype(f32), axis=0)
    lower_bounds = jnp.cumsum(p, axis=0) - p[0:1]
    h = x
    for l in range(DEPTH):
        u = rmsnorm(h, norm_w[l])
        proj = (u @ w_in[l]).astype(f32)
        (a_q, a_k, a_v, a_gr, a_z,
         b_q, b_k, b_v, b_i, b_f, b_o, b_z,
         c_q, c_f, c_i, c_z,
         d_x, d_B, d_C, d_dt, d_z) = jnp.split(proj, split_at, axis=-1)
        y_a = gla_branch(a_q, a_k, a_v, a_gr, a_z, gla_gate_w[l].astype(f32), gla_gate_b[l].astype(f32),
                         gla_norm_w[l])
        y_b = mlstm_branch(b_q, b_k, b_v, b_i, b_f, b_o, b_z, ml_conv_w[l].astype(f32), ml_conv_b[l],
                           ml_i_b[l].astype(f32), ml_f_b[l].astype(f32), ml_norm_w[l])
        y_c = hgrn2_branch(c_q, c_f, c_i, c_z, lower_bounds[l], hg_norm_w[l])
        y_d = ssd_branch(d_x, d_B, d_C, d_dt, d_z, ssd_conv_w[l].astype(f32), ssd_conv_b[l],
                         ssd_dt_bias[l].astype(f32), ssd_A_log[l].astype(f32), ssd_D[l].astype(f32),
                         ssd_norm_w[l])
        mixed = jnp.concatenate([y_a, y_b, y_c, y_d], axis=-1).astype(h.dtype)
        h = h + mixed @ w_out[l]
    return rmsnorm(h, final_norm_w)
```

```cpp
#include <hip/hip_runtime.h>
#include <hip/hip_cooperative_groups.h>
#include <cstdio>
#include <cstdint>
namespace cg = cooperative_groups;

constexpr int NTOK = 16384, SEQ = 8192, DM = 1024, DEPTH = 2, DPROJ = 7712, DINNER = 2048;
constexpr int PP = 7680;
constexpr int NPAD = 7936;
constexpr float EPS = 1e-6f;
constexpr int ZA = 0, ZB = 512, ZC = 1024, ZD = 1536;
__host__ __device__ constexpr int AQc(int h) { return 2048 + h * 256; }
__host__ __device__ constexpr int AKc(int h) { return 2048 + h * 256 + 64; }
__host__ __device__ constexpr int AVc(int h) { return 2048 + h * 256 + 128; }
__host__ __device__ constexpr int BQc(int h) { return 3072 + h * 512; }
__host__ __device__ constexpr int BKc(int h) { return 3072 + h * 512 + 128; }
__host__ __device__ constexpr int BVc(int h) { return 3072 + h * 512 + 256; }
__host__ __device__ constexpr int BOc(int h) { return 3072 + h * 512 + 384; }
__host__ __device__ constexpr int CQc(int h) { return 5120 + h * 384; }
__host__ __device__ constexpr int CFc(int h) { return 5120 + h * 384 + 128; }
__host__ __device__ constexpr int CIc(int h) { return 5120 + h * 384 + 256; }
constexpr int DSSD = 6656;
__host__ __device__ constexpr int DXc(int g) { return DSSD + g * 512; }
__host__ __device__ constexpr int DBc(int g) { return DSSD + g * 512 + 256; }
__host__ __device__ constexpr int DCc(int g) { return DSSD + g * 512 + 384; }
constexpr int G_GR = 0, G_BI = 16, G_BF = 20, G_DT = 24;

__host__ __device__ __forceinline__ int win_src_col(int n) {
    if (n < 2048) { const int g = n >> 9, r = n & 511; const int base = (g == 0) ? 1040 : (g == 1) ? 3608 : (g == 2) ? 5656 : 7200; return base + r; }
    if (n < 3072) { const int j = n - 2048, h = j >> 8, r = j & 255; return (r < 64) ? h * 64 + r : (r < 128) ? 256 + h * 64 + (r - 64) : 512 + h * 128 + (r - 128); }
    if (n < 5120) { const int j = n - 3072, h = j >> 9, r = j & 511, part = r >> 7, c = r & 127; return ((part == 0) ? 1552 : (part == 1) ? 2064 : (part == 2) ? 2576 : 3096) + h * 128 + c; }
    if (n < 6656) { const int j = n - 5120, h = j / 384, r = j % 384, part = r >> 7, c = r & 127; return ((part == 0) ? 4120 : (part == 1) ? 4632 : 5144) + h * 128 + c; }
    if (n < 7680) { const int j = n - 6656, g = j >> 9, r = j & 511; return (r < 256) ? 6168 + g * 256 + r : (r < 384) ? 6680 + g * 128 + (r - 256) : 6936 + g * 128 + (r - 384); }
    const int j = n - 7680;
    if (j < 16) return 1024 + j;
    if (j < 20) return 3088 + (j - 16);
    if (j < 24) return 3092 + (j - 20);
    if (j < 32) return 7192 + (j - 24);
    return -1;
}

constexpr size_t MiB = 1u << 20;
constexpr size_t WS_CTL = 0;
constexpr size_t WS_PROJ = 1 * MiB;
constexpr size_t WS_GATES = 241 * MiB;
constexpr size_t WS_WOUT = 243 * MiB;
constexpr size_t WS_SSQ = 251 * MiB;
constexpr size_t WS_RSTD0 = 252 * MiB;
constexpr size_t WS_MISC = 252 * MiB + 65536;
constexpr size_t WS_HALO = 253 * MiB;
constexpr size_t WS_END = 256 * MiB;
constexpr size_t DO_HB = 0;
constexpr size_t DO_WIN = 32 * MiB;
constexpr size_t DO_WIN_STRIDE = 15 * MiB + MiB / 2;
constexpr size_t DO_STATE = 32 * MiB;

typedef unsigned short bf16;
typedef float f32x4v __attribute__((ext_vector_type(4)));
typedef unsigned u32x4v __attribute__((ext_vector_type(4)));
typedef unsigned u32x2v __attribute__((ext_vector_type(2)));
#define LAS __attribute__((address_space(3)))

__device__ __forceinline__ float bf2f(unsigned short u) { return __uint_as_float(((unsigned)u) << 16); }
__device__ __forceinline__ unsigned f2bf(float f) { unsigned u = __float_as_uint(f); return (u + 0x7fffu + ((u >> 16) & 1u)) >> 16; }
__device__ __forceinline__ unsigned pk2(float lo, float hi) { return f2bf(lo) | (f2bf(hi) << 16); }
__device__ __forceinline__ float sigmoidf_(float x) { return 1.f / (1.f + __expf(-x)); }
__device__ __forceinline__ float siluf_(float x) { return x / (1.f + __expf(-x)); }
__device__ __forceinline__ float softplusf_(float x) { return fmaxf(x, 0.f) + log1pf(__expf(-fabsf(x))); }
__device__ __forceinline__ float logsigmoidf_(float x) { return fminf(x, 0.f) - log1pf(__expf(-fabsf(x))); }
__device__ __forceinline__ float wave_sum(float v) {
#pragma unroll
    for (int o = 1; o < 64; o <<= 1) v += __shfl_xor(v, o);
    return v;
}

typedef float f32x2c __attribute__((ext_vector_type(2)));
typedef __bf16 bf16x2c __attribute__((ext_vector_type(2)));
__device__ __forceinline__ unsigned cvt_pk2(float lo, float hi) { f32x2c v = {lo, hi}; bf16x2c r = __builtin_convertvector(v, bf16x2c); return __builtin_bit_cast(unsigned, r); }
__device__ __forceinline__ int opaque_tid() { int t = threadIdx.x; asm volatile("" : "+v"(t)); return t; }

struct Params {
    const float* x; const float* norm_w; const float* w_in; const float* gla_gate_w; const float* gla_gate_b; const float* gla_norm_w;
    const float* ml_conv_w; const float* ml_conv_b; const float* ml_i_b; const float* ml_f_b; const float* ml_norm_w;
    const float* hg_lb; const float* hg_norm_w; const float* ssd_conv_w; const float* ssd_conv_b; const float* ssd_dt_bias;
    const float* ssd_A_log; const float* ssd_D; const float* ssd_norm_w; const float* w_out; const float* final_norm_w;
    float* out; unsigned char* ws;
};
typedef const __attribute__((address_space(4))) Params* KP;
namespace pg8 {
#define PG8_LAS __attribute__((address_space(3)))
typedef unsigned short bf16_t;
typedef short bf16x8 __attribute__((ext_vector_type(8)));
typedef float f32x4 __attribute__((ext_vector_type(4)));
typedef unsigned u32x4 __attribute__((ext_vector_type(4)));
constexpr int BM = 256, BK = 64, HALF = 128, HTB = HALF * BK * 2  , STAGE_BYTES = 8 * HTB, NXCD = 8, WGM = 4;

__host__ __device__ __forceinline__ int lds_byte(int r, int c) { const int st = (r >> 4) * 2 + (c >> 5), rr = r & 15, cc = c & 31, ob = rr * 64 + cc * 2; return st * 1024 + (ob ^ (((ob >> 9) & 1) << 5)); }
__host__ __device__ __forceinline__ void stage_rc(int b, int& R, int& C) { const int st = b / 1024, sb = b % 1024, swz = sb ^ (((sb >> 9) & 1) << 5); R = (st >> 1) * 16 + swz / 64; C = (st & 1) * 32 + (swz % 64) / 2; }
__host__ __device__ __forceinline__ int perm32(int rho) { const int n = rho >> 4, i = rho & 15; return 8 * (i >> 2) + 4 * n + (i & 3); }

struct Unit { int pm, pn, idx; };
struct Gemm { const bf16_t* A; const bf16_t* Bt; int M, N, K, lda; };

struct StaticOrder {
    int nM, nN, nwg, G, c;
    __host__ __device__ void init(int M, int N, int G_, int c_) { nM = M / BM; nN = N / BM; nwg = nM * nN; G = G_; c = c_; }
    __host__ __device__ bool next(int i, Unit& u) const {
        const long L = (long)i * G + c; if (L >= nwg) return false;
        int wgid = (int)L; { const int q = nwg / NXCD, r = nwg % NXCD, xcd = wgid % NXCD, off = wgid / NXCD; wgid = (xcd < r ? xcd * (q + 1) : r * (q + 1) + (xcd - r) * q) + off; }
        const int nig = WGM * nN, gid = wgid / nig, fm = gid * WGM, gsz = (nM - fm) < WGM ? (nM - fm) : WGM;
        u.pm = fm + ((wgid % nig) % gsz); u.pn = (wgid % nig) / gsz; u.idx = i; return true;
    }
    __device__ __forceinline__ void a_ready(const Unit&) const {}
    __device__ __forceinline__ void done(const Unit&) const {}
};

__device__ __forceinline__ unsigned cvt_pk_bf16(float lo, float hi) { return cvt_pk2(lo, hi); }

template <class Epi, class Sched, bool ALIGN_EPI = false, bool SP2 = false>
__device__ __forceinline__ void gemm_phase(PG8_LAS unsigned char* lds, const Gemm g, const Sched& S, const Epi& E) {
    const int tid = opaque_tid(), wid = __builtin_amdgcn_readfirstlane(tid >> 6), lane = tid & 63, wr = wid >> 2, wc = wid & 3, fr = lane & 15, fq = lane >> 4;
    const int K = g.K, nt = K / BK, lda = g.lda;
    unsigned voffA[2], voffB[2];
#pragma unroll
    for (int i = 0; i < 2; ++i) { int R, C; stage_rc(tid * 16 + i * 8192, R, C); const int Rb = Epi::PERM ? ((R & ~31) + perm32(R & 31)) : R;
        voffA[i] = (unsigned)(R * lda + C) * 2u; voffB[i] = (unsigned)(Rb * K + C) * 2u; }
    const size_t kstep = (size_t)(BK * 2);
    const size_t hsA = (size_t)HALF * lda * 2, hsB = (size_t)HALF * K * 2;
    const size_t tsA = 2 * hsA, tsB = 2 * hsB;
    const unsigned ldsw = (unsigned)wid * 1024u;
    const int aoff = lds_byte(wr * 64 + fr, fq * 8), boff = lds_byte(wc * 32 + fr, fq * 8);
#define PG8_SA(b, h) (((b) * 2 + (h)) * HTB)
#define PG8_SB(b, h) ((4 + (b) * 2 + (h)) * HTB)
#define PG8_STAGE(bufoff, gbase, voff) do { _Pragma("unroll") for (int _i = 0; _i < 2; ++_i) \
        __builtin_amdgcn_global_load_lds((const unsigned*)((const char*)(gbase) + (voff)[_i]), (PG8_LAS unsigned*)(lds + (bufoff) + ldsw + _i * 8192), 16, 0, 0); } while (0)
#define PG8_LDA(dst, b, h) do { _Pragma("unroll") for (int m = 0; m < 4; ++m) _Pragma("unroll") for (int k = 0; k < 2; ++k) dst[m][k] = *(const PG8_LAS bf16x8*)(lds + PG8_SA(b, h) + aoff + m * 2048 + k * 1024); } while (0)
#define PG8_LDB(dst, b, h) do { _Pragma("unroll") for (int n = 0; n < 2; ++n) _Pragma("unroll") for (int k = 0; k < 2; ++k) dst[n][k] = *(const PG8_LAS bf16x8*)(lds + PG8_SB(b, h) + boff + n * 2048 + k * 1024); } while (0)
#define PG8_MMA(ai, bj, At, Bt) do { __builtin_amdgcn_s_setprio(1); _Pragma("unroll") for (int m = 0; m < 4; ++m) _Pragma("unroll") for (int n = 0; n < 2; ++n) _Pragma("unroll") for (int k = 0; k < 2; ++k) \
        acc[ai][bj][m][n] = __builtin_amdgcn_mfma_f32_16x16x32_bf16(Bt[n][k], At[m][k], acc[ai][bj][m][n], 0, 0, 0); __builtin_amdgcn_s_setprio(0); } while (0)
#define PG8_WAIT_V(n) asm volatile("s_waitcnt vmcnt(" #n ")" ::: "memory")
#define PG8_WAIT_L(n) asm volatile("s_waitcnt lgkmcnt(" #n ")" ::: "memory")
#define PG8_BAR __builtin_amdgcn_s_barrier()
#define PG8_SCHED __builtin_amdgcn_sched_barrier(0)
    Unit cur, nxt; int ui = 0;
    if (!S.next(0, cur)) return;
    f32x4 acc[2][2][4][2];
#pragma unroll
    for (int a = 0; a < 2; ++a)
#pragma unroll
        for (int b = 0; b < 2; ++b)
#pragma unroll
            for (int m = 0; m < 4; ++m)
#pragma unroll
                for (int n = 0; n < 2; ++n) acc[a][b][m][n] = (f32x4){0.f, 0.f, 0.f, 0.f};
    bf16x8 At[4][2], B0[2][2], B1[2][2];
    const char* cA = (const char*)g.A + (size_t)cur.pm * tsA; const char* cB = (const char*)g.Bt + (size_t)cur.pn * tsB;
    S.a_ready(cur);
    if constexpr (SP2) {
        PG8_STAGE(PG8_SB(0, 0), cB, voffB); PG8_STAGE(PG8_SB(0, 1), cB + hsB, voffB); PG8_STAGE(PG8_SA(0, 0), cA, voffA); PG8_STAGE(PG8_SA(0, 1), cA + hsA, voffA);
        if (wr == 1) PG8_BAR;
        PG8_WAIT_V(2); PG8_BAR;
        PG8_STAGE(PG8_SB(1, 0), cB + kstep, voffB); PG8_STAGE(PG8_SA(1, 0), cA + kstep, voffA); PG8_STAGE(PG8_SB(1, 1), cB + hsB + kstep, voffB);
        PG8_WAIT_V(6); PG8_BAR;
    } else {
        PG8_STAGE(PG8_SB(0, 0), cB, voffB); PG8_STAGE(PG8_SA(0, 0), cA, voffA); PG8_STAGE(PG8_SB(0, 1), cB + hsB, voffB); PG8_STAGE(PG8_SA(0, 1), cA + hsA, voffA);
        if (wr == 1) PG8_BAR;
        PG8_WAIT_V(4); PG8_BAR;
        PG8_STAGE(PG8_SB(1, 0), cB + kstep, voffB); PG8_STAGE(PG8_SA(1, 0), cA + kstep, voffA); PG8_STAGE(PG8_SB(1, 1), cB + hsB + kstep, voffB);
        PG8_WAIT_V(6); PG8_BAR;
    }
    u32x4 held[4]; bool have_held = false; Unit hu = cur;
    for (;;) {
        const bool has_next = S.next(ui + 1, nxt);
        const char* nA = has_next ? (const char*)g.A + (size_t)nxt.pm * tsA : cA; const char* nB = has_next ? (const char*)g.Bt + (size_t)nxt.pn * tsB : cB;
        for (int t = 0; t < nt; t += 2) {
            const bool last = (t == nt - 2);
            const char* a1 = cA + (size_t)(t + 1) * kstep;
            const char* a2 = last ? nA : cA + (size_t)(t + 2) * kstep; const char* b2 = last ? nB : cB + (size_t)(t + 2) * kstep;
            const char* a3 = a2 + kstep; const char* b3 = b2 + kstep;
            if (last && has_next) S.a_ready(nxt);
            if constexpr (Epi::DEFER) { if (have_held && (t == 2 || t == 6)) E.store_held(held, hu, (t - 2) >> 2, wr, wc, fr, fq); }
            if constexpr (SP2) {
            PG8_LDB(B0, 0, 0); PG8_LDB(B1, 0, 1); PG8_SCHED; PG8_LDA(At, 0, 0); PG8_STAGE(PG8_SA(1, 1), a1 + hsA, voffA);
            PG8_WAIT_V(8); PG8_WAIT_L(0); PG8_BAR; PG8_MMA(0, 0, At, B0); PG8_MMA(0, 1, At, B1); PG8_BAR; PG8_SCHED;
            PG8_LDA(At, 0, 1); PG8_STAGE(PG8_SB(0, 0), b2, voffB); PG8_STAGE(PG8_SB(0, 1), b2 + hsB, voffB); PG8_STAGE(PG8_SA(0, 0), a2, voffA);
            PG8_WAIT_V(8); PG8_WAIT_L(0); PG8_BAR; PG8_MMA(1, 0, At, B0); PG8_MMA(1, 1, At, B1); PG8_BAR; PG8_SCHED;
            PG8_LDB(B0, 1, 0); PG8_LDB(B1, 1, 1); PG8_SCHED; PG8_LDA(At, 1, 0); PG8_STAGE(PG8_SA(0, 1), a2 + hsA, voffA);
            PG8_WAIT_V(8); PG8_WAIT_L(0); PG8_BAR; PG8_MMA(0, 0, At, B0); PG8_MMA(0, 1, At, B1); PG8_BAR; PG8_SCHED;
            PG8_LDA(At, 1, 1); PG8_STAGE(PG8_SB(1, 0), b3, voffB); PG8_STAGE(PG8_SB(1, 1), b3 + hsB, voffB); PG8_STAGE(PG8_SA(1, 0), a3, voffA);
            PG8_WAIT_V(8); PG8_WAIT_L(0); PG8_BAR; PG8_MMA(1, 0, At, B0); PG8_MMA(1, 1, At, B1); PG8_BAR; PG8_SCHED;
            } else {
            PG8_LDB(B0, 0, 0); PG8_SCHED; PG8_LDA(At, 0, 0); PG8_STAGE(PG8_SA(1, 1), a1 + hsA, voffA);
            PG8_WAIT_L(8); PG8_BAR; PG8_WAIT_L(0); PG8_MMA(0, 0, At, B0); PG8_BAR; PG8_SCHED;
            PG8_LDB(B1, 0, 1); PG8_STAGE(PG8_SB(0, 0), b2, voffB);
            PG8_BAR; PG8_WAIT_L(0); PG8_MMA(0, 1, At, B1); PG8_BAR;
            PG8_LDA(At, 0, 1); PG8_STAGE(PG8_SA(0, 0), a2, voffA);
            PG8_BAR; PG8_WAIT_L(0); PG8_MMA(1, 0, At, B0); PG8_BAR; PG8_SCHED;
            PG8_STAGE(PG8_SB(0, 1), b2 + hsB, voffB);
            PG8_WAIT_V(6); PG8_BAR; PG8_MMA(1, 1, At, B1); PG8_BAR;
            PG8_LDB(B0, 1, 0); PG8_SCHED; PG8_LDA(At, 1, 0); PG8_STAGE(PG8_SA(0, 1), a2 + hsA, voffA);
            PG8_WAIT_L(8); PG8_BAR; PG8_WAIT_L(0); PG8_MMA(0, 0, At, B0); PG8_BAR; PG8_SCHED;
            PG8_LDB(B1, 1, 1); PG8_STAGE(PG8_SB(1, 0), b3, voffB);
            PG8_BAR; PG8_WAIT_L(0); PG8_MMA(0, 1, At, B1); PG8_BAR;
            PG8_LDA(At, 1, 1); PG8_STAGE(PG8_SA(1, 0), a3, voffA);
            PG8_BAR; PG8_WAIT_L(0); PG8_MMA(1, 0, At, B0); PG8_BAR; PG8_SCHED;
            PG8_STAGE(PG8_SB(1, 1), b3 + hsB, voffB);
            PG8_WAIT_V(6); PG8_BAR; PG8_MMA(1, 1, At, B1); PG8_BAR;
            }
        }
        if constexpr (ALIGN_EPI) { if (wr == 0) PG8_BAR; }
        if constexpr (Epi::DEFER) {
            have_held = E.first_half_and_pack(acc, cur, wr, wc, fr, fq, held); hu = cur;
            if (!has_next) { if (have_held) { for (int q = 0; q < 2; ++q) E.store_held(held, hu, q, wr, wc, fr, fq); } S.done(cur); break; }
            S.done(cur);
        } else {
            E(acc, cur, wr, wc, fr, fq); S.done(cur);
            if (!has_next) break;
        }
#pragma unroll
        for (int a = 0; a < 2; ++a)
#pragma unroll
            for (int b = 0; b < 2; ++b)
#pragma unroll
                for (int m = 0; m < 4; ++m)
#pragma unroll
                    for (int n = 0; n < 2; ++n) acc[a][b][m][n] = (f32x4){0.f, 0.f, 0.f, 0.f};
        cur = nxt; cA = nA; cB = nB; ++ui;
        if constexpr (ALIGN_EPI) { if (wr == 1) PG8_BAR; }
    }
    PG8_WAIT_V(0);
    if constexpr (!ALIGN_EPI) { if (wr == 0) PG8_BAR; }
    PG8_BAR;
#undef PG8_SA
#undef PG8_SB
#undef PG8_STAGE
#undef PG8_LDA
#undef PG8_LDB
#undef PG8_MMA
#undef PG8_WAIT_V
#undef PG8_WAIT_L
#undef PG8_BAR
#undef PG8_SCHED
}
}
struct EpiProj {
    static constexpr bool PERM = true;
    static constexpr bool DEFER = true;
    bf16* proj; float* gates; const LAS float* rstd_tab; bf16* halo;
    __device__ __forceinline__ u32x4v pack8(const pg8::f32x4& a0, const pg8::f32x4& a1, float rs) const {
        const pg8::f32x4 v0 = a0 * rs, v1 = a1 * rs;
        u32x4v w; w.x = pg8::cvt_pk_bf16(v0[0], v0[1]); w.y = pg8::cvt_pk_bf16(v0[2], v0[3]); w.z = pg8::cvt_pk_bf16(v1[0], v1[1]); w.w = pg8::cvt_pk_bf16(v1[2], v1[3]); return w; }
    __device__ __forceinline__ bool first_half_and_pack(const pg8::f32x4 (&acc)[2][2][4][2], const pg8::Unit& u, int wr, int wc, int fr, int fq, pg8::u32x4 (&held)[4]) const {
        const int row0 = u.pm * 256 + wr * 64 + fr;
        if (u.pn < 30) {
#pragma unroll
            for (int ai = 0; ai < 2; ++ai)
#pragma unroll
                for (int m = 0; m < 4; ++m) {
                    const int row = row0 + ai * 128 + m * 16;
                    const float rs = rstd_tab[u.idx * 256 + (row & 255)];
#pragma unroll
                    for (int bj = 0; bj < 2; ++bj) { const u32x4v w = pack8(acc[ai][bj][m][0], acc[ai][bj][m][1], rs);
                        if (ai == 1 && m >= 2) held[(m - 2) * 2 + bj] = w;
                        else *(u32x4v*)(proj + (size_t)row * PP + u.pn * 256 + bj * 128 + wc * 32 + 8 * fq) = w;
                        if (u.pn >= 26 && (row & 511) >= 509)
                            *(u32x4v*)(halo + ((size_t)((row >> 9) * 3 + ((row & 511) - 509))) * 1024 + (u.pn - 26) * 256 + bj * 128 + wc * 32 + 8 * fq) = w; }
                }
            return true;
        }
        if (wc == 0) {
#pragma unroll
            for (int ai = 0; ai < 2; ++ai)
#pragma unroll
                for (int m = 0; m < 4; ++m) { const int row = row0 + ai * 128 + m * 16; const float rs = rstd_tab[u.idx * 256 + (row & 255)];
                    float* gp = gates + (size_t)row * 32 + 8 * fq;
                    *(pg8::f32x4*)(gp) = acc[ai][0][m][0] * rs; *(pg8::f32x4*)(gp + 4) = acc[ai][0][m][1] * rs; }
        }
        return false;
    }
    __device__ __forceinline__ void store_held(const pg8::u32x4 (&held)[4], const pg8::Unit& u, int q, int wr, int wc, int fr, int fq) const {
        bf16* base = proj + (size_t)(u.pm * 256 + wr * 64 + fr + 128) * PP + u.pn * 256 + wc * 32 + 8 * fq;
#pragma unroll
        for (int m = 2; m < 4; ++m) if (m - 2 == q) {
#pragma unroll
            for (int bj = 0; bj < 2; ++bj) *(u32x4v*)(base + (size_t)(m * 16) * PP + bj * 128) = held[(m - 2) * 2 + bj]; }
    }
};
struct EpiRes {
    static constexpr bool PERM = true;
    static constexpr bool DEFER = false;
    bf16* hb; float* ssq; bf16* h2; int last;
    __device__ __forceinline__ void operator()(const pg8::f32x4 (&acc)[2][2][4][2], const pg8::Unit& u, int wr, int wc, int fr, int fq) const {
        const int row0 = u.pm * 256 + wr * 64 + fr, col0 = u.pn * 256 + wc * 32 + 8 * fq;
        u32x4v res[2][4][2];
#pragma unroll
        for (int ai = 0; ai < 2; ++ai)
#pragma unroll
            for (int m = 0; m < 4; ++m)
#pragma unroll
                for (int bj = 0; bj < 2; ++bj) res[ai][m][bj] = *(const u32x4v*)(hb + (size_t)(row0 + ai * 128 + m * 16) * DM + col0 + bj * 128);
#pragma unroll
        for (int ai = 0; ai < 2; ++ai)
#pragma unroll
            for (int m = 0; m < 4; ++m) {
                const int row = row0 + ai * 128 + m * 16;
                float sq = 0.f;
#pragma unroll
                for (int bj = 0; bj < 2; ++bj) {
                    const int col = col0 + bj * 128;
                    const u32x4v rw = res[ai][m][bj];
                    const pg8::f32x4 r0 = (pg8::f32x4){__uint_as_float(rw.x << 16), __uint_as_float(rw.x & 0xffff0000u), __uint_as_float(rw.y << 16), __uint_as_float(rw.y & 0xffff0000u)};
                    const pg8::f32x4 r1 = (pg8::f32x4){__uint_as_float(rw.z << 16), __uint_as_float(rw.z & 0xffff0000u), __uint_as_float(rw.w << 16), __uint_as_float(rw.w & 0xffff0000u)};
                    const pg8::f32x4 v0 = acc[ai][bj][m][0] + r0, v1 = acc[ai][bj][m][1] + r1;
                    u32x4v w; w.x = pg8::cvt_pk_bf16(v0[0], v0[1]); w.y = pg8::cvt_pk_bf16(v0[2], v0[3]); w.z = pg8::cvt_pk_bf16(v1[0], v1[1]); w.w = pg8::cvt_pk_bf16(v1[2], v1[3]);
                    bf16* dst = last ? (bf16*)((char*)h2 + (size_t)row * (PP * 2)) + col : hb + (size_t)row * DM + col;
                    *(u32x4v*)dst = w;
                    sq += (v0[0] * v0[0] + v0[1] * v0[1]) + (v0[2] * v0[2] + v0[3] * v0[3]) + (v1[0] * v1[0] + v1[1] * v1[1]) + (v1[2] * v1[2] + v1[3] * v1[3]);
                }
                sq += __shfl_xor(sq, 16); sq += __shfl_xor(sq, 32);
                if (fq == 0) ssq[(size_t)(u.pn * 4 + wc) * NTOK + row] = sq;
            }
    }
};

constexpr int NIT_WIN = (DM / 64) * (NPAD / 32), NIT_WOUT = (DINNER / 64) * (DM / 32);
template <int NR>
__device__ __forceinline__ void rows_to_bf16_rstd(const float* x, bf16* hb, float* rstd, int m0, int mstride, int lane) {
    f32x4v v[NR][4];
#pragma unroll
    for (int q = 0; q < NR; ++q) { const f32x4v* xr = (const f32x4v*)(x + (size_t)(m0 + q * mstride) * DM) + lane;
#pragma unroll
        for (int j = 0; j < 4; ++j) v[q][j] = xr[64 * j]; }
#pragma unroll
    for (int q = 0; q < NR; ++q) { float s = 0.f;
#pragma unroll
        for (int j = 0; j < 4; ++j) s += (v[q][j].x * v[q][j].x + v[q][j].y * v[q][j].y) + (v[q][j].z * v[q][j].z + v[q][j].w * v[q][j].w);
        s = wave_sum(s);
        if (lane == 0) rstd[m0 + q * mstride] = 1.0f / sqrtf(s * (1.0f / DM) + EPS);
        u32x2v* o8 = (u32x2v*)(hb + (size_t)(m0 + q * mstride) * DM) + lane;
#pragma unroll
        for (int j = 0; j < 4; ++j) { u32x2v w; w.x = cvt_pk2(v[q][j].x, v[q][j].y); w.y = cvt_pk2(v[q][j].z, v[q][j].w); o8[64 * j] = w; } }
}
template <bool WIN>
__device__ __forceinline__ void transpose_item(const float* W, int K, int Nsrc, int Ndst, bf16* WT, LAS float* scr, int item, int lane, const float* kscale) {
    const int nb_n = Ndst / 32, kb = item / nb_n, nb = item % nb_n, k0 = 64 * kb, n0 = 32 * nb;
    const int n4 = (lane & 7) * 4; const int src = WIN ? win_src_col(n0 + n4) : (n0 + n4);
#pragma unroll
    for (int i = 0; i < 8; ++i) { const int kk = 8 * i + (lane >> 3);
        f32x4v v = (f32x4v){0.f, 0.f, 0.f, 0.f}; if (src >= 0) { v = *(const f32x4v*)(W + (size_t)(k0 + kk) * Nsrc + src); if (WIN) v = v * kscale[k0 + kk]; }
        scr[kk * 33 + n4] = v.x; scr[kk * 33 + n4 + 1] = v.y; scr[kk * 33 + n4 + 2] = v.z; scr[kk * 33 + n4 + 3] = v.w; }
    asm volatile("s_waitcnt lgkmcnt(0)" ::: "memory");
    const int c = lane & 7;
#pragma unroll
    for (int j = 0; j < 4; ++j) { const int n = (lane >> 3) + 8 * j; const LAS float* s = scr + (8 * c) * 33 + n;
        u32x4v o; o.x = cvt_pk2(s[0 * 33], s[1 * 33]); o.y = cvt_pk2(s[2 * 33], s[3 * 33]); o.z = cvt_pk2(s[4 * 33], s[5 * 33]); o.w = cvt_pk2(s[6 * 33], s[7 * 33]);
        *(u32x4v*)(WT + (size_t)(n0 + n) * K + k0 + 8 * c) = o; }
    asm volatile("s_waitcnt lgkmcnt(0)" ::: "memory");
}
struct TItem { const float* W; bf16* WT; const float* kscale; int K, Nsrc, k0, n0, src; bool win; };
__device__ __forceinline__ TItem cvt_item(KP P, int l, int it, int lane) {
    const int n_in = (l + 1 < DEPTH) ? NIT_WIN : 0; TItem t;
    if (it < n_in) { t.W = P->w_in + (size_t)(l + 1) * DM * DPROJ; t.K = DM; t.Nsrc = DPROJ; t.WT = (bf16*)((unsigned char*)P->out + DO_WIN + (size_t)(l + 1) * DO_WIN_STRIDE); t.kscale = P->norm_w + (l + 1) * DM; t.win = true;
        const int nb_n = NPAD / 32; t.k0 = 64 * (it / nb_n); t.n0 = 32 * (it % nb_n); t.src = win_src_col(t.n0 + (lane & 7) * 4); }
    else { const int i2 = it - n_in; t.W = P->w_out + (size_t)l * DINNER * DM; t.K = DINNER; t.Nsrc = DM; t.WT = (bf16*)(P->ws + WS_WOUT) + (size_t)l * DM * DINNER; t.kscale = nullptr; t.win = false;
        const int nb_n = DM / 32; t.k0 = 64 * (i2 / nb_n); t.n0 = 32 * (i2 % nb_n); t.src = t.n0 + (lane & 7) * 4; }
    return t;
}
__device__ __forceinline__ void cvt_load(const TItem& t, int lane, f32x4v (&v)[8]) {
#pragma unroll
    for (int i = 0; i < 8; ++i) { const int kk = 8 * i + (lane >> 3);
        v[i] = (f32x4v){0.f, 0.f, 0.f, 0.f}; if (t.src >= 0) { v[i] = *(const f32x4v*)(t.W + (size_t)(t.k0 + kk) * t.Nsrc + t.src); if (t.win) v[i] = v[i] * t.kscale[t.k0 + kk]; } }
}
__device__ __forceinline__ void cvt_finish(const TItem& t, int lane, const f32x4v (&v)[8], LAS float* scr) {
    const int n4 = (lane & 7) * 4;
#pragma unroll
    for (int i = 0; i < 8; ++i) { const int kk = 8 * i + (lane >> 3);
        scr[kk * 33 + n4] = v[i].x; scr[kk * 33 + n4 + 1] = v[i].y; scr[kk * 33 + n4 + 2] = v[i].z; scr[kk * 33 + n4 + 3] = v[i].w; }
    asm volatile("s_waitcnt lgkmcnt(0)" ::: "memory");
    const int c = lane & 7;
#pragma unroll
    for (int j = 0; j < 4; ++j) { const int n = (lane >> 3) + 8 * j; const LAS float* sp = scr + (8 * c) * 33 + n;
        u32x4v o; o.x = cvt_pk2(sp[0 * 33], sp[1 * 33]); o.y = cvt_pk2(sp[2 * 33], sp[3 * 33]); o.z = cvt_pk2(sp[4 * 33], sp[5 * 33]); o.w = cvt_pk2(sp[6 * 33], sp[7 * 33]);
        *(u32x4v*)(t.WT + (size_t)(t.n0 + n) * t.K + t.k0 + 8 * c) = o; }
    asm volatile("s_waitcnt lgkmcnt(0)" ::: "memory");
}
__device__ __forceinline__ void phase_prologue(KP P, int bid, int nblk, LAS unsigned char* lds) {
    const int tid = opaque_tid(), lane = tid & 63, wave = tid >> 6;
    const int gw = bid * 8 + wave, ngw = nblk * 8;
    LAS float* scr = (LAS float*)(lds + wave * 16384);
    bf16* hb = (bf16*)((unsigned char*)P->out + DO_HB); float* rstd0 = (float*)(P->ws + WS_RSTD0);
    { int m = gw;
      for (; m + 3 * ngw < NTOK; m += 4 * ngw) rows_to_bf16_rstd<4>(P->x, hb, rstd0, m, ngw, lane);
      for (; m < NTOK; m += ngw) rows_to_bf16_rstd<1>(P->x, hb, rstd0, m, 0, lane); }
    for (int it = gw; it < NIT_WIN; it += ngw)
        transpose_item<true>(P->w_in, DM, DPROJ, NPAD, (bf16*)((unsigned char*)P->out + DO_WIN), scr, it, lane, P->norm_w);
}
constexpr int CVT_BATCH = 1;
__device__ __forceinline__ void convert_weights_late(KP P, int l, int gw, int ngw, LAS unsigned char* lds) {
    const int tid = opaque_tid(), lane = tid & 63, wave = tid >> 6;
    LAS float* scr = (LAS float*)(lds + wave * 16384);
    const int n_in = (l + 1 < DEPTH) ? NIT_WIN : 0;
    for (int it = gw; it < n_in + NIT_WOUT; it += ngw) {
        if (it < n_in) transpose_item<true>(P->w_in + (size_t)(l + 1) * DM * DPROJ, DM, DPROJ, NPAD, (bf16*)((unsigned char*)P->out + DO_WIN + (size_t)(l + 1) * DO_WIN_STRIDE), scr, it, lane, P->norm_w + (l + 1) * DM);
        else transpose_item<false>(P->w_out + (size_t)l * DINNER * DM, DINNER, DM, DM, (bf16*)(P->ws + WS_WOUT) + (size_t)l * DM * DINNER, scr, it - n_in, lane, nullptr);
    }
}
__device__ __forceinline__ void convert_weights_queue(KP P, int l, LAS unsigned char* lds) {
    const int tid = opaque_tid(), lane = tid & 63, wave = tid >> 6;
    LAS float* scr = (LAS float*)(lds + wave * 16384);
    volatile LAS int* slot = (volatile LAS int*)(lds + 8 * 16384);
    const int ntot = ((l + 1 < DEPTH) ? NIT_WIN : 0) + NIT_WOUT;
    unsigned* ctr = (unsigned*)(P->ws + WS_CTL) + 64 + 32 * l;
    for (;;) {
        if (tid == 0) *slot = (int)__hip_atomic_fetch_add(ctr, 16u, __ATOMIC_RELAXED, __HIP_MEMORY_SCOPE_AGENT);
        __syncthreads();
        const int base = __builtin_amdgcn_readfirstlane(*slot);
        __syncthreads();
        if (base >= ntot) break;
        const int i0 = base + wave, i1 = base + 8 + wave;
        f32x4v va[8], vb[8]; TItem ta, tb;
        if (i0 < ntot) { ta = cvt_item(P, l, i0, lane); cvt_load(ta, lane, va); }
        if (i1 < ntot) { tb = cvt_item(P, l, i1, lane); cvt_load(tb, lane, vb); }
        if (i0 < ntot) cvt_finish(ta, lane, va, scr);
        if (i1 < ntot) cvt_finish(tb, lane, vb, scr);
    }
}
__device__ __forceinline__ void phase_gemm_in(KP P, int l, int bid, int nblk, LAS unsigned char* lds) {
    pg8::Gemm g{(const bf16*)((unsigned char*)P->out + DO_HB), (const bf16*)((unsigned char*)P->out + DO_WIN + (size_t)l * DO_WIN_STRIDE), NTOK, NPAD, DM, DM};
    pg8::StaticOrder S; S.init(NTOK, NPAD, nblk, bid);
    LAS float* rtab = (LAS float*)(lds + 131072);
    { const int tid = opaque_tid(); const float* rstd0 = (const float*)(P->ws + WS_RSTD0); const float* ssq = (const float*)(P->ws + WS_SSQ);
      const int nunit = min(((NTOK / 256) * (NPAD / 256) + nblk - 1) / nblk, 31);
      for (int e = tid; e < nunit * 256; e += 512) { pg8::Unit u; const int i = e >> 8;
          if (S.next(i, u)) { const int row = u.pm * 256 + (e & 255); float r;
              if (l == 0) r = rstd0[row];
              else { float sum = 0.f;
#pragma unroll
                  for (int p = 0; p < 16; ++p) sum += ssq[(size_t)p * NTOK + row];
                  r = 1.0f / sqrtf(sum * (1.0f / DM) + EPS); }
              rtab[e] = r; } }
      __syncthreads(); }
    EpiProj E{(bf16*)(P->ws + WS_PROJ), (float*)(P->ws + WS_GATES), rtab, (bf16*)(P->ws + WS_HALO)};
    pg8::gemm_phase<EpiProj, pg8::StaticOrder, true, true>(lds, g, S, E);
}
__device__ __forceinline__ void phase_gemm_out(KP P, int l, int bid, int nblk, LAS unsigned char* lds) {
    pg8::Gemm g{(const bf16*)(P->ws + WS_PROJ), (const bf16*)(P->ws + WS_WOUT) + (size_t)l * DM * DINNER, NTOK, DM, DINNER, PP};
    pg8::StaticOrder S; S.init(NTOK, DM, nblk, bid);
    EpiRes E{(bf16*)((unsigned char*)P->out + DO_HB), (float*)(P->ws + WS_SSQ), (bf16*)(P->ws + WS_PROJ + 4096), (l == DEPTH - 1) ? 1 : 0};
    pg8::gemm_phase<EpiRes, pg8::StaticOrder, false, true>(lds, g, S, E);
}
__device__ __forceinline__ void phase_final(KP P, int bid, int nblk) {
    const int tid = opaque_tid(), lane = tid & 63, wave = tid >> 6;
    const int gw = bid * 8 + wave, ngw = nblk * 8;
    const float* ssq = (const float*)(P->ws + WS_SSQ);
    f32x4v wv[4];
#pragma unroll
    for (int j = 0; j < 4; ++j) wv[j] = *((const f32x4v*)P->final_norm_w + 2 * lane + (j & 1) + 128 * (j >> 1));
    for (int m0 = gw; m0 < NTOK; m0 += 2 * ngw) {
        u32x4v ha[2], hb_[2]; float sp[2];
#pragma unroll
        for (int q = 0; q < 2; ++q) { const int m = m0 + q * ngw; const u32x4v* hr = (const u32x4v*)(P->ws + WS_PROJ + 4096 + (size_t)m * (PP * 2));
            ha[q] = hr[lane]; hb_[q] = hr[64 + lane]; sp[q] = (lane < 16) ? ssq[(size_t)lane * NTOK + m] : 0.f; }
#pragma unroll
        for (int q = 0; q < 2; ++q) { const int m = m0 + q * ngw;
            const float rs = 1.0f / sqrtf(wave_sum(sp[q]) * (1.0f / DM) + EPS);
            f32x4v* o = (f32x4v*)(P->out + (size_t)m * DM);
            f32x4v v;
            v = (f32x4v){__uint_as_float(ha[q].x << 16), __uint_as_float(ha[q].x & 0xffff0000u), __uint_as_float(ha[q].y << 16), __uint_as_float(ha[q].y & 0xffff0000u)}; o[2 * lane] = v * rs * wv[0];
            v = (f32x4v){__uint_as_float(ha[q].z << 16), __uint_as_float(ha[q].z & 0xffff0000u), __uint_as_float(ha[q].w << 16), __uint_as_float(ha[q].w & 0xffff0000u)}; o[2 * lane + 1] = v * rs * wv[1];
            v = (f32x4v){__uint_as_float(hb_[q].x << 16), __uint_as_float(hb_[q].x & 0xffff0000u), __uint_as_float(hb_[q].y << 16), __uint_as_float(hb_[q].y & 0xffff0000u)}; o[128 + 2 * lane] = v * rs * wv[2];
            v = (f32x4v){__uint_as_float(hb_[q].z << 16), __uint_as_float(hb_[q].z & 0xffff0000u), __uint_as_float(hb_[q].w << 16), __uint_as_float(hb_[q].w & 0xffff0000u)}; o[128 + 2 * lane + 1] = v * rs * wv[3]; }
    }
}
namespace mx {
typedef short bf16x8 __attribute__((ext_vector_type(8)));
typedef float f32x4 __attribute__((ext_vector_type(4)));
constexpr int SEGL = 512, NSEG = SEQ / SEGL, CH = 64, NCH = SEGL / CH;
constexpr int L_QT = 0, L_KT = 17408, L_KTT = 34816, L_VT = 53248, L_PM = 73984, L_ST = 92416, L_VVT = 131584, L_VEC = 150016;
constexpr int V_TOT = 0, V_PRE = 4096, V_POST = 4608, V_MISC = 5120;
constexpr size_t ST_GLA = 0, ST_HGRN = 1048576, ST_ML = 3145728, ST_SSD = 5505024;
constexpr int DS_GLA = 0, DS_HGRN = 8192, DS_ML = 24576, DS_SSD = 25600;

__device__ __forceinline__ int opq(int v) { asm volatile("" : "+v"(v)); return v; }
#define MFMA16(a, b, c) __builtin_amdgcn_mfma_f32_16x16x32_bf16((a), (b), (c), 0, 0, 0)
__device__ __forceinline__ bf16x8 frag(LAS unsigned char* base, int row, int pitch, int ks, int qd) { return *(const LAS bf16x8*)(base + row * pitch + ks * 64 + qd * 16); }
__device__ __forceinline__ int sw64(int row, int byteoff) { return row * 128 + ((((byteoff >> 4) ^ ((row >> 1) & 7)) << 4) | (byteoff & 15)); }
__device__ __forceinline__ bf16x8 frag64(LAS unsigned char* base, int row, int ks, int qd) { return *(const LAS bf16x8*)(base + row * 128 + (((4 * ks + qd) ^ ((row >> 1) & 7)) << 4)); }
template <int PQ> __device__ __forceinline__ int offp(int row, int byteoff) { return PQ == 272 ? row * 272 + byteoff : sw64(row, byteoff); }
template <int PQ> __device__ __forceinline__ bf16x8 fragp(LAS unsigned char* base, int row, int ks, int qd) { return PQ == 272 ? frag(base, row, 272, ks, qd) : frag64(base, row, ks, qd); }
__device__ __forceinline__ unsigned cvtpk(float lo, float hi) { return cvt_pk2(lo, hi); }
__device__ __forceinline__ u32x2v pack4(f32x4 v) { u32x2v w; w.x = cvtpk(v[0], v[1]); w.y = cvtpk(v[2], v[3]); return w; }
__device__ __forceinline__ float lo2f(unsigned w) { return __uint_as_float(w << 16); }
__device__ __forceinline__ float hi2f(unsigned w) { return __uint_as_float(w & 0xffff0000u); }

__device__ __forceinline__ float fexp(float x) { return __builtin_amdgcn_exp2f(x * 1.4426950408889634f); }
__device__ __forceinline__ float flog(float x) { return __builtin_amdgcn_logf(x) * 0.6931471805599453f; }
__device__ __forceinline__ float frcp(float x) { return __builtin_amdgcn_rcpf(x); }
__device__ __forceinline__ float frsq(float x) { return __builtin_amdgcn_rsqf(x); }
__device__ __forceinline__ float fsigmoid(float x) { return frcp(1.f + fexp(-x)); }
__device__ __forceinline__ float fsilu(float x) { return x * frcp(1.f + fexp(-x)); }
__device__ __forceinline__ float flog1pexp(float nx) { return flog(1.f + fexp(nx)); }
__device__ __forceinline__ float flogsigmoid(float x) { return fminf(x, 0.f) - flog1pexp(-fabsf(x)); }
__device__ __forceinline__ float fsoftplus(float x) { return fmaxf(x, 0.f) + flog1pexp(-fabsf(x)); }

constexpr int FLAG_OFF = 8192, FLAG_SSD = 0, FLAG_ML = 64, FLAG_HG = 192, FLAG_GLA = 320;
__device__ __forceinline__ unsigned* flag_ptr(KP P, int fbase, int idx) { return (unsigned*)(P->ws + WS_CTL) + FLAG_OFF + (fbase + idx) * 16; }
__device__ __forceinline__ void st_wt(bf16* p, u32x2v v) { __hip_atomic_store((unsigned long long*)p, ((unsigned long long)v.y << 32) | v.x, __ATOMIC_RELAXED, __HIP_MEMORY_SCOPE_AGENT); }
__device__ __forceinline__ void st_wt_f(float* p, float v) { __hip_atomic_store(p, v, __ATOMIC_RELAXED, __HIP_MEMORY_SCOPE_AGENT); }
__device__ __forceinline__ void publish_item(unsigned* flag, unsigned epoch) {
    asm volatile("s_waitcnt vmcnt(0)" ::: "memory");
    __syncthreads();
    if (threadIdx.x == 0) __hip_atomic_store(flag, epoch, __ATOMIC_RELAXED, __HIP_MEMORY_SCOPE_AGENT);
}
__device__ __forceinline__ void wait_predecessors(unsigned* flag0, int s, unsigned epoch) {
    {
        if ((int)threadIdx.x < 64) {
            if ((int)threadIdx.x < s) { unsigned spins = 0;
                while (__hip_atomic_load(flag0 + threadIdx.x * 16, __ATOMIC_RELAXED, __HIP_MEMORY_SCOPE_AGENT) < epoch) { __builtin_amdgcn_s_sleep(2); if (++spins > (1u << 22)) break; } }
            __builtin_amdgcn_fence(__ATOMIC_ACQUIRE, "agent");
            asm volatile("s_waitcnt vmcnt(0)" ::: "memory");
        }
    }
    __syncthreads();
}

template <int TYPE, bool OUT, bool DRY = false>
__device__ __forceinline__ void pc_item(KP P, int l, int b, int h, int s, LAS unsigned char* lds) {
    if (!OUT && s == NSEG - 1) return;
    constexpr int DK = (TYPE == 0) ? 64 : 128, NDT = DK / 16, PQ = (DK == 128) ? 272 : 144, NKS = DK / 32;
    const int tid = opaque_tid(), lane = tid & 63, w = __builtin_amdgcn_readfirstlane(tid >> 6), r = lane & 15, qd = lane >> 4;
    const int cp = lane, g = w;
    constexpr int NTK = (TYPE == 0) ? 4 : 8;
    const int ck = (TYPE == 0) ? (lane & 31) : lane, th = (TYPE == 0) ? (lane >> 5) : 0;
    const bool kact = true;
    bf16* proj = (bf16*)(P->ws + WS_PROJ);
    LAS float* vtot = (LAS float*)(lds + L_VEC + V_TOT); LAS float* vpre = (LAS float*)(lds + L_VEC + V_PRE); LAS float* vpost = (LAS float*)(lds + L_VEC + V_POST);
    const int QCOL = (TYPE == 0) ? AQc(h) : CQc(h), KCOL = (TYPE == 0) ? AKc(h) : CFc(h), VCOL = (TYPE == 0) ? AVc(h) : CIc(h), ZCOL = ((TYPE == 0) ? ZA : ZC) + h * 128;
    const float qscale = (TYPE == 0) ? 0.125f : 0.08838834764831845f;
    const int idx = (b * 4 + h) * NSEG + s;
    bf16* stbase = (bf16*)((unsigned char*)P->out + DO_STATE) + ((TYPE == 0) ? ST_GLA : ST_HGRN);
    float* dsbase = (float*)(P->ws + WS_MISC) + ((TYPE == 0) ? DS_GLA : DS_HGRN);
    float lb0 = 0.f, lb1 = 0.f, gb0 = 0.f, gb1 = 0.f, gw0[16], gw1[16];
#pragma unroll
    for (int rr = 0; rr < 16; ++rr) { gw0[rr] = 0.f; gw1[rr] = 0.f; }
    if (kact) {
        if (TYPE == 2) {
#pragma unroll
            for (int c2 = 0; c2 < 2; ++c2) { const int ch = h * 128 + 2 * ck + c2;
                float mx_ = -1e30f; for (int i = 0; i < DEPTH; ++i) mx_ = fmaxf(mx_, P->hg_lb[i * 512 + ch]);
                float den = 0.f, num = 0.f; for (int i = 0; i < DEPTH; ++i) { const float e = fexp(P->hg_lb[i * 512 + ch] - mx_); den += e; if (i >= 1 && i <= l) num += e; }
                if (c2 == 0) lb0 = num / den; else lb1 = num / den; }
        } else {
#pragma unroll
            for (int rr = 0; rr < 16; ++rr) { gw0[rr] = P->gla_gate_w[((size_t)l * 16 + rr) * 256 + h * 64 + 2 * ck]; gw1[rr] = P->gla_gate_w[((size_t)l * 16 + rr) * 256 + h * 64 + 2 * ck + 1]; }
            gb0 = P->gla_gate_b[l * 256 + h * 64 + 2 * ck]; gb1 = P->gla_gate_b[l * 256 + h * 64 + 2 * ck + 1];
        }
    }
    unsigned rq[8], rk[8], rv[8]; f32x4 grv = (f32x4){0.f, 0.f, 0.f, 0.f};
#define PC_LOAD(cc) do { const size_t rw_ = (size_t)b * SEQ + (size_t)s * SEGL + (size_t)(cc) * CH + 8 * g; \
        _Pragma("unroll") for (int jj = 0; jj < 8; ++jj) rv[jj] = *(const unsigned*)(proj + (rw_ + jj) * PP + VCOL + 2 * cp); \
        _Pragma("unroll") for (int jj = 0; jj < NTK; ++jj) { const bf16* pr = proj + (rw_ + NTK * th + jj) * PP; \
            rk[jj] = *(const unsigned*)(pr + KCOL + 2 * ck); rq[jj] = OUT ? *(const unsigned*)(pr + QCOL + 2 * ck) : 0u; } \
        if (TYPE == 0) { if (lane < 32) grv = *(const f32x4*)((const float*)(P->ws + WS_GATES) + (rw_ + (lane >> 2)) * 32 + G_GR + (lane & 3) * 4); } } while (0)
    PC_LOAD(0);
    f32x4 S[NDT];
#pragma unroll
    for (int dt = 0; dt < NDT; ++dt) S[dt] = (f32x4){0.f, 0.f, 0.f, 0.f};
    if (OUT) {
        wait_predecessors(flag_ptr(P, (TYPE == 0) ? FLAG_GLA : FLAG_HG, idx - s), s, (unsigned)l + 1u);
        LAS float* vds = (LAS float*)(lds + L_QT);
        for (int i = tid; i < s * DK; i += 512) vds[i] = dsbase[(size_t)(idx - s) * DK + i];
        __syncthreads();
        for (int sp0 = 0; sp0 < s; sp0 += 4) {
            u32x2v raw[4][NDT];
#pragma unroll
            for (int u = 0; u < 4; ++u) { const int sp = (sp0 + u < s) ? sp0 + u : s - 1; const bf16* sb = stbase + (size_t)(idx - s + sp) * (DK * 128);
#pragma unroll
                for (int dt = 0; dt < NDT; ++dt) raw[u][dt] = *(const u32x2v*)(sb + ((size_t)(w * NDT + dt) * 64 + lane) * 4); }
#pragma unroll
            for (int u = 0; u < 4; ++u) if (sp0 + u < s) {
#pragma unroll
                for (int dt = 0; dt < NDT; ++dt) { const f32x4 d4 = *(const LAS f32x4*)(vds + (sp0 + u) * DK + 16 * dt + 4 * qd);
                    const f32x4 ds = (f32x4){lo2f(raw[u][dt].x), hi2f(raw[u][dt].x), lo2f(raw[u][dt].y), hi2f(raw[u][dt].y)}; S[dt] = S[dt] * d4 + ds; } }
        }
        __syncthreads();
    }
    float gsum0 = 0.f, gsum1 = 0.f;
    const int ei = tid >> 3, ecc = tid & 7;
    float nw[16];
#pragma unroll
    for (int k = 0; k < 16; ++k) nw[k] = OUT ? ((TYPE == 0) ? P->gla_norm_w : P->hg_norm_w)[l * 512 + h * 128 + 16 * ecc + k] : 0.f;

    constexpr int L_OB = L_VVT;
    float lg0[8], lg1[8], kk0[8], kk1[8];
#define PC_A1() do { \
        if (TYPE == 0) { if (lane < 32) *(LAS f32x4*)((LAS float*)(lds + L_VEC + V_MISC) + g * 128 + (lane >> 2) * 16 + (lane & 3) * 4) = grv; } \
        if (kact) { \
            if (TYPE == 2) { \
                _Pragma("unroll") for (int jj = 0; jj < 8; ++jj) { const float f0 = lo2f(rk[jj]), f1 = hi2f(rk[jj]); \
                    const float s0 = fsigmoid(f0), s1 = fsigmoid(f1); \
                    lg0[jj] = flog(fmaxf(lb0 + (1.f - lb0) * s0, 1e-30f)); lg1[jj] = flog(fmaxf(lb1 + (1.f - lb1) * s1, 1e-30f)); \
                    kk0[jj] = (1.f - lb0) * (1.f - s0); kk1[jj] = (1.f - lb1) * (1.f - s1); } \
            } else { \
                LAS float* vgr = (LAS float*)(lds + L_VEC + V_MISC) + g * 128; \
                _Pragma("unroll") for (int jj = 0; jj < NTK; ++jj) { const LAS f32x4* gr4 = (const LAS f32x4*)(vgr + (NTK * th + jj) * 16); float a0 = gb0, a1 = gb1; \
                    _Pragma("unroll") for (int r4 = 0; r4 < 4; ++r4) { const f32x4 x = gr4[r4]; \
                        _Pragma("unroll") for (int e = 0; e < 4; ++e) { a0 += x[e] * gw0[4 * r4 + e]; a1 += x[e] * gw1[4 * r4 + e]; } } \
                    lg0[jj] = flogsigmoid(a0) * (1.0f / 16.0f); lg1[jj] = flogsigmoid(a1) * (1.0f / 16.0f); \
                    kk0[jj] = lo2f(rk[jj]); kk1[jj] = hi2f(rk[jj]); } \
            } \
            _Pragma("unroll") for (int jj = 1; jj < NTK; ++jj) { lg0[jj] += lg0[jj - 1]; lg1[jj] += lg1[jj - 1]; } \
            if (TYPE == 0) { const float o0 = __shfl_xor(lg0[NTK - 1], 32), o1 = __shfl_xor(lg1[NTK - 1], 32);       \
                if (th) { _Pragma("unroll") for (int jj = 0; jj < NTK; ++jj) { lg0[jj] += o0; lg1[jj] += o1; } } \
                else { vtot[g * 128 + 2 * ck] = lg0[NTK - 1] + o0; vtot[g * 128 + 2 * ck + 1] = lg1[NTK - 1] + o1; } } \
            else { vtot[g * 128 + 2 * ck] = lg0[NTK - 1]; vtot[g * 128 + 2 * ck + 1] = lg1[NTK - 1]; } \
        } } while (0)
#define PC_A2(cc) do { \
        if (kact) { \
            float base0 = 0.f, base1 = 0.f, ref0 = 0.f, ref1 = 0.f, end0 = 0.f, end1 = 0.f; \
            _Pragma("unroll") for (int gg = 0; gg < 8; ++gg) { const float t0 = vtot[gg * 128 + 2 * ck], t1 = vtot[gg * 128 + 2 * ck + 1]; \
                if (gg < g) { base0 += t0; base1 += t1; } if (gg < 4) { ref0 += t0; ref1 += t1; } end0 += t0; end1 += t1; } \
            float kt0[8], kt1[8]; \
            _Pragma("unroll") for (int jj = 0; jj < NTK; ++jj) { const float G0 = base0 + lg0[jj], G1 = base1 + lg1[jj]; \
                kt0[jj] = kk0[jj] * fexp(fminf(ref0 - G0, 80.f)); kt1[jj] = kk1[jj] * fexp(fminf(ref1 - G1, 80.f)); \
                if (OUT) { *(LAS unsigned*)(lds + L_QT + offp<PQ>(8 * g + NTK * th + jj, 4 * ck)) = cvtpk(lo2f(rq[jj]) * qscale * fexp(fminf(G0 - ref0, 80.f)), hi2f(rq[jj]) * qscale * fexp(fminf(G1 - ref1, 80.f))); \
                           *(LAS unsigned*)(lds + L_KT + offp<PQ>(8 * g + NTK * th + jj, 4 * ck)) = cvtpk(kt0[jj], kt1[jj]); } } \
            if (TYPE == 0) { u32x2v t2; \
                t2.x = cvtpk(kt0[0], kt0[1]); t2.y = cvtpk(kt0[2], kt0[3]); *(LAS u32x2v*)(lds + L_KTT + sw64(2 * ck, 16 * g + 8 * th)) = t2; \
                t2.x = cvtpk(kt1[0], kt1[1]); t2.y = cvtpk(kt1[2], kt1[3]); *(LAS u32x2v*)(lds + L_KTT + sw64(2 * ck + 1, 16 * g + 8 * th)) = t2; \
            } else { u32x4v t; \
                t.x = cvtpk(kt0[0], kt0[1]); t.y = cvtpk(kt0[2], kt0[3]); t.z = cvtpk(kt0[4], kt0[5]); t.w = cvtpk(kt0[6], kt0[7]); *(LAS u32x4v*)(lds + L_KTT + (2 * ck) * 128 + ((g ^ (ck & 7)) << 4)) = t; \
                t.x = cvtpk(kt1[0], kt1[1]); t.y = cvtpk(kt1[2], kt1[3]); t.z = cvtpk(kt1[4], kt1[5]); t.w = cvtpk(kt1[6], kt1[7]); *(LAS u32x4v*)(lds + L_KTT + (2 * ck + 1) * 128 + ((g ^ (ck & 7)) << 4)) = t; } \
            if (g == 0 && th == 0) { vpre[2 * ck] = fexp(ref0); vpre[2 * ck + 1] = fexp(ref1); vpost[2 * ck] = fexp(end0 - ref0); vpost[2 * ck + 1] = fexp(end1 - ref1); gsum0 += end0; gsum1 += end1; } \
        } \
        { u32x4v t; \
          t.x = (rv[0] & 0xffffu) | (rv[1] << 16); t.y = (rv[2] & 0xffffu) | (rv[3] << 16); t.z = (rv[4] & 0xffffu) | (rv[5] << 16); t.w = (rv[6] & 0xffffu) | (rv[7] << 16); \
          *(LAS u32x4v*)(lds + L_VT + (2 * cp) * 128 + ((g ^ (cp & 7)) << 4)) = t; \
          t.x = (rv[0] >> 16) | (rv[1] & 0xffff0000u); t.y = (rv[2] >> 16) | (rv[3] & 0xffff0000u); t.z = (rv[4] >> 16) | (rv[5] & 0xffff0000u); t.w = (rv[6] >> 16) | (rv[7] & 0xffff0000u); \
          *(LAS u32x4v*)(lds + L_VT + (2 * cp + 1) * 128 + ((g ^ (cp & 7)) << 4)) = t; } \
        if ((cc) + 1 < NCH) PC_LOAD((cc) + 1); } while (0)
    PC_A1();
    __syncthreads();
    PC_A2(0);
    __syncthreads();
    for (int c = 0; c < NCH; ++c) {
        const size_t rowc = (size_t)b * SEQ + (size_t)s * SEGL + (size_t)c * CH;
        bf16* zp = proj + (rowc + ei) * PP + ZCOL + 16 * ecc;
        u32x4v za = (u32x4v){0u, 0u, 0u, 0u}, zb = za;
        if (OUT) { za = *(const u32x4v*)zp; zb = *(const u32x4v*)(zp + 8); }
#pragma unroll
        for (int dt = 0; dt < NDT; ++dt) { const f32x4 p4 = *(const LAS f32x4*)(vpre + 16 * dt + 4 * qd); S[dt] = S[dt] * p4;
            if (OUT) *(LAS u32x2v*)(lds + L_ST + offp<PQ>(16 * w + r, (16 * dt + 4 * qd) * 2)) = pack4(S[dt]); }
        if (OUT) {
            const int it = w & 3;
#pragma unroll
            for (int j2 = 0; j2 < 2; ++j2) { const int jt = 2 * (w >> 2) + j2; f32x4 acc = (f32x4){0.f, 0.f, 0.f, 0.f};
                if (jt <= it) {
#pragma unroll
                    for (int ks = 0; ks < NKS; ++ks) acc = MFMA16(fragp<PQ>(lds + L_KT, 16 * jt + r, ks, qd), fragp<PQ>(lds + L_QT, 16 * it + r, ks, qd), acc);
                    if (jt == it) {
#pragma unroll
                        for (int rg = 0; rg < 4; ++rg) if (4 * qd + rg > r) acc[rg] = 0.f; }
                }
                *(LAS u32x2v*)(lds + L_PM + sw64(16 * it + r, (16 * jt + 4 * qd) * 2)) = pack4(acc); }
            __syncthreads();
        }
        f32x4 o[4];
        if (OUT) {
#pragma unroll
            for (int it = 0; it < 4; ++it) { o[it] = (f32x4){0.f, 0.f, 0.f, 0.f};
#pragma unroll
                for (int ks = 0; ks < 2; ++ks) if (ks == 0 || it >= 2) o[it] = MFMA16(frag64(lds + L_VT, 16 * w + r, ks, qd), frag64(lds + L_PM, 16 * it + r, ks, qd), o[it]);
#pragma unroll
                for (int ks = 0; ks < NKS; ++ks) o[it] = MFMA16(fragp<PQ>(lds + L_ST, 16 * w + r, ks, qd), fragp<PQ>(lds + L_QT, 16 * it + r, ks, qd), o[it]); }
        }
#pragma unroll
        for (int dt = 0; dt < NDT; ++dt) {
#pragma unroll
            for (int ks = 0; ks < 2; ++ks) S[dt] = MFMA16(frag64(lds + L_KTT, 16 * dt + r, ks, qd), frag64(lds + L_VT, 16 * w + r, ks, qd), S[dt]);
            const f32x4 q4 = *(const LAS f32x4*)(vpost + 16 * dt + 4 * qd); S[dt] = S[dt] * q4; }
        if (c + 1 < NCH) PC_A1();
        if (OUT) {
#pragma unroll
            for (int it = 0; it < 4; ++it) *(LAS u32x2v*)(lds + L_OB + (16 * it + r) * 272 + (16 * w + 4 * qd) * 2) = pack4(o[it]);
        }
        __syncthreads();
        if (c + 1 < NCH) PC_A2(c + 1);
        if (OUT) {
            const u32x4v oa = *(const LAS u32x4v*)(lds + L_OB + ei * 272 + ecc * 32), ob = *(const LAS u32x4v*)(lds + L_OB + ei * 272 + ecc * 32 + 16);
            float ov[16] = {lo2f(oa.x), hi2f(oa.x), lo2f(oa.y), hi2f(oa.y), lo2f(oa.z), hi2f(oa.z), lo2f(oa.w), hi2f(oa.w), lo2f(ob.x), hi2f(ob.x), lo2f(ob.y), hi2f(ob.y), lo2f(ob.z), hi2f(ob.z), lo2f(ob.w), hi2f(ob.w)};
            float ss = 0.f;
#pragma unroll
            for (int k = 0; k < 16; ++k) ss += ov[k] * ov[k];
            ss += __shfl_xor(ss, 1); ss += __shfl_xor(ss, 2); ss += __shfl_xor(ss, 4);
            const float rs = frsq(ss * (1.0f / 128.0f) + EPS);
            const float zv[16] = {lo2f(za.x), hi2f(za.x), lo2f(za.y), hi2f(za.y), lo2f(za.z), hi2f(za.z), lo2f(za.w), hi2f(za.w), lo2f(zb.x), hi2f(zb.x), lo2f(zb.y), hi2f(zb.y), lo2f(zb.z), hi2f(zb.z), lo2f(zb.w), hi2f(zb.w)};
            float y[16];
#pragma unroll
            for (int k = 0; k < 16; ++k) y[k] = ov[k] * rs * nw[k] * fsilu(zv[k]);
            u32x4v ya, yb; ya.x = cvtpk(y[0], y[1]); ya.y = cvtpk(y[2], y[3]); ya.z = cvtpk(y[4], y[5]); ya.w = cvtpk(y[6], y[7]); yb.x = cvtpk(y[8], y[9]); yb.y = cvtpk(y[10], y[11]); yb.z = cvtpk(y[12], y[13]); yb.w = cvtpk(y[14], y[15]);
            if (DRY) { asm volatile("" :: "v"(ya.x), "v"(ya.y), "v"(ya.z), "v"(ya.w), "v"(yb.x), "v"(yb.y), "v"(yb.z), "v"(yb.w)); } else { *(u32x4v*)zp = ya; *(u32x4v*)(zp + 8) = yb; }
        }
        __syncthreads();
    }
    if (!OUT) {
        bf16* sb = stbase + (size_t)idx * (DK * 128);
#pragma unroll
        for (int dt = 0; dt < NDT; ++dt) st_wt(sb + ((size_t)(w * NDT + dt) * 64 + lane) * 4, pack4(S[dt]));
        if (g == 0 && th == 0) { st_wt_f(dsbase + (size_t)idx * DK + 2 * ck, fexp(gsum0)); st_wt_f(dsbase + (size_t)idx * DK + 2 * ck + 1, fexp(gsum1)); }
        publish_item(flag_ptr(P, (TYPE == 0) ? FLAG_GLA : FLAG_HG, idx), (unsigned)l + 1u);
    }
    __syncthreads();
#undef PC_LOAD
#undef PC_A1
#undef PC_A2
}

template <int TYPE>
__device__ __forceinline__ void pc_pass1(KP P, int l, int b, int h, int s, LAS unsigned char* lds) {
    if (s == NSEG - 1) return;
    constexpr int DK = (TYPE == 0) ? 64 : 128, NDT = DK / 16;
    const int tid = opaque_tid(), lane = tid & 63, w = __builtin_amdgcn_readfirstlane(tid >> 6), r = lane & 15, qd = lane >> 4;
    const int cp = lane, g = w;
    constexpr int NTK = (TYPE == 0) ? 4 : 8;
    const int ck = (TYPE == 0) ? (lane & 31) : lane, th = (TYPE == 0) ? (lane >> 5) : 0;
    bf16* proj = (bf16*)(P->ws + WS_PROJ);
    const int KCOL = (TYPE == 0) ? AKc(h) : CFc(h), VCOL = (TYPE == 0) ? AVc(h) : CIc(h);
    const int idx = (b * 4 + h) * NSEG + s;
    bf16* stbase = (bf16*)((unsigned char*)P->out + DO_STATE) + ((TYPE == 0) ? ST_GLA : ST_HGRN);
    float* dsbase = (float*)(P->ws + WS_MISC) + ((TYPE == 0) ? DS_GLA : DS_HGRN);
    float lb0 = 0.f, lb1 = 0.f, gb0 = 0.f, gb1 = 0.f, gw0[16], gw1[16];
#pragma unroll
    for (int rr = 0; rr < 16; ++rr) { gw0[rr] = 0.f; gw1[rr] = 0.f; }
    if (TYPE == 2) {
#pragma unroll
        for (int c2 = 0; c2 < 2; ++c2) { const int ch = h * 128 + 2 * ck + c2;
            float mx_ = -1e30f; for (int i = 0; i < DEPTH; ++i) mx_ = fmaxf(mx_, P->hg_lb[i * 512 + ch]);
            float den = 0.f, num = 0.f; for (int i = 0; i < DEPTH; ++i) { const float e = fexp(P->hg_lb[i * 512 + ch] - mx_); den += e; if (i >= 1 && i <= l) num += e; }
            if (c2 == 0) lb0 = num / den; else lb1 = num / den; }
    } else {
#pragma unroll
        for (int rr = 0; rr < 16; ++rr) { gw0[rr] = P->gla_gate_w[((size_t)l * 16 + rr) * 256 + h * 64 + 2 * ck]; gw1[rr] = P->gla_gate_w[((size_t)l * 16 + rr) * 256 + h * 64 + 2 * ck + 1]; }
        gb0 = P->gla_gate_b[l * 256 + h * 64 + 2 * ck]; gb1 = P->gla_gate_b[l * 256 + h * 64 + 2 * ck + 1];
    }
    f32x4 S[NDT];
#pragma unroll
    for (int dt = 0; dt < NDT; ++dt) S[dt] = (f32x4){0.f, 0.f, 0.f, 0.f};
    float gsum0 = 0.f, gsum1 = 0.f;
#define P1_KTT(par) ((par) ? L_ST : L_KTT)
#define P1_VT(par) ((par) ? L_ST + 16384 : L_VT)
#define P1_TOT(par) ((LAS float*)(lds + ((par) ? L_QT : L_VEC + V_TOT)))
#define P1_PRE(par) ((LAS float*)(lds + ((par) ? L_QT + 4096 : L_VEC + V_PRE)))
#define P1_POST(par) ((LAS float*)(lds + ((par) ? L_QT + 4608 : L_VEC + V_POST)))
    unsigned rk[8], rv[2][8]; f32x4 grv = (f32x4){0.f, 0.f, 0.f, 0.f};
    float lg0[8], lg1[8], kk0[8], kk1[8];
#define P1_LOAD(cc, par) do { const size_t rw_ = (size_t)b * SEQ + (size_t)s * SEGL + (size_t)(cc) * CH + 8 * g; \
        _Pragma("unroll") for (int jj = 0; jj < 8; ++jj) rv[par][jj] = *(const unsigned*)(proj + (rw_ + jj) * PP + VCOL + 2 * cp); \
        _Pragma("unroll") for (int jj = 0; jj < NTK; ++jj) rk[jj] = *(const unsigned*)(proj + (rw_ + NTK * th + jj) * PP + KCOL + 2 * ck); \
        if (TYPE == 0) { if (lane < 32) grv = *(const f32x4*)((const float*)(P->ws + WS_GATES) + (rw_ + (lane >> 2)) * 32 + G_GR + (lane & 3) * 4); } } while (0)
#define P1_A1(par) do { LAS float* vtot_ = P1_TOT(par); \
        if (TYPE == 0) { if (lane < 32) *(LAS f32x4*)((LAS float*)(lds + L_VEC + V_MISC) + g * 128 + (lane >> 2) * 16 + (lane & 3) * 4) = grv; } \
        if (TYPE == 2) { \
            _Pragma("unroll") for (int jj = 0; jj < 8; ++jj) { const float f0 = lo2f(rk[jj]), f1 = hi2f(rk[jj]); \
                const float s0 = fsigmoid(f0), s1 = fsigmoid(f1); \
                lg0[jj] = flog(fmaxf(lb0 + (1.f - lb0) * s0, 1e-30f)); lg1[jj] = flog(fmaxf(lb1 + (1.f - lb1) * s1, 1e-30f)); \
                kk0[jj] = (1.f - lb0) * (1.f - s0); kk1[jj] = (1.f - lb1) * (1.f - s1); } \
        } else { \
            LAS float* vgr = (LAS float*)(lds + L_VEC + V_MISC) + g * 128; \
            _Pragma("unroll") for (int jj = 0; jj < NTK; ++jj) { const LAS f32x4* gr4 = (const LAS f32x4*)(vgr + (NTK * th + jj) * 16); float a0 = gb0, a1 = gb1; \
                _Pragma("unroll") for (int r4 = 0; r4 < 4; ++r4) { const f32x4 x = gr4[r4]; \
                    _Pragma("unroll") for (int e = 0; e < 4; ++e) { a0 += x[e] * gw0[4 * r4 + e]; a1 += x[e] * gw1[4 * r4 + e]; } } \
                lg0[jj] = flogsigmoid(a0) * (1.0f / 16.0f); lg1[jj] = flogsigmoid(a1) * (1.0f / 16.0f); \
                kk0[jj] = lo2f(rk[jj]); kk1[jj] = hi2f(rk[jj]); } \
        } \
        _Pragma("unroll") for (int jj = 1; jj < NTK; ++jj) { lg0[jj] += lg0[jj - 1]; lg1[jj] += lg1[jj - 1]; } \
        if (TYPE == 0) { const float o0 = __shfl_xor(lg0[NTK - 1], 32), o1 = __shfl_xor(lg1[NTK - 1], 32); \
            if (th) { _Pragma("unroll") for (int jj = 0; jj < NTK; ++jj) { lg0[jj] += o0; lg1[jj] += o1; } } \
            else { vtot_[g * 128 + 2 * ck] = lg0[NTK - 1] + o0; vtot_[g * 128 + 2 * ck + 1] = lg1[NTK - 1] + o1; } } \
        else { vtot_[g * 128 + 2 * ck] = lg0[NTK - 1]; vtot_[g * 128 + 2 * ck + 1] = lg1[NTK - 1]; } } while (0)
#define P1_A2(par) do { const LAS float* vtot_ = P1_TOT(par); \
        float base0 = 0.f, base1 = 0.f, ref0 = 0.f, ref1 = 0.f, end0 = 0.f, end1 = 0.f; \
        _Pragma("unroll") for (int gg = 0; gg < 8; ++gg) { const float t0 = vtot_[gg * 128 + 2 * ck], t1 = vtot_[gg * 128 + 2 * ck + 1]; \
            if (gg < g) { base0 += t0; base1 += t1; } if (gg < 4) { ref0 += t0; ref1 += t1; } end0 += t0; end1 += t1; } \
        float kt0[8], kt1[8]; \
        _Pragma("unroll") for (int jj = 0; jj < NTK; ++jj) { const float G0 = base0 + lg0[jj], G1 = base1 + lg1[jj]; \
            kt0[jj] = kk0[jj] * fexp(fminf(ref0 - G0, 80.f)); kt1[jj] = kk1[jj] * fexp(fminf(ref1 - G1, 80.f)); } \
        if (TYPE == 0) { u32x2v t2; \
            t2.x = cvtpk(kt0[0], kt0[1]); t2.y = cvtpk(kt0[2], kt0[3]); *(LAS u32x2v*)(lds + P1_KTT(par) + sw64(2 * ck, 16 * g + 8 * th)) = t2; \
            t2.x = cvtpk(kt1[0], kt1[1]); t2.y = cvtpk(kt1[2], kt1[3]); *(LAS u32x2v*)(lds + P1_KTT(par) + sw64(2 * ck + 1, 16 * g + 8 * th)) = t2; \
        } else { u32x4v t; \
            t.x = cvtpk(kt0[0], kt0[1]); t.y = cvtpk(kt0[2], kt0[3]); t.z = cvtpk(kt0[4], kt0[5]); t.w = cvtpk(kt0[6], kt0[7]); *(LAS u32x4v*)(lds + P1_KTT(par) + (2 * ck) * 128 + ((g ^ (ck & 7)) << 4)) = t; \
            t.x = cvtpk(kt1[0], kt1[1]); t.y = cvtpk(kt1[2], kt1[3]); t.z = cvtpk(kt1[4], kt1[5]); t.w = cvtpk(kt1[6], kt1[7]); *(LAS u32x4v*)(lds + P1_KTT(par) + (2 * ck + 1) * 128 + ((g ^ (ck & 7)) << 4)) = t; } \
        if (g == 0 && th == 0) { LAS float* vpre_ = P1_PRE(par); LAS float* vpost_ = P1_POST(par); \
            vpre_[2 * ck] = fexp(ref0); vpre_[2 * ck + 1] = fexp(ref1); vpost_[2 * ck] = fexp(end0 - ref0); vpost_[2 * ck + 1] = fexp(end1 - ref1); gsum0 += end0; gsum1 += end1; } \
        { u32x4v t; \
          t.x = (rv[par][0] & 0xffffu) | (rv[par][1] << 16); t.y = (rv[par][2] & 0xffffu) | (rv[par][3] << 16); t.z = (rv[par][4] & 0xffffu) | (rv[par][5] << 16); t.w = (rv[par][6] & 0xffffu) | (rv[par][7] << 16); \
          *(LAS u32x4v*)(lds + P1_VT(par) + (2 * cp) * 128 + ((g ^ (cp & 7)) << 4)) = t; \
          t.x = (rv[par][0] >> 16) | (rv[par][1] & 0xffff0000u); t.y = (rv[par][2] >> 16) | (rv[par][3] & 0xffff0000u); t.z = (rv[par][4] >> 16) | (rv[par][5] & 0xffff0000u); t.w = (rv[par][6] >> 16) | (rv[par][7] & 0xffff0000u); \
          *(LAS u32x4v*)(lds + P1_VT(par) + (2 * cp + 1) * 128 + ((g ^ (cp & 7)) << 4)) = t; } } while (0)
#define P1_E(par) do { const LAS float* vpre_ = P1_PRE(par); const LAS float* vpost_ = P1_POST(par); \
        _Pragma("unroll") for (int dt = 0; dt < NDT; ++dt) { const f32x4 p4 = *(const LAS f32x4*)(vpre_ + 16 * dt + 4 * qd); S[dt] = S[dt] * p4; } \
        _Pragma("unroll") for (int dt = 0; dt < NDT; ++dt) { \
            _Pragma("unroll") for (int ks = 0; ks < 2; ++ks) S[dt] = MFMA16(frag64(lds + P1_KTT(par), 16 * dt + r, ks, qd), frag64(lds + P1_VT(par), 16 * w + r, ks, qd), S[dt]); \
            const f32x4 q4 = *(const LAS f32x4*)(vpost_ + 16 * dt + 4 * qd); S[dt] = S[dt] * q4; } } while (0)
    P1_LOAD(0, 0);
    P1_A1(0);
    P1_LOAD(1, 1);
    __syncthreads();
    P1_A2(0);
    P1_A1(1);
    P1_LOAD(2, 0);
    __syncthreads();
    for (int c = 0; c < NCH; c += 2) {
        P1_E(0);
        P1_A2(1);
        if (c + 2 < NCH) P1_A1(0);
        if (c + 3 < NCH) P1_LOAD(c + 3, 1);
        __syncthreads();
        P1_E(1);
        if (c + 2 < NCH) P1_A2(0);
        if (c + 3 < NCH) P1_A1(1);
        if (c + 4 < NCH) P1_LOAD(c + 4, 0);
        __syncthreads();
    }
    {
        bf16* sb = stbase + (size_t)idx * (DK * 128);
#pragma unroll
        for (int dt = 0; dt < NDT; ++dt) st_wt(sb + ((size_t)(w * NDT + dt) * 64 + lane) * 4, pack4(S[dt]));
        if (g == 0 && th == 0) { st_wt_f(dsbase + (size_t)idx * DK + 2 * ck, fexp(gsum0)); st_wt_f(dsbase + (size_t)idx * DK + 2 * ck + 1, fexp(gsum1)); }
        publish_item(flag_ptr(P, (TYPE == 0) ? FLAG_GLA : FLAG_HG, idx), (unsigned)l + 1u);
    }
    __syncthreads();
#undef P1_KTT
#undef P1_VT
#undef P1_TOT
#undef P1_PRE
#undef P1_POST
#undef P1_LOAD
#undef P1_A1
#undef P1_A2
#undef P1_E
}

template <bool OUT, bool DRY = false>
__device__ __forceinline__ void ml_item(KP P, int l, int b, int h, int s, LAS unsigned char* lds) {
    if (!OUT && s == NSEG - 1) return;
    constexpr int PQ = 272;
    const int tid = opaque_tid(), lane = tid & 63, w = __builtin_amdgcn_readfirstlane(tid >> 6), r = lane & 15, qd = lane >> 4;
    const int cp = lane, g = w;
    bf16* proj = (bf16*)(P->ws + WS_PROJ); const float* gts = (const float*)(P->ws + WS_GATES);
    LAS float* vg = (LAS float*)(lds + L_VEC + V_TOT);
    LAS float* vemr = (LAS float*)(lds + L_VEC + V_MISC);
    LAS float* vden = vemr + 64;
    const int idx = (b * 4 + h) * NSEG + s;
    bf16* stbase = (bf16*)((unsigned char*)P->out + DO_STATE) + ST_ML;
    float* dsbase = (float*)(P->ws + WS_MISC) + DS_ML;
    float wq[4][2], wk[4][2], bq[2], bk[2];
#pragma unroll
    for (int c2 = 0; c2 < 2; ++c2) { const int ch = h * 128 + 2 * cp + c2;
#pragma unroll
        for (int kk = 0; kk < 4; ++kk) { wq[kk][c2] = P->ml_conv_w[((size_t)l * 4 + kk) * 1024 + ch]; wk[kk][c2] = P->ml_conv_w[((size_t)l * 4 + kk) * 1024 + 512 + ch]; }
        bq[c2] = P->ml_conv_b[l * 1024 + ch]; bk[c2] = P->ml_conv_b[l * 1024 + 512 + ch]; }
    const float ib = P->ml_i_b[l * 4 + h], fb = P->ml_f_b[l * 4 + h];
    unsigned rq[11], rk[11], rv[8]; float gpre = 0.f;
#define ML_LOAD(cc) do { const size_t rw_ = (size_t)b * SEQ + (size_t)s * SEGL + (size_t)(cc) * CH + 8 * g; const int ts_ = s * SEGL + (cc) * CH + 8 * g; \
        _Pragma("unroll") for (int jj = 0; jj < 11; ++jj) { const bool ok = (ts_ + jj - 3) >= 0; const bf16* pr = proj + (rw_ + jj - 3) * PP; \
            rk[jj] = ok ? *(const unsigned*)(pr + BKc(h) + 2 * cp) : 0u; rq[jj] = (ok && OUT) ? *(const unsigned*)(pr + BQc(h) + 2 * cp) : 0u; } \
        _Pragma("unroll") for (int jj = 0; jj < 8; ++jj) rv[jj] = *(const unsigned*)(proj + (rw_ + jj) * PP + BVc(h) + 2 * cp); \
        if (lane < 16) gpre = gts[(rw_ + (lane >> 1)) * 32 + ((lane & 1) ? G_BF : G_BI) + h]; } while (0)
    ML_LOAD(0);
    f32x4 S[8], Sx = (f32x4){0.f, 0.f, 0.f, 0.f};
#pragma unroll
    for (int dt = 0; dt < 8; ++dt) S[dt] = (f32x4){0.f, 0.f, 0.f, 0.f};
    float m = 0.f, bsum = 0.f;
    if (OUT) {
        wait_predecessors(flag_ptr(P, FLAG_ML, idx - s), s, (unsigned)l + 1u);
        LAS float* vds = (LAS float*)(lds + L_QT);
        for (int i = tid; i < s * 4; i += 512) vds[i] = dsbase[(size_t)(idx - s) * 4 + i];
        __syncthreads();
        for (int sp0 = 0; sp0 < s; sp0 += 4) {
            u32x2v raw[4][9];
#pragma unroll
            for (int u = 0; u < 4; ++u) { const int sp = (sp0 + u < s) ? sp0 + u : s - 1; const bf16* sb = stbase + (size_t)(idx - s + sp) * 18432;
#pragma unroll
                for (int dt = 0; dt < 9; ++dt) raw[u][dt] = *(const u32x2v*)(sb + ((size_t)(w * 9 + dt) * 64 + lane) * 4); }
#pragma unroll
            for (int u = 0; u < 4; ++u) if (sp0 + u < s) {
                const float ml_ = vds[(sp0 + u) * 4], bs = vds[(sp0 + u) * 4 + 1];
                const float mn = fmaxf(bs + m, ml_), f1 = fexp(bs + m - mn), f2 = fexp(ml_ - mn); m = mn;
#pragma unroll
                for (int dt = 0; dt < 9; ++dt) { const f32x4 ds = (f32x4){lo2f(raw[u][dt].x), hi2f(raw[u][dt].x), lo2f(raw[u][dt].y), hi2f(raw[u][dt].y)};
                    if (dt < 8) S[dt] = S[dt] * f1 + ds * f2; else Sx = Sx * f1 + ds * f2; } }
        }
        __syncthreads();
    }
    if (tid < 128) { const int rr = tid >> 3, ck = tid & 7; const unsigned one2 = (rr == 0) ? 0x3f803f80u : 0u; u32x4v t; t.x = one2; t.y = one2; t.z = one2; t.w = one2; *(LAS u32x4v*)(lds + L_VT + (128 + rr) * 128 + 16 * ck) = t; }
    const int ei = tid >> 3, ecc = tid & 7;
    float nw[16];
#pragma unroll
    for (int k = 0; k < 16; ++k) nw[k] = OUT ? P->ml_norm_w[l * 512 + h * 128 + 16 * ecc + k] : 0.f;

    for (int c = 0; c < NCH; ++c) {
        const size_t rowc = (size_t)b * SEQ + (size_t)s * SEGL + (size_t)c * CH;
        float ig[8], bl[8];
        const float gval = (lane & 1) ? flogsigmoid(gpre + fb) : gpre + ib;
#pragma unroll
        for (int jj = 0; jj < 8; ++jj) { ig[jj] = __int_as_float(__builtin_amdgcn_readlane(__float_as_int(gval), 2 * jj)); bl[jj] = __int_as_float(__builtin_amdgcn_readlane(__float_as_int(gval), 2 * jj + 1)); }
#pragma unroll
        for (int jj = 1; jj < 8; ++jj) bl[jj] += bl[jj - 1];
        float lpm[8];
        lpm[0] = ig[0] - bl[0];
#pragma unroll
        for (int jj = 1; jj < 8; ++jj) lpm[jj] = fmaxf(lpm[jj - 1], ig[jj] - bl[jj]);
        if (lane == 0) { vg[g] = bl[7]; vg[8 + g] = lpm[7]; }
        __syncthreads();
        float base = 0.f, cmprev = -1e30f, blast = 0.f, M = m;
#pragma unroll
        for (int gg = 0; gg < 8; ++gg) { const float t = vg[gg], lm = vg[8 + gg]; const float ag = lm - blast;
            if (gg < g) cmprev = fmaxf(cmprev, ag); M = fmaxf(M, ag); if (gg < g) base += t; blast += t; }
        float kt0[8], kt1[8];
#pragma unroll
        for (int jj = 0; jj < 8; ++jj) {
            const float bj = base + bl[jj]; const float cmj = fmaxf(cmprev, lpm[jj] - base); const float mu = fmaxf(cmj, m);
            const float ek = fexp(ig[jj] - bj - M), eq = fexp(M - mu);
            float yk0 = bk[0], yk1 = bk[1], yq0 = bq[0], yq1 = bq[1];
#pragma unroll
            for (int kk = 0; kk < 4; ++kk) { yk0 += wk[kk][0] * lo2f(rk[jj + kk]); yk1 += wk[kk][1] * hi2f(rk[jj + kk]); yq0 += wq[kk][0] * lo2f(rq[jj + kk]); yq1 += wq[kk][1] * hi2f(rq[jj + kk]); }
            kt0[jj] = fsilu(yk0) * 0.08838834764831845f * ek; kt1[jj] = fsilu(yk1) * 0.08838834764831845f * ek;
            if (OUT) { *(LAS unsigned*)(lds + L_QT + (8 * g + jj) * PQ + 4 * cp) = cvtpk(fsilu(yq0) * eq, fsilu(yq1) * eq);
                       *(LAS unsigned*)(lds + L_KT + (8 * g + jj) * PQ + 4 * cp) = cvtpk(kt0[jj], kt1[jj]);
                       if (lane == 0) vemr[8 * g + jj] = fexp(-bj - mu); } }
        { u32x4v t;
          t.x = cvtpk(kt0[0], kt0[1]); t.y = cvtpk(kt0[2], kt0[3]); t.z = cvtpk(kt0[4], kt0[5]); t.w = cvtpk(kt0[6], kt0[7]); *(LAS u32x4v*)(lds + L_KTT + (2 * cp) * 128 + ((g ^ (cp & 7)) << 4)) = t;
          t.x = cvtpk(kt1[0], kt1[1]); t.y = cvtpk(kt1[2], kt1[3]); t.z = cvtpk(kt1[4], kt1[5]); t.w = cvtpk(kt1[6], kt1[7]); *(LAS u32x4v*)(lds + L_KTT + (2 * cp + 1) * 128 + ((g ^ (cp & 7)) << 4)) = t;
          t.x = (rv[0] & 0xffffu) | (rv[1] << 16); t.y = (rv[2] & 0xffffu) | (rv[3] << 16); t.z = (rv[4] & 0xffffu) | (rv[5] << 16); t.w = (rv[6] & 0xffffu) | (rv[7] << 16);
          *(LAS u32x4v*)(lds + L_VT + (2 * cp) * 128 + ((g ^ (cp & 7)) << 4)) = t;
          t.x = (rv[0] >> 16) | (rv[1] & 0xffff0000u); t.y = (rv[2] >> 16) | (rv[3] & 0xffff0000u); t.z = (rv[4] >> 16) | (rv[5] & 0xffff0000u); t.w = (rv[6] >> 16) | (rv[7] & 0xffff0000u);
          *(LAS u32x4v*)(lds + L_VT + (2 * cp + 1) * 128 + ((g ^ (cp & 7)) << 4)) = t; }
        const float pre = fexp(m - M);
        m = blast + M; bsum += blast;
        if (c + 1 < NCH) ML_LOAD(c + 1);
        __syncthreads();
        bf16* zp = proj + (rowc + ei) * PP + ZB + h * 128 + 16 * ecc; const bf16* gp = proj + (rowc + ei) * PP + BOc(h) + 16 * ecc;
        u32x4v za = (u32x4v){0u, 0u, 0u, 0u}, zb = za, ga = za, gb_ = za;
        if (OUT) { za = *(const u32x4v*)zp; zb = *(const u32x4v*)(zp + 8); ga = *(const u32x4v*)gp; gb_ = *(const u32x4v*)(gp + 8); }
#pragma unroll
        for (int dt = 0; dt < 8; ++dt) { S[dt] = S[dt] * pre; if (OUT) *(LAS u32x2v*)(lds + L_ST + (16 * w + r) * PQ + (16 * dt + 4 * qd) * 2) = pack4(S[dt]); }
        Sx = Sx * pre; if (OUT) *(LAS u32x2v*)(lds + L_ST + (128 + r) * PQ + (16 * w + 4 * qd) * 2) = pack4(Sx);
        if (OUT) {
            const int it = w & 3;
#pragma unroll
            for (int j2 = 0; j2 < 2; ++j2) { const int jt = 2 * (w >> 2) + j2; f32x4 acc = (f32x4){0.f, 0.f, 0.f, 0.f};
                if (jt <= it) {
#pragma unroll
                    for (int ks = 0; ks < 4; ++ks) acc = MFMA16(frag(lds + L_KT, 16 * jt + r, PQ, ks, qd), frag(lds + L_QT, 16 * it + r, PQ, ks, qd), acc);
                    if (jt == it) {
#pragma unroll
                        for (int rg = 0; rg < 4; ++rg) if (4 * qd + rg > r) acc[rg] = 0.f; }
                }
                *(LAS u32x2v*)(lds + L_PM + sw64(16 * it + r, (16 * jt + 4 * qd) * 2)) = pack4(acc); }
            __syncthreads();
        }
        f32x4 o[4], ox = (f32x4){0.f, 0.f, 0.f, 0.f};
        if (OUT) {
#pragma unroll
            for (int it = 0; it < 4; ++it) { o[it] = (f32x4){0.f, 0.f, 0.f, 0.f};
#pragma unroll
                for (int ks = 0; ks < 2; ++ks) if (ks == 0 || it >= 2) o[it] = MFMA16(frag64(lds + L_VT, 16 * w + r, ks, qd), frag64(lds + L_PM, 16 * it + r, ks, qd), o[it]);
#pragma unroll
                for (int ks = 0; ks < 4; ++ks) o[it] = MFMA16(frag(lds + L_ST, 16 * w + r, PQ, ks, qd), frag(lds + L_QT, 16 * it + r, PQ, ks, qd), o[it]); }
            const int itx = w & 3;
#pragma unroll
            for (int ks = 0; ks < 2; ++ks) ox = MFMA16(frag64(lds + L_VT, 128 + r, ks, qd), frag64(lds + L_PM, 16 * itx + r, ks, qd), ox);
#pragma unroll
            for (int ks = 0; ks < 4; ++ks) ox = MFMA16(frag(lds + L_ST, 128 + r, PQ, ks, qd), frag(lds + L_QT, 16 * itx + r, PQ, ks, qd), ox);
            if (w < 4 && qd == 0) vden[16 * itx + r] = ox[0];
        }
#pragma unroll
        for (int dt = 0; dt < 8; ++dt)
#pragma unroll
            for (int ks = 0; ks < 2; ++ks) S[dt] = MFMA16(frag64(lds + L_KTT, 16 * dt + r, ks, qd), frag64(lds + L_VT, 16 * w + r, ks, qd), S[dt]);
#pragma unroll
        for (int ks = 0; ks < 2; ++ks) Sx = MFMA16(frag64(lds + L_KTT, 16 * w + r, ks, qd), frag64(lds + L_VT, 128 + r, ks, qd), Sx);
        if (OUT) {
#pragma unroll
            for (int it = 0; it < 4; ++it) *(LAS u32x2v*)(lds + L_KT + (16 * it + r) * 272 + (16 * w + 4 * qd) * 2) = pack4(o[it]);
            __syncthreads();
            const u32x4v oa = *(const LAS u32x4v*)(lds + L_KT + ei * 272 + ecc * 32), ob = *(const LAS u32x4v*)(lds + L_KT + ei * 272 + ecc * 32 + 16);
            float ov[16] = {lo2f(oa.x), hi2f(oa.x), lo2f(oa.y), hi2f(oa.y), lo2f(oa.z), hi2f(oa.z), lo2f(oa.w), hi2f(oa.w), lo2f(ob.x), hi2f(ob.x), lo2f(ob.y), hi2f(ob.y), lo2f(ob.z), hi2f(ob.z), lo2f(ob.w), hi2f(ob.w)};
            const float dinv = frcp(fmaxf(fabsf(vden[ei]), vemr[ei]));
            const float zv[16] = {lo2f(za.x), hi2f(za.x), lo2f(za.y), hi2f(za.y), lo2f(za.z), hi2f(za.z), lo2f(za.w), hi2f(za.w), lo2f(zb.x), hi2f(zb.x), lo2f(zb.y), hi2f(zb.y), lo2f(zb.z), hi2f(zb.z), lo2f(zb.w), hi2f(zb.w)};
            const float gv[16] = {lo2f(ga.x), hi2f(ga.x), lo2f(ga.y), hi2f(ga.y), lo2f(ga.z), hi2f(ga.z), lo2f(ga.w), hi2f(ga.w), lo2f(gb_.x), hi2f(gb_.x), lo2f(gb_.y), hi2f(gb_.y), lo2f(gb_.z), hi2f(gb_.z), lo2f(gb_.w), hi2f(gb_.w)};
            float ss = 0.f;
#pragma unroll
            for (int k = 0; k < 16; ++k) { ov[k] = ov[k] * dinv * fsigmoid(gv[k]); ss += ov[k] * ov[k]; }
            ss += __shfl_xor(ss, 1); ss += __shfl_xor(ss, 2); ss += __shfl_xor(ss, 4);
            const float rs = frsq(ss * (1.0f / 128.0f) + EPS);
            float y[16];
#pragma unroll
            for (int k = 0; k < 16; ++k) y[k] = ov[k] * rs * nw[k] * fsilu(zv[k]);
            u32x4v ya, yb; ya.x = cvtpk(y[0], y[1]); ya.y = cvtpk(y[2], y[3]); ya.z = cvtpk(y[4], y[5]); ya.w = cvtpk(y[6], y[7]); yb.x = cvtpk(y[8], y[9]); yb.y = cvtpk(y[10], y[11]); yb.z = cvtpk(y[12], y[13]); yb.w = cvtpk(y[14], y[15]);
            if (DRY) { asm volatile("" :: "v"(ya.x), "v"(ya.y), "v"(ya.z), "v"(ya.w), "v"(yb.x), "v"(yb.y), "v"(yb.z), "v"(yb.w)); } else { *(u32x4v*)zp = ya; *(u32x4v*)(zp + 8) = yb; }
        }
    }
    if (!OUT) {
        bf16* sb = stbase + (size_t)idx * 18432;
#pragma unroll
        for (int dt = 0; dt < 8; ++dt) st_wt(sb + ((size_t)(w * 9 + dt) * 64 + lane) * 4, pack4(S[dt]));
        st_wt(sb + ((size_t)(w * 9 + 8) * 64 + lane) * 4, pack4(Sx));
        if (tid == 0) { st_wt_f(dsbase + (size_t)idx * 4, m); st_wt_f(dsbase + (size_t)idx * 4 + 1, bsum); }
        publish_item(flag_ptr(P, FLAG_ML, idx), (unsigned)l + 1u);
    }
    __syncthreads();
#undef ML_LOAD
}

template <bool OUT, bool DRY = false>
__device__ __forceinline__ void ssd_item(KP P, int l, int b, int gq, int s, LAS unsigned char* lds) {
    constexpr int PQ = 272;
    const int tid = opaque_tid(), lane = tid & 63, w = __builtin_amdgcn_readfirstlane(tid >> 6);
    const int g = w, hsub = lane >> 5;
    bf16* proj = (bf16*)(P->ws + WS_PROJ); const float* gts = (const float*)(P->ws + WS_GATES);
    LAS float* vg = (LAS float*)(lds + L_VEC + V_TOT);
    LAS float* vaend = vg + 32;
    LAS float* vacs = (LAS float*)(lds + L_VEC + 256);
    LAS float* veacs = vacs + 256;
    LAS float* vdti = veacs + 256;
    LAS float* vcw = (LAS float*)(lds + L_VEC + 3328);
    const int idx = (b * 2 + gq) * NSEG + s;
    bf16* stbase = (bf16*)((unsigned char*)P->out + DO_STATE) + ST_SSD;
    float* dsbase = (float*)(P->ws + WS_MISC) + DS_SSD;
    { const int cp = lane; (void)cp; const int ch = tid;
      const int src = (ch < 128) ? 512 + gq * 128 + ch : (ch < 256) ? 768 + gq * 128 + (ch - 128) : gq * 256 + (ch - 256);
#pragma unroll
      for (int kk = 0; kk < 4; ++kk) vcw[ch * 5 + kk] = P->ssd_conv_w[((size_t)l * 4 + kk) * 1024 + src];
      vcw[ch * 5 + 4] = P->ssd_conv_b[l * 1024 + src]; }
    const int qd0 = lane >> 4, r0 = lane & 15; (void)qd0; (void)r0;
    float dtb[2], An[2], iAn[2];
#pragma unroll
    for (int k = 0; k < 2; ++k) { const int hh = gq * 4 + 2 * k + hsub; dtb[k] = P->ssd_dt_bias[l * 8 + hh]; An[k] = -fexp(P->ssd_A_log[l * 8 + hh]); iAn[k] = 1.0f / An[k]; }
    const float dtb_l = P->ssd_dt_bias[l * 8 + gq * 4 + (lane & 3)], An_l = -fexp(P->ssd_A_log[l * 8 + gq * 4 + (lane & 3)]);
    const int hw0 = (w >> 2), hw1 = 2 + (w >> 2);
    const float Dh[2][2] = {{P->ssd_D[l * 8 + gq * 4 + 0], P->ssd_D[l * 8 + gq * 4 + 1]}, {P->ssd_D[l * 8 + gq * 4 + 2], P->ssd_D[l * 8 + gq * 4 + 3]}};
    f32x4 S[2][8];
#pragma unroll
    for (int R = 0; R < 2; ++R)
#pragma unroll
        for (int dt = 0; dt < 8; ++dt) S[R][dt] = (f32x4){0.f, 0.f, 0.f, 0.f};
    if (OUT) {
        wait_predecessors(flag_ptr(P, FLAG_SSD, idx - s), s, (unsigned)l + 1u);
        LAS float* vds = (LAS float*)(lds + L_QT);
        for (int i = tid; i < s * 4; i += 512) vds[i] = dsbase[(size_t)(idx - s) * 4 + i];
        __syncthreads();
        for (int sp0 = 0; sp0 < s; sp0 += 2) {
            u32x2v raw[2][16];
#pragma unroll
            for (int u = 0; u < 2; ++u) { const int sp = (sp0 + u < s) ? sp0 + u : s - 1; const bf16* sb = stbase + (size_t)(idx - s + sp) * 32768;
#pragma unroll
                for (int t = 0; t < 16; ++t) raw[u][t] = *(const u32x2v*)(sb + ((size_t)(w * 16 + t) * 64 + lane) * 4); }
#pragma unroll
            for (int u = 0; u < 2; ++u) if (sp0 + u < s) {
                const float f0 = fexp(vds[(sp0 + u) * 4 + hw0]), f1 = fexp(vds[(sp0 + u) * 4 + hw1]);
#pragma unroll
                for (int R = 0; R < 2; ++R)
#pragma unroll
                    for (int dt = 0; dt < 8; ++dt) { const u32x2v rw = raw[u][R * 8 + dt];
                        const f32x4 ds = (f32x4){lo2f(rw.x), hi2f(rw.x), lo2f(rw.y), hi2f(rw.y)}; S[R][dt] = S[R][dt] * (R == 0 ? f0 : f1) + ds; } }
        }
        __syncthreads();
    }
    float asum[2] = {0.f, 0.f};

    unsigned rC[11], rB[11], rx[2][11]; float gdt = 0.f;
    const bf16* halo = (const bf16*)(P->ws + WS_HALO);
    LAS unsigned* hxch = (LAS unsigned*)(lds + L_ST);
#define SSD_LOAD(cc) do { const int cl_ = opq(lane); const size_t rw_ = (size_t)b * SEQ + (size_t)s * SEGL + (size_t)(cc) * CH + 8 * g; \
        if (OUT) { \
            _Pragma("unroll") for (int jj = 0; jj < 8; ++jj) { const bf16* pr = proj + (rw_ + jj) * PP; \
                rB[jj] = *(const unsigned*)(pr + DBc(gq) + 2 * cl_); rC[jj] = *(const unsigned*)(pr + DCc(gq) + 2 * cl_); \
                rx[0][jj] = *(const unsigned*)(pr + DXc(gq) + 2 * cl_); rx[1][jj] = *(const unsigned*)(pr + DXc(gq) + 128 + 2 * cl_); } \
        } else { \
            _Pragma("unroll") for (int jj = 0; jj < 11; ++jj) { \
                if (jj < 3 && g == 0) {       \
                    if ((cc) == 0) { const bool ok = s > 0; const bf16* hr = halo + ((size_t)((b * NSEG + s - 1) * 3 + jj)) * 1024; \
                        rB[jj] = ok ? *(const unsigned*)(hr + (DBc(gq) - DSSD) + 2 * cl_) : 0u; rC[jj] = ok ? *(const unsigned*)(hr + (DCc(gq) - DSSD) + 2 * cl_) : 0u; \
                        rx[0][jj] = ok ? *(const unsigned*)(hr + (DXc(gq) - DSSD) + 2 * cl_) : 0u; rx[1][jj] = ok ? *(const unsigned*)(hr + (DXc(gq) - DSSD) + 128 + 2 * cl_) : 0u; } \
                } else { const bf16* pr = proj + (rw_ + jj - 3) * PP; \
                    rB[jj] = *(const unsigned*)(pr + DBc(gq) + 2 * cl_); rC[jj] = *(const unsigned*)(pr + DCc(gq) + 2 * cl_); \
                    rx[0][jj] = *(const unsigned*)(pr + DXc(gq) + 2 * cl_); rx[1][jj] = *(const unsigned*)(pr + DXc(gq) + 128 + 2 * cl_); } } \
        } \
        if (cl_ < 32) gdt = gts[(rw_ + (cl_ >> 2)) * 32 + G_DT + gq * 4 + (cl_ & 3)]; } while (0)
    SSD_LOAD(0);
    for (int c = 0; c < NCH; ++c) {
        const size_t rowc = (size_t)b * SEQ + (size_t)s * SEGL + (size_t)c * CH;
        const int cp = opq(lane);
        LAS float* vsl = vacs + (cp >> 5) * 64 + 8 * g;
        const float a_l = fsoftplus(gdt + dtb_l) * An_l;
        float al[2][8];
#pragma unroll
        for (int k = 0; k < 2; ++k) {
#pragma unroll
            for (int jj = 0; jj < 8; ++jj) { const float pa = __int_as_float(__builtin_amdgcn_readlane(__float_as_int(a_l), 4 * jj + 2 * k)), pb = __int_as_float(__builtin_amdgcn_readlane(__float_as_int(a_l), 4 * jj + 2 * k + 1));
                al[k][jj] = hsub ? pb : pa; }
#pragma unroll
            for (int jj = 1; jj < 8; ++jj) al[k][jj] += al[k][jj - 1];
            if ((lane & 31) == 0) vg[(2 * k + hsub) * 8 + g] = al[k][7];
        }
        __syncthreads();
        float base[2] = {0.f, 0.f}, aend[2] = {0.f, 0.f};
#pragma unroll
        for (int k = 0; k < 2; ++k)
#pragma unroll
            for (int gg = 0; gg < 8; ++gg) { const float t = vg[(2 * k + hsub) * 8 + gg]; if (gg < g) base[k] += t; aend[k] += t; }
#define SSD_PUT_T(region, src) do { u32x4v t_; \
          t_.x = (src[0] & 0xffffu) | (src[1] << 16); t_.y = (src[2] & 0xffffu) | (src[3] << 16); t_.z = (src[4] & 0xffffu) | (src[5] << 16); t_.w = (src[6] & 0xffffu) | (src[7] << 16); \
          *(LAS u32x4v*)(lds + (region) + (2 * cp) * 128 + ((g ^ (cp & 7)) << 4)) = t_; \
          t_.x = (src[0] >> 16) | (src[1] & 0xffff0000u); t_.y = (src[2] >> 16) | (src[3] & 0xffff0000u); t_.z = (src[4] >> 16) | (src[5] & 0xffff0000u); t_.w = (src[6] >> 16) | (src[7] & 0xffff0000u); \
          *(LAS u32x4v*)(lds + (region) + (2 * cp + 1) * 128 + ((g ^ (cp & 7)) << 4)) = t_; } while (0)
        unsigned x1a[8], x1s[8];
        unsigned Bp[8], Cp[8], x0p[8];
        if (OUT) {
#pragma unroll
            for (int jj = 0; jj < 8; ++jj) { *(LAS unsigned*)(lds + L_KT + (8 * g + jj) * PQ + 4 * cp) = rB[jj]; *(LAS unsigned*)(lds + L_QT + (8 * g + jj) * PQ + 4 * cp) = rC[jj]; }
            SSD_PUT_T(L_KTT, rB);
            { unsigned x0s[8];
#pragma unroll
              for (int jj = 0; jj < 8; ++jj) { const float a0 = base[0] + al[0][jj]; const float dtj = (al[0][jj] - (jj ? al[0][jj - 1] : 0.f)) * iAn[0], e0 = fexp(aend[0] - a0);
                  x0s[jj] = cvtpk(lo2f(rx[0][jj]) * e0, hi2f(rx[0][jj]) * e0);
                  if ((cp & 31) == 0) { vsl[jj] = a0; vsl[256 + jj] = fexp(a0); vsl[512 + jj] = frcp(dtj); } }
              SSD_PUT_T(L_VVT, x0s); SSD_PUT_T(L_VT, rx[0]); }
#pragma unroll
            for (int jj = 0; jj < 8; ++jj) { const float a1 = base[1] + al[1][jj]; const float dtj = (al[1][jj] - (jj ? al[1][jj - 1] : 0.f)) * iAn[1];
                x1a[jj] = rx[1][jj];
                if ((cp & 31) == 0) { vsl[128 + jj] = a1; vsl[128 + 256 + jj] = fexp(a1); vsl[128 + 512 + jj] = frcp(dtj); } }
        } else {
            LAS unsigned* hw_ = hxch + (c & 1) * 768; LAS unsigned* hr_ = hxch + ((c + 1) & 1) * 768;
            if (g == 7) {
#pragma unroll
                for (int jj = 0; jj < 3; ++jj) { hw_[(0 * 3 + jj) * 64 + cp] = rB[8 + jj]; hw_[(1 * 3 + jj) * 64 + cp] = rC[8 + jj]; hw_[(2 * 3 + jj) * 64 + cp] = rx[0][8 + jj]; hw_[(3 * 3 + jj) * 64 + cp] = rx[1][8 + jj]; } }
            if (g == 0 && c > 0) {
#pragma unroll
                for (int jj = 0; jj < 3; ++jj) { rB[jj] = hr_[(0 * 3 + jj) * 64 + cp]; rC[jj] = hr_[(1 * 3 + jj) * 64 + cp]; rx[0][jj] = hr_[(2 * 3 + jj) * 64 + cp]; rx[1][jj] = hr_[(3 * 3 + jj) * 64 + cp]; } }
#define SSD_TAPS(chan) float w0_[5], w1_[5]; _Pragma("unroll") for (int kk = 0; kk < 5; ++kk) { w0_[kk] = vcw[(chan) * 5 + kk]; w1_[kk] = vcw[((chan) + 1) * 5 + kk]; }
#define SSD_CONV(raw, jj, y0, y1) float y0 = w0_[4], y1 = w1_[4]; _Pragma("unroll") for (int kk = 0; kk < 4; ++kk) { y0 += w0_[kk] * lo2f(raw[jj + kk]); y1 += w1_[kk] * hi2f(raw[jj + kk]); }
            { SSD_TAPS(2 * cp)
#pragma unroll
              for (int jj = 0; jj < 8; ++jj) { SSD_CONV(rB, jj, y0, y1) Bp[jj] = cvtpk(fsilu(y0), fsilu(y1)); }
              SSD_PUT_T(L_KTT, Bp); }
            { SSD_TAPS(128 + 2 * cp)
#pragma unroll
              for (int jj = 0; jj < 8; ++jj) { SSD_CONV(rC, jj, y0, y1) Cp[jj] = cvtpk(fsilu(y0), fsilu(y1)); } }
            { SSD_TAPS(256 + 2 * cp)
              unsigned x0s[8];
#pragma unroll
              for (int jj = 0; jj < 8; ++jj) { SSD_CONV(rx[0], jj, y0, y1) const float a0 = base[0] + al[0][jj]; const float dtj = (al[0][jj] - (jj ? al[0][jj - 1] : 0.f)) * iAn[0], e0 = fexp(aend[0] - a0);
                  x0p[jj] = cvtpk(fsilu(y0) * dtj, fsilu(y1) * dtj); x0s[jj] = cvtpk(lo2f(x0p[jj]) * e0, hi2f(x0p[jj]) * e0); }
              SSD_PUT_T(L_VVT, x0s); }
            { SSD_TAPS(256 + 128 + 2 * cp)
#pragma unroll
              for (int jj = 0; jj < 8; ++jj) { SSD_CONV(rx[1], jj, y0, y1) const float a1 = base[1] + al[1][jj]; const float dtj = (al[1][jj] - (jj ? al[1][jj - 1] : 0.f)) * iAn[1], e1 = fexp(aend[1] - a1);
                  x1a[jj] = cvtpk(fsilu(y0) * dtj, fsilu(y1) * dtj); x1s[jj] = cvtpk(lo2f(x1a[jj]) * e1, hi2f(x1a[jj]) * e1); } }
#undef SSD_TAPS
#undef SSD_CONV
        }
        if (g == 0 && (lane & 31) == 0) { vaend[hsub] = fexp(aend[0]); vaend[2 + hsub] = fexp(aend[1]); }
        asum[0] += aend[0]; asum[1] += aend[1];
        if (!OUT) SSD_PUT_T(L_VT, x1s);
        if (c + 1 < NCH) SSD_LOAD(c + 1);
        __syncthreads();
        const int lc = opq(lane), r = lc & 15, qd = lc >> 4;
        if (!OUT) {
#pragma unroll
            for (int jj = 0; jj < 8; ++jj) { bf16* pr = proj + (rowc + 8 * g + jj) * PP;
                *(unsigned*)(pr + DBc(gq) + 2 * cp) = Bp[jj]; *(unsigned*)(pr + DCc(gq) + 2 * cp) = Cp[jj];
                *(unsigned*)(pr + DXc(gq) + 2 * cp) = x0p[jj]; *(unsigned*)(pr + DXc(gq) + 128 + 2 * cp) = x1a[jj]; }
            const float fe0 = vaend[hw0], fe1 = vaend[hw1];
#pragma unroll
            for (int dt = 0; dt < 8; ++dt) { S[0][dt] = S[0][dt] * fe0; S[1][dt] = S[1][dt] * fe1;
#pragma unroll
                for (int ks = 0; ks < 2; ++ks) { const bf16x8 a = frag64(lds + L_KTT, 16 * dt + r, ks, qd);
                    S[0][dt] = MFMA16(a, frag64(lds + L_VVT, 16 * w + r, ks, qd), S[0][dt]); S[1][dt] = MFMA16(a, frag64(lds + L_VT, 16 * w + r, ks, qd), S[1][dt]); } }
        } else {
            const int it = w & 3;
            f32x4 cb[2];
#pragma unroll
            for (int j2 = 0; j2 < 2; ++j2) { const int jt = 2 * (w >> 2) + j2; cb[j2] = (f32x4){0.f, 0.f, 0.f, 0.f};
                if (jt <= it) {
#pragma unroll
                    for (int ks = 0; ks < 4; ++ks) cb[j2] = MFMA16(frag(lds + L_KT, 16 * jt + r, PQ, ks, qd), frag(lds + L_QT, 16 * it + r, PQ, ks, qd), cb[j2]); } }
            unsigned uA[8]; float ssq = 0.f;
#pragma unroll
            for (int R = 0; R < 2; ++R) {
#pragma unroll
                for (int hs = 0; hs < 2; ++hs) { const int hd = 2 * R + hs; const float ai = vacs[hd * 64 + 16 * it + r]; const float dgi = Dh[R][hs] * vdti[hd * 64 + 16 * it + r];
#pragma unroll
                    for (int j2 = 0; j2 < 2; ++j2) { const int jt = 2 * (w >> 2) + j2; f32x4 pv = (f32x4){0.f, 0.f, 0.f, 0.f};
                        if (jt <= it) { const f32x4 aj = *(const LAS f32x4*)(vacs + hd * 64 + 16 * jt + 4 * qd);
#pragma unroll
                            for (int rg = 0; rg < 4; ++rg) { float v = cb[j2][rg] * fexp(fminf(ai - aj[rg], 0.f));
                                if (jt == it) { if (4 * qd + rg > r) v = 0.f; else if (4 * qd + rg == r) v += dgi; }
                                pv[rg] = v; } }
                        *(LAS u32x2v*)(lds + L_PM + hs * 9216 + sw64(16 * it + r, (16 * jt + 4 * qd) * 2)) = pack4(pv); } }
#pragma unroll
                for (int dt = 0; dt < 8; ++dt) *(LAS u32x2v*)(lds + L_ST + (16 * w + r) * PQ + (16 * dt + 4 * qd) * 2) = pack4(S[R][dt]);
                if (R == 1) {
#pragma unroll
                    for (int jj = 0; jj < 8; ++jj) { const float e1 = fexp(aend[1] - vsl[128 + jj]); x1s[jj] = cvtpk(lo2f(x1a[jj]) * e1, hi2f(x1a[jj]) * e1); }
                    SSD_PUT_T(L_VVT, x1s); SSD_PUT_T(L_VT, x1a); }
                __syncthreads();
                const int le_ = opq(lane), r = le_ & 15, qd = le_ >> 4;
                const int hd = 2 * R + (w >> 2);
                const int te = opq(tid), ei = te >> 3, ecc = te & 7;
                bf16* zp = proj + (rowc + ei) * PP + ZD + gq * 256 + R * 128 + 16 * ecc;
                const u32x4v za = *(const u32x4v*)zp, zb = *(const u32x4v*)(zp + 8);
                f32x4 o[4];
#pragma unroll
                for (int it2 = 0; it2 < 4; ++it2) { f32x4 o1 = (f32x4){0.f, 0.f, 0.f, 0.f}, o2 = (f32x4){0.f, 0.f, 0.f, 0.f};
#pragma unroll
                    for (int ks = 0; ks < 2; ++ks) if (ks == 0 || it2 >= 2) o1 = MFMA16(frag64(lds + L_VT, 16 * w + r, ks, qd), frag64(lds + L_PM + (w >> 2) * 9216, 16 * it2 + r, ks, qd), o1);
#pragma unroll
                    for (int ks = 0; ks < 4; ++ks) o2 = MFMA16(frag(lds + L_ST, 16 * w + r, PQ, ks, qd), frag(lds + L_QT, 16 * it2 + r, PQ, ks, qd), o2);
                    const float ea = veacs[hd * 64 + 16 * it2 + r]; o[it2] = o1 + o2 * ea; }
                const float fe = vaend[hd];
#pragma unroll
                for (int dt = 0; dt < 8; ++dt) { S[R][dt] = S[R][dt] * fe;
#pragma unroll
                    for (int ks = 0; ks < 2; ++ks) S[R][dt] = MFMA16(frag64(lds + L_KTT, 16 * dt + r, ks, qd), frag64(lds + L_VVT, 16 * w + r, ks, qd), S[R][dt]); }
#pragma unroll
                for (int it2 = 0; it2 < 4; ++it2) *(LAS u32x2v*)(lds + L_KT + (16 * it2 + r) * 272 + (16 * w + 4 * qd) * 2) = pack4(o[it2]);
                __syncthreads();
                const u32x4v oa = *(const LAS u32x4v*)(lds + L_KT + ei * 272 + ecc * 32), ob = *(const LAS u32x4v*)(lds + L_KT + ei * 272 + ecc * 32 + 16);
                const float ov[16] = {lo2f(oa.x), hi2f(oa.x), lo2f(oa.y), hi2f(oa.y), lo2f(oa.z), hi2f(oa.z), lo2f(oa.w), hi2f(oa.w), lo2f(ob.x), hi2f(ob.x), lo2f(ob.y), hi2f(ob.y), lo2f(ob.z), hi2f(ob.z), lo2f(ob.w), hi2f(ob.w)};
                const float zv[16] = {lo2f(za.x), hi2f(za.x), lo2f(za.y), hi2f(za.y), lo2f(za.z), hi2f(za.z), lo2f(za.w), hi2f(za.w), lo2f(zb.x), hi2f(zb.x), lo2f(zb.y), hi2f(zb.y), lo2f(zb.z), hi2f(zb.z), lo2f(zb.w), hi2f(zb.w)};
                if (R == 0) {
#pragma unroll
                    for (int k = 0; k < 8; ++k) { const float u0 = ov[2 * k] * fsilu(zv[2 * k]), u1 = ov[2 * k + 1] * fsilu(zv[2 * k + 1]); uA[k] = cvtpk(u0, u1); ssq += lo2f(uA[k]) * lo2f(uA[k]) + hi2f(uA[k]) * hi2f(uA[k]); }
                } else {
                    float uB[16];
#pragma unroll
                    for (int k = 0; k < 16; ++k) { uB[k] = ov[k] * fsilu(zv[k]); ssq += uB[k] * uB[k]; }
                    ssq += __shfl_xor(ssq, 1); ssq += __shfl_xor(ssq, 2); ssq += __shfl_xor(ssq, 4);
                    const float rs = frsq(ssq * (1.0f / 256.0f) + EPS);
                    const float* nwp = P->ssd_norm_w + l * 512 + gq * 256 + 16 * ecc;
                    u32x4v ya, yb;
                    ya.x = cvtpk(lo2f(uA[0]) * rs * nwp[0], hi2f(uA[0]) * rs * nwp[1]); ya.y = cvtpk(lo2f(uA[1]) * rs * nwp[2], hi2f(uA[1]) * rs * nwp[3]); ya.z = cvtpk(lo2f(uA[2]) * rs * nwp[4], hi2f(uA[2]) * rs * nwp[5]); ya.w = cvtpk(lo2f(uA[3]) * rs * nwp[6], hi2f(uA[3]) * rs * nwp[7]);
                    yb.x = cvtpk(lo2f(uA[4]) * rs * nwp[8], hi2f(uA[4]) * rs * nwp[9]); yb.y = cvtpk(lo2f(uA[5]) * rs * nwp[10], hi2f(uA[5]) * rs * nwp[11]); yb.z = cvtpk(lo2f(uA[6]) * rs * nwp[12], hi2f(uA[6]) * rs * nwp[13]); yb.w = cvtpk(lo2f(uA[7]) * rs * nwp[14], hi2f(uA[7]) * rs * nwp[15]);
                    if (DRY) { asm volatile("" :: "v"(ya.x), "v"(ya.y), "v"(ya.z), "v"(ya.w), "v"(yb.x), "v"(yb.y), "v"(yb.z), "v"(yb.w)); } else { *(u32x4v*)(zp - 128) = ya; *(u32x4v*)(zp - 128 + 8) = yb; }
                    nwp += 128;
                    ya.x = cvtpk(uB[0] * rs * nwp[0], uB[1] * rs * nwp[1]); ya.y = cvtpk(uB[2] * rs * nwp[2], uB[3] * rs * nwp[3]); ya.z = cvtpk(uB[4] * rs * nwp[4], uB[5] * rs * nwp[5]); ya.w = cvtpk(uB[6] * rs * nwp[6], uB[7] * rs * nwp[7]);
                    yb.x = cvtpk(uB[8] * rs * nwp[8], uB[9] * rs * nwp[9]); yb.y = cvtpk(uB[10] * rs * nwp[10], uB[11] * rs * nwp[11]); yb.z = cvtpk(uB[12] * rs * nwp[12], uB[13] * rs * nwp[13]); yb.w = cvtpk(uB[14] * rs * nwp[14], uB[15] * rs * nwp[15]);
                    if (DRY) { asm volatile("" :: "v"(ya.x), "v"(ya.y), "v"(ya.z), "v"(ya.w), "v"(yb.x), "v"(yb.y), "v"(yb.z), "v"(yb.w)); } else { *(u32x4v*)zp = ya; *(u32x4v*)(zp + 8) = yb; }
                }
            }
        }
    }
    if (!OUT) {
        bf16* sb = stbase + (size_t)idx * 32768;
#pragma unroll
        for (int R = 0; R < 2; ++R)
#pragma unroll
            for (int dt = 0; dt < 8; ++dt) st_wt(sb + ((size_t)(w * 16 + R * 8 + dt) * 64 + lane) * 4, pack4(S[R][dt]));
        if (g == 0 && (lane & 31) == 0) { st_wt_f(dsbase + (size_t)idx * 4 + hsub, asum[0]); st_wt_f(dsbase + (size_t)idx * 4 + 2 + hsub, asum[1]); }
        publish_item(flag_ptr(P, FLAG_SSD, idx), (unsigned)l + 1u);
    }
    __syncthreads();
#undef SSD_PUT_T
#undef SSD_LOAD
}
}
#define GAS __attribute__((address_space(1)))
typedef GAS unsigned gu32;
#define XB_TMO      128
#define XB_XCNT(j)  (256  + 64 * (j))
#define XB_XSUB(j)  (1280 + 64 * (j))
#define XB_XGEN(j)  (2304 + 64 * (j))
#define XB_TOP      3328
#define XB_TOPGEN   3392
#define XCD_BAR_WORDS 3456
#define XB_SPIN_CAP (1u << 18)

__device__ __forceinline__ unsigned xb_ld(unsigned* p)              { return __hip_atomic_load(p, __ATOMIC_RELAXED, __HIP_MEMORY_SCOPE_AGENT); }
__device__ __forceinline__ unsigned xb_add(unsigned* p, unsigned v) { return __hip_atomic_fetch_add(p, v, __ATOMIC_RELAXED, __HIP_MEMORY_SCOPE_AGENT); }
__device__ __forceinline__ unsigned xb_xcc_id() { return (unsigned)__builtin_amdgcn_s_getreg((3 << 11) | 20) & 0xFu; }
#define XB_SPIN(cond, bar) do { unsigned _sp = 0; while (cond) { __builtin_amdgcn_s_sleep(1); \
    if ((++_sp & 255u) == 0u) { if (xb_ld(&(bar)[XB_TMO])) break; if (_sp > XB_SPIN_CAP) { atomicAdd(&(bar)[XB_TMO], 1u); break; } } } } while (0)

struct XcdBarrier {
    unsigned* bar; unsigned x;
    volatile LAS unsigned* st;
};

__device__ __forceinline__ XcdBarrier xcd_barrier_post(unsigned* bar, volatile LAS unsigned* st) {
    XcdBarrier b; b.bar = bar; b.x = xb_xcc_id(); b.st = st;
    if (threadIdx.x == 0) (void)xb_add(&bar[XB_XCNT(b.x)], 1u);
    return b;
}
__device__ __forceinline__ void xcd_barrier_complete(unsigned* bar, unsigned x, unsigned& nloc, unsigned& nx) {
    const unsigned G = gridDim.x * gridDim.y * gridDim.z;
    unsigned sum, cnt, mine, sp = 0u;
    for (;;) {
        sum = 0u; cnt = 0u; mine = 0u;
#pragma unroll
        for (unsigned j = 0; j < 16; ++j) { const unsigned c = xb_ld(&bar[XB_XCNT(j)]); sum += c; cnt += (c > 0u) ? 1u : 0u; mine = (j == x) ? c : mine; }
        if (sum == G) break;
        __builtin_amdgcn_s_sleep(1);
        if ((++sp & 255u) == 0u) { if (xb_ld(&bar[XB_TMO])) break; if (sp > XB_SPIN_CAP) { atomicAdd(&bar[XB_TMO], 1u); break; } }
    }
    nloc = mine > 0u ? mine : 1u; nx = cnt > 0u ? cnt : 1u;
}

__device__ __forceinline__ void xcd_barrier(const XcdBarrier& b) {
    asm volatile("s_waitcnt vmcnt(0)" ::: "memory");
    __syncthreads();
    if (threadIdx.x == 0) {
        unsigned* bar = b.bar;
        __builtin_amdgcn_s_waitcnt(0);
        unsigned nloc = b.st[0], nx = b.st[1];
        if (nloc == 0u) { xcd_barrier_complete(bar, b.x, nloc, nx); b.st[0] = nloc; b.st[1] = nx; }
        const unsigned old = xb_add(&bar[XB_XSUB(b.x)], 1u);
        const unsigned gen = old / nloc;
        if (old + 1u == (gen + 1u) * nloc) {
            __builtin_amdgcn_fence(__ATOMIC_RELEASE, "agent");
            asm volatile("s_waitcnt vmcnt(0)" ::: "memory");
            const unsigned og = xb_add(&bar[XB_TOP], 1u);
            const unsigned tg = og / nx;
            if (og + 1u == (tg + 1u) * nx) xb_add(&bar[XB_TOPGEN], 1u);
            else XB_SPIN(xb_ld(&bar[XB_TOPGEN]) == tg, bar);
            __builtin_amdgcn_fence(__ATOMIC_ACQUIRE, "agent");
            xb_add(&bar[XB_XGEN(b.x)], 1u);
            asm volatile("s_waitcnt vmcnt(0)" ::: "memory");
        } else {
            XB_SPIN(xb_ld(&bar[XB_XGEN(b.x)]) == gen, bar);
            __builtin_amdgcn_fence(__ATOMIC_ACQUIRE, "agent");
            asm volatile("s_waitcnt vmcnt(0)" ::: "memory");
        }
    }
    __syncthreads();
}
constexpr int LDS_BYTES = 163840;
constexpr int LDS_BARST = 163832;
constexpr int CTL_BYTES = 65536;
template <bool OUT>
__device__ __forceinline__ void engine_items(KP P, int l, int bid, int nblk, LAS unsigned char* lds) {
    if (nblk == 256) {
        const int x = bid & 7;
        if (bid < 64) { const int j = bid >> 3, bg = x >> 1, s = (x & 1) * 8 + j; mx::ssd_item<OUT>(P, l, bg >> 1, bg & 1, s, lds); }
        else if (bid < 192) { const int s = (bid - 64) >> 3, bh = x;
            mx::ml_item<OUT>(P, l, bh >> 2, bh & 3, s, lds); if (OUT) mx::pc_item<0, true>(P, l, bh >> 2, bh & 3, 15 - s, lds); else mx::pc_pass1<0>(P, l, bh >> 2, bh & 3, 15 - s, lds); }
        else { const int sh = (bid - 192) >> 3, bh = x;
            if (OUT) { mx::pc_item<2, true>(P, l, bh >> 2, bh & 3, sh, lds); mx::pc_item<2, true>(P, l, bh >> 2, bh & 3, 15 - sh, lds); }
            else { mx::pc_pass1<2>(P, l, bh >> 2, bh & 3, sh, lds); mx::pc_pass1<2>(P, l, bh >> 2, bh & 3, 15 - sh, lds); } }
    } else {
        for (int ii = bid; ii < 448; ii += nblk) {
            if (ii < 64) { const int s = ii & 15, bg = ii >> 4; mx::ssd_item<OUT>(P, l, bg >> 1, bg & 1, s, lds); }
            else if (ii < 192) { const int i2 = ii - 64, s = i2 & 15, bh = i2 >> 4; mx::ml_item<OUT>(P, l, bh >> 2, bh & 3, s, lds); }
            else if (ii < 320) { const int i2 = ii - 192, s = i2 & 15, bh = i2 >> 4; mx::pc_item<2, OUT>(P, l, bh >> 2, bh & 3, s, lds); }
            else { const int i2 = ii - 320, s = i2 & 15, bh = i2 >> 4; mx::pc_item<0, OUT>(P, l, bh >> 2, bh & 3, s, lds); }
        }
    }
}
__global__ void __launch_bounds__(512, 2) fwd_mega(Params Pval) {
    extern __shared__ __attribute__((aligned(16))) unsigned char lds_raw[]; LAS unsigned char* lds = (LAS unsigned char*)lds_raw;
    (void)Pval; KP P = (KP)__builtin_amdgcn_kernarg_segment_ptr();
#define LAUNDER() asm volatile("" : "+s"(P))
    const int bid = blockIdx.x, nblk = gridDim.x;
    if (threadIdx.x < 2) ((LAS unsigned*)(lds + LDS_BARST))[threadIdx.x] = 0u;
    __syncthreads();
    LAUNDER();
    XcdBarrier bar = xcd_barrier_post((unsigned*)(P->ws + WS_CTL) + 1024, (volatile LAS unsigned*)(lds + LDS_BARST));
    LAUNDER(); phase_prologue(P, bid, nblk, lds);
    xcd_barrier(bar);
#define LAYER_BODY(l) do { \
        LAUNDER(); phase_gemm_in(P, l, bid, nblk, lds); \
        xcd_barrier(bar); \
        LAUNDER(); engine_items<false>(P, l, bid, nblk, lds); \
        LAUNDER(); engine_items<true>(P, l, bid, nblk, lds); \
        LAUNDER(); convert_weights_queue(P, l, lds); \
        xcd_barrier(bar); \
        LAUNDER(); phase_gemm_out(P, l, bid, nblk, lds); \
        xcd_barrier(bar); } while (0)
    LAYER_BODY(0);
    LAYER_BODY(1);
    static_assert(DEPTH == 2, "layer bodies are written out");
    LAUNDER(); phase_final(P, bid, nblk);
}

extern "C" void kernel_launch(void* const* d_in, const int* in_sizes, int n_in, void* d_out, int out_size, void* d_ws, size_t ws_size, hipStream_t stream) {
    static int grid_blocks = 0;
    if (!grid_blocks) {
        if (n_in != 21 || out_size != NTOK * DM || ws_size < WS_END) { fprintf(stderr, "kernel_launch: unexpected shapes (n_in %d out %d ws %zu)\n", n_in, out_size, ws_size); grid_blocks = -1; return; }
        if (hipFuncSetAttribute((const void*)fwd_mega, hipFuncAttributeMaxDynamicSharedMemorySize, LDS_BYTES) != hipSuccess) { fprintf(stderr, "hipFuncSetAttribute failed\n"); grid_blocks = -1; return; }
        int dev = 0, cus = 0, per_cu = 0;
        (void)hipGetDevice(&dev); (void)hipDeviceGetAttribute(&cus, hipDeviceAttributeMultiprocessorCount, dev);
        (void)hipOccupancyMaxActiveBlocksPerMultiprocessor(&per_cu, (const void*)fwd_mega, 512, LDS_BYTES);
        if (per_cu < 1) { fprintf(stderr, "kernel_launch: occupancy query says %d blocks per CU\n", per_cu); grid_blocks = -1; return; }
        grid_blocks = cus;
    }
    if (grid_blocks < 0) return;
    (void)hipMemsetAsync((unsigned char*)d_ws + WS_CTL, 0, CTL_BYTES, stream);
    Params P{};
    const float** pp = (const float**)&P;
    for (int i = 0; i < 21; ++i) pp[i] = (const float*)d_in[i];
    P.out = (float*)d_out; P.ws = (unsigned char*)d_ws;
    void* args[] = {&P};
    hipError_t e = hipLaunchCooperativeKernel((const void*)fwd_mega, dim3(grid_blocks), dim3(512), args, LDS_BYTES, stream);
    if (e != hipSuccess) fprintf(stderr, "cooperative launch failed: %s (grid %d)\n", hipGetErrorString(e), grid_blocks);
}
```

```cpp
#include <hip/hip_runtime.h>
#include <hip/hip_cooperative_groups.h>
#include <cstdio>
#include <cstdint>
namespace cg = cooperative_groups;

constexpr int NTOK = 16384, SEQ = 8192, DM = 1024, DEPTH = 2, DPROJ = 7712, DINNER = 2048;
constexpr int PP = 7680;
constexpr int NPAD = 7936;
constexpr float EPS = 1e-6f;
constexpr int ZA = 0, ZB = 512, ZC = 1024, ZD = 1536;
__host__ __device__ constexpr int AQc(int h) { return 2048 + h * 256; }
__host__ __device__ constexpr int AKc(int h) { return 2048 + h * 256 + 64; }
__host__ __device__ constexpr int AVc(int h) { return 2048 + h * 256 + 128; }
__host__ __device__ constexpr int BQc(int h) { return 3072 + h * 512; }
__host__ __device__ constexpr int BKc(int h) { return 3072 + h * 512 + 128; }
__host__ __device__ constexpr int BVc(int h) { return 3072 + h * 512 + 256; }
__host__ __device__ constexpr int BOc(int h) { return 3072 + h * 512 + 384; }
__host__ __device__ constexpr int CQc(int h) { return 5120 + h * 384; }
__host__ __device__ constexpr int CFc(int h) { return 5120 + h * 384 + 128; }
__host__ __device__ constexpr int CIc(int h) { return 5120 + h * 384 + 256; }
constexpr int DSSD = 6656;
__host__ __device__ constexpr int DXc(int g) { return DSSD + g * 512; }
__host__ __device__ constexpr int DBc(int g) { return DSSD + g * 512 + 256; }
__host__ __device__ constexpr int DCc(int g) { return DSSD + g * 512 + 384; }
constexpr int G_GR = 0, G_BI = 16, G_BF = 20, G_DT = 24;

__host__ __device__ __forceinline__ int win_src_col(int n) {
    if (n < 2048) { const int g = n >> 9, r = n & 511; const int base = (g == 0) ? 1040 : (g == 1) ? 3608 : (g == 2) ? 5656 : 7200; return base + r; }
    if (n < 3072) { const int j = n - 2048, h = j >> 8, r = j & 255; return (r < 64) ? h * 64 + r : (r < 128) ? 256 + h * 64 + (r - 64) : 512 + h * 128 + (r - 128); }
    if (n < 5120) { const int j = n - 3072, h = j >> 9, r = j & 511, part = r >> 7, c = r & 127; return ((part == 0) ? 1552 : (part == 1) ? 2064 : (part == 2) ? 2576 : 3096) + h * 128 + c; }
    if (n < 6656) { const int j = n - 5120, h = j / 384, r = j % 384, part = r >> 7, c = r & 127; return ((part == 0) ? 4120 : (part == 1) ? 4632 : 5144) + h * 128 + c; }
    if (n < 7680) { const int j = n - 6656, g = j >> 9, r = j & 511; return (r < 256) ? 6168 + g * 256 + r : (r < 384) ? 6680 + g * 128 + (r - 256) : 6936 + g * 128 + (r - 384); }
    const int j = n - 7680;
    if (j < 16) return 1024 + j;
    if (j < 20) return 3088 + (j - 16);
    if (j < 24) return 3092 + (j - 20);
    if (j < 32) return 7192 + (j - 24);
    return -1;
}

constexpr size_t MiB = 1u << 20;
constexpr size_t WS_CTL = 0;
constexpr size_t WS_PROJ = 1 * MiB;
constexpr size_t WS_GATES = 241 * MiB;
constexpr size_t WS_WOUT = 243 * MiB;
constexpr size_t WS_SSQ = 251 * MiB;
constexpr size_t WS_RSTD0 = 252 * MiB;
constexpr size_t WS_MISC = 252 * MiB + 65536;
constexpr size_t WS_HALO = 253 * MiB;
constexpr size_t WS_END = 256 * MiB;
constexpr size_t DO_HB = 0;
constexpr size_t DO_WIN = 32 * MiB;
constexpr size_t DO_WIN_STRIDE = 15 * MiB + MiB / 2;
constexpr size_t DO_STATE = 32 * MiB;

typedef unsigned short bf16;
typedef float f32x4v __attribute__((ext_vector_type(4)));
typedef unsigned u32x4v __attribute__((ext_vector_type(4)));
typedef unsigned u32x2v __attribute__((ext_vector_type(2)));
#define LAS __attribute__((address_space(3)))

__device__ __forceinline__ float bf2f(unsigned short u) { return __uint_as_float(((unsigned)u) << 16); }
__device__ __forceinline__ unsigned f2bf(float f) { unsigned u = __float_as_uint(f); return (u + 0x7fffu + ((u >> 16) & 1u)) >> 16; }
__device__ __forceinline__ unsigned pk2(float lo, float hi) { return f2bf(lo) | (f2bf(hi) << 16); }
__device__ __forceinline__ float sigmoidf_(float x) { return 1.f / (1.f + __expf(-x)); }
__device__ __forceinline__ float siluf_(float x) { return x / (1.f + __expf(-x)); }
__device__ __forceinline__ float softplusf_(float x) { return fmaxf(x, 0.f) + log1pf(__expf(-fabsf(x))); }
__device__ __forceinline__ float logsigmoidf_(float x) { return fminf(x, 0.f) - log1pf(__expf(-fabsf(x))); }
__device__ __forceinline__ float wave_sum(float v) {
#pragma unroll
    for (int o = 1; o < 64; o <<= 1) v += __shfl_xor(v, o);
    return v;
}

typedef float f32x2c __attribute__((ext_vector_type(2)));
typedef __bf16 bf16x2c __attribute__((ext_vector_type(2)));
__device__ __forceinline__ unsigned cvt_pk2(float lo, float hi) { f32x2c v = {lo, hi}; bf16x2c r = __builtin_convertvector(v, bf16x2c); return __builtin_bit_cast(unsigned, r); }
__device__ __forceinline__ int opaque_tid() { int t = threadIdx.x; asm volatile("" : "+v"(t)); return t; }

struct Params {
    const float* x; const float* norm_w; const float* w_in; const float* gla_gate_w; const float* gla_gate_b; const float* gla_norm_w;
    const float* ml_conv_w; const float* ml_conv_b; const float* ml_i_b; const float* ml_f_b; const float* ml_norm_w;
    const float* hg_lb; const float* hg_norm_w; const float* ssd_conv_w; const float* ssd_conv_b; const float* ssd_dt_bias;
    const float* ssd_A_log; const float* ssd_D; const float* ssd_norm_w; const float* w_out; const float* final_norm_w;
    float* out; unsigned char* ws;
};
typedef const __attribute__((address_space(4))) Params* KP;
namespace pg8 {
#define PG8_LAS __attribute__((address_space(3)))
typedef unsigned short bf16_t;
typedef short bf16x8 __attribute__((ext_vector_type(8)));
typedef float f32x4 __attribute__((ext_vector_type(4)));
typedef unsigned u32x4 __attribute__((ext_vector_type(4)));
constexpr int BM = 256, BK = 64, HALF = 128, HTB = HALF * BK * 2  , STAGE_BYTES = 8 * HTB, NXCD = 8, WGM = 4;

__host__ __device__ __forceinline__ int lds_byte(int r, int c) { const int st = (r >> 4) * 2 + (c >> 5), rr = r & 15, cc = c & 31, ob = rr * 64 + cc * 2; return st * 1024 + (ob ^ (((ob >> 9) & 1) << 5)); }
__host__ __device__ __forceinline__ void stage_rc(int b, int& R, int& C) { const int st = b / 1024, sb = b % 1024, swz = sb ^ (((sb >> 9) & 1) << 5); R = (st >> 1) * 16 + swz / 64; C = (st & 1) * 32 + (swz % 64) / 2; }
__host__ __device__ __forceinline__ int perm32(int rho) { const int n = rho >> 4, i = rho & 15; return 8 * (i >> 2) + 4 * n + (i & 3); }

struct Unit { int pm, pn, idx; };
struct Gemm { const bf16_t* A; const bf16_t* Bt; int M, N, K, lda; };

struct StaticOrder {
    int nM, nN, nwg, G, c;
    __host__ __device__ void init(int M, int N, int G_, int c_) { nM = M / BM; nN = N / BM; nwg = nM * nN; G = G_; c = c_; }
    __host__ __device__ bool next(int i, Unit& u) const {
        const long L = (long)i * G + c; if (L >= nwg) return false;
        int wgid = (int)L; { const int q = nwg / NXCD, r = nwg % NXCD, xcd = wgid % NXCD, off = wgid / NXCD; wgid = (xcd < r ? xcd * (q + 1) : r * (q + 1) + (xcd - r) * q) + off; }
        const int nig = WGM * nN, gid = wgid / nig, fm = gid * WGM, gsz = (nM - fm) < WGM ? (nM - fm) : WGM;
        u.pm = fm + ((wgid % nig) % gsz); u.pn = (wgid % nig) / gsz; u.idx = i; return true;
    }
    __device__ __forceinline__ void a_ready(const Unit&) const {}
    __device__ __forceinline__ void done(const Unit&) const {}
};

__device__ __forceinline__ unsigned cvt_pk_bf16(float lo, float hi) { return cvt_pk2(lo, hi); }

template <class Epi, class Sched, bool ALIGN_EPI = false, bool SP2 = false>
__device__ __forceinline__ void gemm_phase(PG8_LAS unsigned char* lds, const Gemm g, const Sched& S, const Epi& E) {
    const int tid = opaque_tid(), wid = __builtin_amdgcn_readfirstlane(tid >> 6), lane = tid & 63, wr = wid >> 2, wc = wid & 3, fr = lane & 15, fq = lane >> 4;
    const int K = g.K, nt = K / BK, lda = g.lda;
    unsigned voffA[2], voffB[2];
#pragma unroll
    for (int i = 0; i < 2; ++i) { int R, C; stage_rc(tid * 16 + i * 8192, R, C); const int Rb = Epi::PERM ? ((R & ~31) + perm32(R & 31)) : R;
        voffA[i] = (unsigned)(R * lda + C) * 2u; voffB[i] = (unsigned)(Rb * K + C) * 2u; }
    const size_t kstep = (size_t)(BK * 2);
    const size_t hsA = (size_t)HALF * lda * 2, hsB = (size_t)HALF * K * 2;
    const size_t tsA = 2 * hsA, tsB = 2 * hsB;
    const unsigned ldsw = (unsigned)wid * 1024u;
    const int aoff = lds_byte(wr * 64 + fr, fq * 8), boff = lds_byte(wc * 32 + fr, fq * 8);
#define PG8_SA(b, h) (((b) * 2 + (h)) * HTB)
#define PG8_SB(b, h) ((4 + (b) * 2 + (h)) * HTB)
#define PG8_STAGE(bufoff, gbase, voff) do { _Pragma("unroll") for (int _i = 0; _i < 2; ++_i) \
        __builtin_amdgcn_global_load_lds((const unsigned*)((const char*)(gbase) + (voff)[_i]), (PG8_LAS unsigned*)(lds + (bufoff) + ldsw + _i * 8192), 16, 0, 0); } while (0)
#define PG8_LDA(dst, b, h) do { _Pragma("unroll") for (int m = 0; m < 4; ++m) _Pragma("unroll") for (int k = 0; k < 2; ++k) dst[m][k] = *(const PG8_LAS bf16x8*)(lds + PG8_SA(b, h) + aoff + m * 2048 + k * 1024); } while (0)
#define PG8_LDB(dst, b, h) do { _Pragma("unroll") for (int n = 0; n < 2; ++n) _Pragma("unroll") for (int k = 0; k < 2; ++k) dst[n][k] = *(const PG8_LAS bf16x8*)(lds + PG8_SB(b, h) + boff + n * 2048 + k * 1024); } while (0)
#define PG8_MMA(ai, bj, At, Bt) do { __builtin_amdgcn_s_setprio(1); _Pragma("unroll") for (int m = 0; m < 4; ++m) _Pragma("unroll") for (int n = 0; n < 2; ++n) _Pragma("unroll") for (int k = 0; k < 2; ++k) \
        acc[ai][bj][m][n] = __builtin_amdgcn_mfma_f32_16x16x32_bf16(Bt[n][k], At[m][k], acc[ai][bj][m][n], 0, 0, 0); __builtin_amdgcn_s_setprio(0); } while (0)
#define PG8_WAIT_V(n) asm volatile("s_waitcnt vmcnt(" #n ")" ::: "memory")
#define PG8_WAIT_L(n) asm volatile("s_waitcnt lgkmcnt(" #n ")" ::: "memory")
#define PG8_BAR __builtin_amdgcn_s_barrier()
#define PG8_SCHED __builtin_amdgcn_sched_barrier(0)
    Unit cur, nxt; int ui = 0;
    if (!S.next(0, cur)) return;
    f32x4 acc[2][2][4][2];
#pragma unroll
    for (int a = 0; a < 2; ++a)
#pragma unroll
        for (int b = 0; b < 2; ++b)
#pragma unroll
            for (int m = 0; m < 4; ++m)
#pragma unroll
                for (int n = 0; n < 2; ++n) acc[a][b][m][n] = (f32x4){0.f, 0.f, 0.f, 0.f};
    bf16x8 At[4][2], B0[2][2], B1[2][2];
    const char* cA = (const char*)g.A + (size_t)cur.pm * tsA; const char* cB = (const char*)g.Bt + (size_t)cur.pn * tsB;
    S.a_ready(cur);
    if constexpr (SP2) {
        PG8_STAGE(PG8_SB(0, 0), cB, voffB); PG8_STAGE(PG8_SB(0, 1), cB + hsB, voffB); PG8_STAGE(PG8_SA(0, 0), cA, voffA); PG8_STAGE(PG8_SA(0, 1), cA + hsA, voffA);
        if (wr == 1) PG8_BAR;
        PG8_WAIT_V(2); PG8_BAR;
        PG8_STAGE(PG8_SB(1, 0), cB + kstep, voffB); PG8_STAGE(PG8_SA(1, 0), cA + kstep, voffA); PG8_STAGE(PG8_SB(1, 1), cB + hsB + kstep, voffB);
        PG8_WAIT_V(6); PG8_BAR;
    } else {
        PG8_STAGE(PG8_SB(0, 0), cB, voffB); PG8_STAGE(PG8_SA(0, 0), cA, voffA); PG8_STAGE(PG8_SB(0, 1), cB + hsB, voffB); PG8_STAGE(PG8_SA(0, 1), cA + hsA, voffA);
        if (wr == 1) PG8_BAR;
        PG8_WAIT_V(4); PG8_BAR;
        PG8_STAGE(PG8_SB(1, 0), cB + kstep, voffB); PG8_STAGE(PG8_SA(1, 0), cA + kstep, voffA); PG8_STAGE(PG8_SB(1, 1), cB + hsB + kstep, voffB);
        PG8_WAIT_V(6); PG8_BAR;
    }
    u32x4 held[4]; bool have_held = false; Unit hu = cur;
    for (;;) {
        const bool has_next = S.next(ui + 1, nxt);
        const char* nA = has_next ? (const char*)g.A + (size_t)nxt.pm * tsA : cA; const char* nB = has_next ? (const char*)g.Bt + (size_t)nxt.pn * tsB : cB;
        for (int t = 0; t < nt; t += 2) {
            const bool last = (t == nt - 2);
            const char* a1 = cA + (size_t)(t + 1) * kstep;
            const char* a2 = last ? nA : cA + (size_t)(t + 2) * kstep; const char* b2 = last ? nB : cB + (size_t)(t + 2) * kstep;
            const char* a3 = a2 + kstep; const char* b3 = b2 + kstep;
            if (last && has_next) S.a_ready(nxt);
            if constexpr (Epi::DEFER) { if (have_held && (t == 2 || t == 6)) E.store_held(held, hu, (t - 2) >> 2, wr, wc, fr, fq); }
            if constexpr (SP2) {
            PG8_LDB(B0, 0, 0); PG8_LDB(B1, 0, 1); PG8_SCHED; PG8_LDA(At, 0, 0); PG8_STAGE(PG8_SA(1, 1), a1 + hsA, voffA);
            PG8_WAIT_V(8); PG8_WAIT_L(0); PG8_BAR; PG8_MMA(0, 0, At, B0); PG8_MMA(0, 1, At, B1); PG8_BAR; PG8_SCHED;
            PG8_LDA(At, 0, 1); PG8_STAGE(PG8_SB(0, 0), b2, voffB); PG8_STAGE(PG8_SB(0, 1), b2 + hsB, voffB); PG8_STAGE(PG8_SA(0, 0), a2, voffA);
            PG8_WAIT_V(8); PG8_WAIT_L(0); PG8_BAR; PG8_MMA(1, 0, At, B0); PG8_MMA(1, 1, At, B1); PG8_BAR; PG8_SCHED;
            PG8_LDB(B0, 1, 0); PG8_LDB(B1, 1, 1); PG8_SCHED; PG8_LDA(At, 1, 0); PG8_STAGE(PG8_SA(0, 1), a2 + hsA, voffA);
            PG8_WAIT_V(8); PG8_WAIT_L(0); PG8_BAR; PG8_MMA(0, 0, At, B0); PG8_MMA(0, 1, At, B1); PG8_BAR; PG8_SCHED;
            PG8_LDA(At, 1, 1); PG8_STAGE(PG8_SB(1, 0), b3, voffB); PG8_STAGE(PG8_SB(1, 1), b3 + hsB, voffB); PG8_STAGE(PG8_SA(1, 0), a3, voffA);
            PG8_WAIT_V(8); PG8_WAIT_L(0); PG8_BAR; PG8_MMA(1, 0, At, B0); PG8_MMA(1, 1, At, B1); PG8_BAR; PG8_SCHED;
            } else {
            PG8_LDB(B0, 0, 0); PG8_SCHED; PG8_LDA(At, 0, 0); PG8_STAGE(PG8_SA(1, 1), a1 + hsA, voffA);
            PG8_WAIT_L(8); PG8_BAR; PG8_WAIT_L(0); PG8_MMA(0, 0, At, B0); PG8_BAR; PG8_SCHED;
            PG8_LDB(B1, 0, 1); PG8_STAGE(PG8_SB(0, 0), b2, voffB);
            PG8_BAR; PG8_WAIT_L(0); PG8_MMA(0, 1, At, B1); PG8_BAR;
            PG8_LDA(At, 0, 1); PG8_STAGE(PG8_SA(0, 0), a2, voffA);
            PG8_BAR; PG8_WAIT_L(0); PG8_MMA(1, 0, At, B0); PG8_BAR; PG8_SCHED;
            PG8_STAGE(PG8_SB(0, 1), b2 + hsB, voffB);
            PG8_WAIT_V(6); PG8_BAR; PG8_MMA(1, 1, At, B1); PG8_BAR;
            PG8_LDB(B0, 1, 0); PG8_SCHED; PG8_LDA(At, 1, 0); PG8_STAGE(PG8_SA(0, 1), a2 + hsA, voffA);
            PG8_WAIT_L(8); PG8_BAR; PG8_WAIT_L(0); PG8_MMA(0, 0, At, B0); PG8_BAR; PG8_SCHED;
            PG8_LDB(B1, 1, 1); PG8_STAGE(PG8_SB(1, 0), b3, voffB);
            PG8_BAR; PG8_WAIT_L(0); PG8_MMA(0, 1, At, B1); PG8_BAR;
            PG8_LDA(At, 1, 1); PG8_STAGE(PG8_SA(1, 0), a3, voffA);
            PG8_BAR; PG8_WAIT_L(0); PG8_MMA(1, 0, At, B0); PG8_BAR; PG8_SCHED;
            PG8_STAGE(PG8_SB(1, 1), b3 + hsB, voffB);
            PG8_WAIT_V(6); PG8_BAR; PG8_MMA(1, 1, At, B1); PG8_BAR;
            }
        }
        if constexpr (ALIGN_EPI) { if (wr == 0) PG8_BAR; }
        if constexpr (Epi::DEFER) {
            have_held = E.first_half_and_pack(acc, cur, wr, wc, fr, fq, held); hu = cur;
            if (!has_next) { if (have_held) { for (int q = 0; q < 2; ++q) E.store_held(held, hu, q, wr, wc, fr, fq); } S.done(cur); break; }
            S.done(cur);
        } else {
            E(acc, cur, wr, wc, fr, fq); S.done(cur);
            if (!has_next) break;
        }
#pragma unroll
        for (int a = 0; a < 2; ++a)
#pragma unroll
            for (int b = 0; b < 2; ++b)
#pragma unroll
                for (int m = 0; m < 4; ++m)
#pragma unroll
                    for (int n = 0; n < 2; ++n) acc[a][b][m][n] = (f32x4){0.f, 0.f, 0.f, 0.f};
        cur = nxt; cA = nA; cB = nB; ++ui;
        if constexpr (ALIGN_EPI) { if (wr == 1) PG8_BAR; }
    }
    PG8_WAIT_V(0);
    if constexpr (!ALIGN_EPI) { if (wr == 0) PG8_BAR; }
    PG8_BAR;
#undef PG8_SA
#undef PG8_SB
#undef PG8_STAGE
#undef PG8_LDA
#undef PG8_LDB
#undef PG8_MMA
#undef PG8_WAIT_V
#undef PG8_WAIT_L
#undef PG8_BAR
#undef PG8_SCHED
}
}
struct EpiProj {
    static constexpr bool PERM = true;
    static constexpr bool DEFER = true;
    bf16* proj; float* gates; const LAS float* rstd_tab; bf16* halo;
    __device__ __forceinline__ u32x4v pack8(const pg8::f32x4& a0, const pg8::f32x4& a1, float rs) const {
        const pg8::f32x4 v0 = a0 * rs, v1 = a1 * rs;
        u32x4v w; w.x = pg8::cvt_pk_bf16(v0[0], v0[1]); w.y = pg8::cvt_pk_bf16(v0[2], v0[3]); w.z = pg8::cvt_pk_bf16(v1[0], v1[1]); w.w = pg8::cvt_pk_bf16(v1[2], v1[3]); return w; }
    __device__ __forceinline__ bool first_half_and_pack(const pg8::f32x4 (&acc)[2][2][4][2], const pg8::Unit& u, int wr, int wc, int fr, int fq, pg8::u32x4 (&held)[4]) const {
        const int row0 = u.pm * 256 + wr * 64 + fr;
        if (u.pn < 30) {
#pragma unroll
            for (int ai = 0; ai < 2; ++ai)
#pragma unroll
                for (int m = 0; m < 4; ++m) {
                    const int row = row0 + ai * 128 + m * 16;
                    const float rs = rstd_tab[u.idx * 256 + (row & 255)];
#pragma unroll
                    for (int bj = 0; bj < 2; ++bj) { const u32x4v w = pack8(acc[ai][bj][m][0], acc[ai][bj][m][1], rs);
                        if (ai == 1 && m >= 2) held[(m - 2) * 2 + bj] = w;
                        else *(u32x4v*)(proj + (size_t)row * PP + u.pn * 256 + bj * 128 + wc * 32 + 8 * fq) = w;
                        if (u.pn >= 26 && (row & 511) >= 509)
                            *(u32x4v*)(halo + ((size_t)((row >> 9) * 3 + ((row & 511) - 509))) * 1024 + (u.pn - 26) * 256 + bj * 128 + wc * 32 + 8 * fq) = w; }
                }
            return true;
        }
        if (wc == 0) {
#pragma unroll
            for (int ai = 0; ai < 2; ++ai)
#pragma unroll
                for (int m = 0; m < 4; ++m) { const int row = row0 + ai * 128 + m * 16; const float rs = rstd_tab[u.idx * 256 + (row & 255)];
                    float* gp = gates + (size_t)row * 32 + 8 * fq;
                    *(pg8::f32x4*)(gp) = acc[ai][0][m][0] * rs; *(pg8::f32x4*)(gp + 4) = acc[ai][0][m][1] * rs; }
        }
        return false;
    }
    __device__ __forceinline__ void store_held(const pg8::u32x4 (&held)[4], const pg8::Unit& u, int q, int wr, int wc, int fr, int fq) const {
        bf16* base = proj + (size_t)(u.pm * 256 + wr * 64 + fr + 128) * PP + u.pn * 256 + wc * 32 + 8 * fq;
#pragma unroll
        for (int m = 2; m < 4; ++m) if (m - 2 == q) {
#pragma unroll
            for (int bj = 0; bj < 2; ++bj) *(u32x4v*)(base + (size_t)(m * 16) * PP + bj * 128) = held[(m - 2) * 2 + bj]; }
    }
};
struct EpiRes {
    static constexpr bool PERM = true;
    static constexpr bool DEFER = false;
    bf16* hb; float* ssq; bf16* h2; int last;
    __device__ __forceinline__ void operator()(const pg8::f32x4 (&acc)[2][2][4][2], const pg8::Unit& u, int wr, int wc, int fr, int fq) const {
        const int row0 = u.pm * 256 + wr * 64 + fr, col0 = u.pn * 256 + wc * 32 + 8 * fq;
        u32x4v res[2][4][2];
#pragma unroll
        for (int ai = 0; ai < 2; ++ai)
#pragma unroll
            for (int m = 0; m < 4; ++m)
#pragma unroll
                for (int bj = 0; bj < 2; ++bj) res[ai][m][bj] = *(const u32x4v*)(hb + (size_t)(row0 + ai * 128 + m * 16) * DM + col0 + bj * 128);
#pragma unroll
        for (int ai = 0; ai < 2; ++ai)
#pragma unroll
            for (int m = 0; m < 4; ++m) {
                const int row = row0 + ai * 128 + m * 16;
                float sq = 0.f;
#pragma unroll
                for (int bj = 0; bj < 2; ++bj) {
                    const int col = col0 + bj * 128;
                    const u32x4v rw = res[ai][m][bj];
                    const pg8::f32x4 r0 = (pg8::f32x4){__uint_as_float(rw.x << 16), __uint_as_float(rw.x & 0xffff0000u), __uint_as_float(rw.y << 16), __uint_as_float(rw.y & 0xffff0000u)};
                    const pg8::f32x4 r1 = (pg8::f32x4){__uint_as_float(rw.z << 16), __uint_as_float(rw.z & 0xffff0000u), __uint_as_float(rw.w << 16), __uint_as_float(rw.w & 0xffff0000u)};
                    const pg8::f32x4 v0 = acc[ai][bj][m][0] + r0, v1 = acc[ai][bj][m][1] + r1;
                    u32x4v w; w.x = pg8::cvt_pk_bf16(v0[0], v0[1]); w.y = pg8::cvt_pk_bf16(v0[2], v0[3]); w.z = pg8::cvt_pk_bf16(v1[0], v1[1]); w.w = pg8::cvt_pk_bf16(v1[2], v1[3]);
                    bf16* dst = last ? (bf16*)((char*)h2 + (size_t)row * (PP * 2)) + col : hb + (size_t)row * DM + col;
                    *(u32x4v*)dst = w;
                    sq += (v0[0] * v0[0] + v0[1] * v0[1]) + (v0[2] * v0[2] + v0[3] * v0[3]) + (v1[0] * v1[0] + v1[1] * v1[1]) + (v1[2] * v1[2] + v1[3] * v1[3]);
                }
                sq += __shfl_xor(sq, 16); sq += __shfl_xor(sq, 32);
                if (fq == 0) ssq[(size_t)(u.pn * 4 + wc) * NTOK + row] = sq;
            }
    }
};

constexpr int NIT_WIN = (DM / 64) * (NPAD / 32), NIT_WOUT = (DINNER / 64) * (DM / 32);
template <int NR>
__device__ __forceinline__ void rows_to_bf16_rstd(const float* x, bf16* hb, float* rstd, int m0, int mstride, int lane) {
    f32x4v v[NR][4];
#pragma unroll
    for (int q = 0; q < NR; ++q) { const f32x4v* xr = (const f32x4v*)(x + (size_t)(m0 + q * mstride) * DM) + lane;
#pragma unroll
        for (int j = 0; j < 4; ++j) v[q][j] = xr[64 * j]; }
#pragma unroll
    for (int q = 0; q < NR; ++q) { float s = 0.f;
#pragma unroll
        for (int j = 0; j < 4; ++j) s += (v[q][j].x * v[q][j].x + v[q][j].y * v[q][j].y) + (v[q][j].z * v[q][j].z + v[q][j].w * v[q][j].w);
        s = wave_sum(s);
        if (lane == 0) rstd[m0 + q * mstride] = 1.0f / sqrtf(s * (1.0f / DM) + EPS);
        u32x2v* o8 = (u32x2v*)(hb + (size_t)(m0 + q * mstride) * DM) + lane;
#pragma unroll
        for (int j = 0; j < 4; ++j) { u32x2v w; w.x = cvt_pk2(v[q][j].x, v[q][j].y); w.y = cvt_pk2(v[q][j].z, v[q][j].w); o8[64 * j] = w; } }
}
template <bool WIN>
__device__ __forceinline__ void transpose_item(const float* W, int K, int Nsrc, int Ndst, bf16* WT, LAS float* scr, int item, int lane, const float* kscale) {
    const int nb_n = Ndst / 32, kb = item / nb_n, nb = item % nb_n, k0 = 64 * kb, n0 = 32 * nb;
    const int n4 = (lane & 7) * 4; const int src = WIN ? win_src_col(n0 + n4) : (n0 + n4);
#pragma unroll
    for (int i = 0; i < 8; ++i) { const int kk = 8 * i + (lane >> 3);
        f32x4v v = (f32x4v){0.f, 0.f, 0.f, 0.f}; if (src >= 0) { v = *(const f32x4v*)(W + (size_t)(k0 + kk) * Nsrc + src); if (WIN) v = v * kscale[k0 + kk]; }
        scr[kk * 33 + n4] = v.x; scr[kk * 33 + n4 + 1] = v.y; scr[kk * 33 + n4 + 2] = v.z; scr[kk * 33 + n4 + 3] = v.w; }
    asm volatile("s_waitcnt lgkmcnt(0)" ::: "memory");
    const int c = lane & 7;
#pragma unroll
    for (int j = 0; j < 4; ++j) { const int n = (lane >> 3) + 8 * j; const LAS float* s = scr + (8 * c) * 33 + n;
        u32x4v o; o.x = cvt_pk2(s[0 * 33], s[1 * 33]); o.y = cvt_pk2(s[2 * 33], s[3 * 33]); o.z = cvt_pk2(s[4 * 33], s[5 * 33]); o.w = cvt_pk2(s[6 * 33], s[7 * 33]);
        *(u32x4v*)(WT + (size_t)(n0 + n) * K + k0 + 8 * c) = o; }
    asm volatile("s_waitcnt lgkmcnt(0)" ::: "memory");
}
struct TItem { const float* W; bf16* WT; const float* kscale; int K, Nsrc, k0, n0, src; bool win; };
__device__ __forceinline__ TItem cvt_item(KP P, int l, int it, int lane) {
    const int n_in = (l + 1 < DEPTH) ? NIT_WIN : 0; TItem t;
    if (it < n_in) { t.W = P->w_in + (size_t)(l + 1) * DM * DPROJ; t.K = DM; t.Nsrc = DPROJ; t.WT = (bf16*)((unsigned char*)P->out + DO_WIN + (size_t)(l + 1) * DO_WIN_STRIDE); t.kscale = P->norm_w + (l + 1) * DM; t.win = true;
        const int nb_n = NPAD / 32; t.k0 = 64 * (it / nb_n); t.n0 = 32 * (it % nb_n); t.src = win_src_col(t.n0 + (lane & 7) * 4); }
    else { const int i2 = it - n_in; t.W = P->w_out + (size_t)l * DINNER * DM; t.K = DINNER; t.Nsrc = DM; t.WT = (bf16*)(P->ws + WS_WOUT) + (size_t)l * DM * DINNER; t.kscale = nullptr; t.win = false;
        const int nb_n = DM / 32; t.k0 = 64 * (i2 / nb_n); t.n0 = 32 * (i2 % nb_n); t.src = t.n0 + (lane & 7) * 4; }
    return t;
}
__device__ __forceinline__ void cvt_load(const TItem& t, int lane, f32x4v (&v)[8]) {
#pragma unroll
    for (int i = 0; i < 8; ++i) { const int kk = 8 * i + (lane >> 3);
        v[i] = (f32x4v){0.f, 0.f, 0.f, 0.f}; if (t.src >= 0) { v[i] = *(const f32x4v*)(t.W + (size_t)(t.k0 + kk) * t.Nsrc + t.src); if (t.win) v[i] = v[i] * t.kscale[t.k0 + kk]; } }
}
__device__ __forceinline__ void cvt_finish(const TItem& t, int lane, const f32x4v (&v)[8], LAS float* scr) {
    const int n4 = (lane & 7) * 4;
#pragma unroll
    for (int i = 0; i < 8; ++i) { const int kk = 8 * i + (lane >> 3);
        scr[kk * 33 + n4] = v[i].x; scr[kk * 33 + n4 + 1] = v[i].y; scr[kk * 33 + n4 + 2] = v[i].z; scr[kk * 33 + n4 + 3] = v[i].w; }
    asm volatile("s_waitcnt lgkmcnt(0)" ::: "memory");
    const int c = lane & 7;
#pragma unroll
    for (int j = 0; j < 4; ++j) { const int n = (lane >> 3) + 8 * j; const LAS float* sp = scr + (8 * c) * 33 + n;
        u32x4v o; o.x = cvt_pk2(sp[0 * 33], sp[1 * 33]); o.y = cvt_pk2(sp[2 * 33], sp[3 * 33]); o.z = cvt_pk2(sp[4 * 33], sp[5 * 33]); o.w = cvt_pk2(sp[6 * 33], sp[7 * 33]);
        *(u32x4v*)(t.WT + (size_t)(t.n0 + n) * t.K + t.k0 + 8 * c) = o; }
    asm volatile("s_waitcnt lgkmcnt(0)" ::: "memory");
}
__device__ __forceinline__ void phase_prologue(KP P, int bid, int nblk, LAS unsigned char* lds) {
    const int tid = opaque_tid(), lane = tid & 63, wave = tid >> 6;
    const int gw = bid * 8 + wave, ngw = nblk * 8;
    LAS float* scr = (LAS float*)(lds + wave * 16384);
    bf16* hb = (bf16*)((unsigned char*)P->out + DO_HB); float* rstd0 = (float*)(P->ws + WS_RSTD0);
    { int m = gw;
      for (; m + 7 * ngw < NTOK; m += 8 * ngw) rows_to_bf16_rstd<8>(P->x, hb, rstd0, m, ngw, lane);
      for (; m + 3 * ngw < NTOK; m += 4 * ngw) rows_to_bf16_rstd<4>(P->x, hb, rstd0, m, ngw, lane);
      for (; m < NTOK; m += ngw) rows_to_bf16_rstd<1>(P->x, hb, rstd0, m, 0, lane); }
    for (int it = gw; it < NIT_WIN; it += ngw)
        transpose_item<true>(P->w_in, DM, DPROJ, NPAD, (bf16*)((unsigned char*)P->out + DO_WIN), scr, it, lane, P->norm_w);
}
constexpr int CVT_BATCH = 1;
__device__ __forceinline__ void convert_weights_late(KP P, int l, int gw, int ngw, LAS unsigned char* lds) {
    const int tid = opaque_tid(), lane = tid & 63, wave = tid >> 6;
    LAS float* scr = (LAS float*)(lds + wave * 16384);
    const int n_in = (l + 1 < DEPTH) ? NIT_WIN : 0;
    for (int it = gw; it < n_in + NIT_WOUT; it += ngw) {
        if (it < n_in) transpose_item<true>(P->w_in + (size_t)(l + 1) * DM * DPROJ, DM, DPROJ, NPAD, (bf16*)((unsigned char*)P->out + DO_WIN + (size_t)(l + 1) * DO_WIN_STRIDE), scr, it, lane, P->norm_w + (l + 1) * DM);
        else transpose_item<false>(P->w_out + (size_t)l * DINNER * DM, DINNER, DM, DM, (bf16*)(P->ws + WS_WOUT) + (size_t)l * DM * DINNER, scr, it - n_in, lane, nullptr);
    }
}
__device__ __forceinline__ void convert_weights_queue(KP P, int l, LAS unsigned char* lds) {
    const int tid = opaque_tid(), lane = tid & 63, wave = tid >> 6;
    LAS float* scr = (LAS float*)(lds + wave * 16384);
    volatile LAS int* slot = (volatile LAS int*)(lds + 8 * 16384);
    const int ntot = ((l + 1 < DEPTH) ? NIT_WIN : 0) + NIT_WOUT;
    unsigned* ctr = (unsigned*)(P->ws + WS_CTL) + 64 + 32 * l;
    for (;;) {
        if (tid == 0) *slot = (int)__hip_atomic_fetch_add(ctr, 16u, __ATOMIC_RELAXED, __HIP_MEMORY_SCOPE_AGENT);
        __syncthreads();
        const int base = __builtin_amdgcn_readfirstlane(*slot);
        __syncthreads();
        if (base >= ntot) break;
        const int i0 = base + wave, i1 = base + 8 + wave;
        f32x4v va[8], vb[8]; TItem ta, tb;
        if (i0 < ntot) { ta = cvt_item(P, l, i0, lane); cvt_load(ta, lane, va); }
        if (i1 < ntot) { tb = cvt_item(P, l, i1, lane); cvt_load(tb, lane, vb); }
        if (i0 < ntot) cvt_finish(ta, lane, va, scr);
        if (i1 < ntot) cvt_finish(tb, lane, vb, scr);
    }
}
__device__ __forceinline__ void phase_gemm_in(KP P, int l, int bid, int nblk, LAS unsigned char* lds) {
    pg8::Gemm g{(const bf16*)((unsigned char*)P->out + DO_HB), (const bf16*)((unsigned char*)P->out + DO_WIN + (size_t)l * DO_WIN_STRIDE), NTOK, NPAD, DM, DM};
    pg8::StaticOrder S; S.init(NTOK, NPAD, nblk, bid);
    LAS float* rtab = (LAS float*)(lds + 131072);
    { const int tid = opaque_tid(); const float* rstd0 = (const float*)(P->ws + WS_RSTD0); const float* ssq = (const float*)(P->ws + WS_SSQ);
      const int nunit = min(((NTOK / 256) * (NPAD / 256) + nblk - 1) / nblk, 31);
      for (int e = tid; e < nunit * 256; e += 512) { pg8::Unit u; const int i = e >> 8;
          if (S.next(i, u)) { const int row = u.pm * 256 + (e & 255); float r;
              if (l == 0) r = rstd0[row];
              else { float sum = 0.f;
#pragma unroll
                  for (int p = 0; p < 16; ++p) sum += ssq[(size_t)p * NTOK + row];
                  r = 1.0f / sqrtf(sum * (1.0f / DM) + EPS); }
              rtab[e] = r; } }
      __syncthreads(); }
    EpiProj E{(bf16*)(P->ws + WS_PROJ), (float*)(P->ws + WS_GATES), rtab, (bf16*)(P->ws + WS_HALO)};
    pg8::gemm_phase<EpiProj, pg8::StaticOrder, true, true>(lds, g, S, E);
}
__device__ __forceinline__ void phase_gemm_out(KP P, int l, int bid, int nblk, LAS unsigned char* lds) {
    pg8::Gemm g{(const bf16*)(P->ws + WS_PROJ), (const bf16*)(P->ws + WS_WOUT) + (size_t)l * DM * DINNER, NTOK, DM, DINNER, PP};
    pg8::StaticOrder S; S.init(NTOK, DM, nblk, bid);
    EpiRes E{(bf16*)((unsigned char*)P->out + DO_HB), (float*)(P->ws + WS_SSQ), (bf16*)(P->ws + WS_PROJ + 4096), (l == DEPTH - 1) ? 1 : 0};
    pg8::gemm_phase<EpiRes, pg8::StaticOrder, false, true>(lds, g, S, E);
}
__device__ __forceinline__ void phase_final(KP P, int bid, int nblk) {
    const int tid = opaque_tid(), lane = tid & 63, wave = tid >> 6;
    const int gw = bid * 8 + wave, ngw = nblk * 8;
    const float* ssq = (const float*)(P->ws + WS_SSQ);
    f32x4v wv[4];
#pragma unroll
    for (int j = 0; j < 4; ++j) wv[j] = *((const f32x4v*)P->final_norm_w + 2 * lane + (j & 1) + 128 * (j >> 1));
    for (int m0 = gw; m0 < NTOK; m0 += 2 * ngw) {
        u32x4v ha[2], hb_[2]; float sp[2];
#pragma unroll
        for (int q = 0; q < 2; ++q) { const int m = m0 + q * ngw; const u32x4v* hr = (const u32x4v*)(P->ws + WS_PROJ + 4096 + (size_t)m * (PP * 2));
            ha[q] = hr[lane]; hb_[q] = hr[64 + lane]; sp[q] = (lane < 16) ? ssq[(size_t)lane * NTOK + m] : 0.f; }
#pragma unroll
        for (int q = 0; q < 2; ++q) { const int m = m0 + q * ngw;
            const float rs = 1.0f / sqrtf(wave_sum(sp[q]) * (1.0f / DM) + EPS);
            f32x4v* o = (f32x4v*)(P->out + (size_t)m * DM);
            f32x4v v;
            v = (f32x4v){__uint_as_float(ha[q].x << 16), __uint_as_float(ha[q].x & 0xffff0000u), __uint_as_float(ha[q].y << 16), __uint_as_float(ha[q].y & 0xffff0000u)}; o[2 * lane] = v * rs * wv[0];
            v = (f32x4v){__uint_as_float(ha[q].z << 16), __uint_as_float(ha[q].z & 0xffff0000u), __uint_as_float(ha[q].w << 16), __uint_as_float(ha[q].w & 0xffff0000u)}; o[2 * lane + 1] = v * rs * wv[1];
            v = (f32x4v){__uint_as_float(hb_[q].x << 16), __uint_as_float(hb_[q].x & 0xffff0000u), __uint_as_float(hb_[q].y << 16), __uint_as_float(hb_[q].y & 0xffff0000u)}; o[128 + 2 * lane] = v * rs * wv[2];
            v = (f32x4v){__uint_as_float(hb_[q].z << 16), __uint_as_float(hb_[q].z & 0xffff0000u), __uint_as_float(hb_[q].w << 16), __uint_as_float(hb_[q].w & 0xffff0000u)}; o[128 + 2 * lane + 1] = v * rs * wv[3]; }
    }
}
namespace mx {
typedef short bf16x8 __attribute__((ext_vector_type(8)));
typedef float f32x4 __attribute__((ext_vector_type(4)));
constexpr int SEGL = 512, NSEG = SEQ / SEGL, CH = 64, NCH = SEGL / CH;
constexpr int L_QT = 0, L_KT = 17408, L_KTT = 34816, L_VT = 53248, L_PM = 73984, L_ST = 92416, L_VVT = 131584, L_VEC = 150016;
constexpr int V_TOT = 0, V_PRE = 4096, V_POST = 4608, V_MISC = 5120;
constexpr size_t ST_GLA = 0, ST_HGRN = 1048576, ST_ML = 3145728, ST_SSD = 5505024;
constexpr int DS_GLA = 0, DS_HGRN = 8192, DS_ML = 24576, DS_SSD = 25600;

__device__ __forceinline__ int opq(int v) { asm volatile("" : "+v"(v)); return v; }
#define MFMA16(a, b, c) __builtin_amdgcn_mfma_f32_16x16x32_bf16((a), (b), (c), 0, 0, 0)
__device__ __forceinline__ bf16x8 frag(LAS unsigned char* base, int row, int pitch, int ks, int qd) { return *(const LAS bf16x8*)(base + row * pitch + ks * 64 + qd * 16); }
__device__ __forceinline__ int sw64(int row, int byteoff) { return row * 128 + ((((byteoff >> 4) ^ ((row >> 1) & 7)) << 4) | (byteoff & 15)); }
__device__ __forceinline__ bf16x8 frag64(LAS unsigned char* base, int row, int ks, int qd) { return *(const LAS bf16x8*)(base + row * 128 + (((4 * ks + qd) ^ ((row >> 1) & 7)) << 4)); }
template <int PQ> __device__ __forceinline__ int offp(int row, int byteoff) { return PQ == 272 ? row * 272 + byteoff : sw64(row, byteoff); }
template <int PQ> __device__ __forceinline__ bf16x8 fragp(LAS unsigned char* base, int row, int ks, int qd) { return PQ == 272 ? frag(base, row, 272, ks, qd) : frag64(base, row, ks, qd); }
__device__ __forceinline__ unsigned cvtpk(float lo, float hi) { return cvt_pk2(lo, hi); }
__device__ __forceinline__ u32x2v pack4(f32x4 v) { u32x2v w; w.x = cvtpk(v[0], v[1]); w.y = cvtpk(v[2], v[3]); return w; }
__device__ __forceinline__ float lo2f(unsigned w) { return __uint_as_float(w << 16); }
__device__ __forceinline__ float hi2f(unsigned w) { return __uint_as_float(w & 0xffff0000u); }

__device__ __forceinline__ float fexp(float x) { return __builtin_amdgcn_exp2f(x * 1.4426950408889634f); }
__device__ __forceinline__ float flog(float x) { return __builtin_amdgcn_logf(x) * 0.6931471805599453f; }
__device__ __forceinline__ float frcp(float x) { return __builtin_amdgcn_rcpf(x); }
__device__ __forceinline__ float frsq(float x) { return __builtin_amdgcn_rsqf(x); }
__device__ __forceinline__ float fsigmoid(float x) { return frcp(1.f + fexp(-x)); }
__device__ __forceinline__ float fsilu(float x) { return x * frcp(1.f + fexp(-x)); }
__device__ __forceinline__ float flog1pexp(float nx) { return flog(1.f + fexp(nx)); }
__device__ __forceinline__ float flogsigmoid(float x) { return fminf(x, 0.f) - flog1pexp(-fabsf(x)); }
__device__ __forceinline__ float fsoftplus(float x) { return fmaxf(x, 0.f) + flog1pexp(-fabsf(x)); }

constexpr int FLAG_OFF = 8192, FLAG_SSD = 0, FLAG_ML = 64, FLAG_HG = 192, FLAG_GLA = 320;
__device__ __forceinline__ unsigned* flag_ptr(KP P, int fbase, int idx) { return (unsigned*)(P->ws + WS_CTL) + FLAG_OFF + (fbase + idx) * 16; }
__device__ __forceinline__ void st_wt(bf16* p, u32x2v v) { __hip_atomic_store((unsigned long long*)p, ((unsigned long long)v.y << 32) | v.x, __ATOMIC_RELAXED, __HIP_MEMORY_SCOPE_AGENT); }
__device__ __forceinline__ void st_wt_f(float* p, float v) { __hip_atomic_store(p, v, __ATOMIC_RELAXED, __HIP_MEMORY_SCOPE_AGENT); }
__device__ __forceinline__ void publish_item(unsigned* flag, unsigned epoch) {
    asm volatile("s_waitcnt vmcnt(0)" ::: "memory");
    __syncthreads();
    if (threadIdx.x == 0) __hip_atomic_store(flag, epoch, __ATOMIC_RELAXED, __HIP_MEMORY_SCOPE_AGENT);
}
__device__ __forceinline__ void wait_predecessors(unsigned* flag0, int s, unsigned epoch) {
    {
        if ((int)threadIdx.x < 64) {
            if ((int)threadIdx.x < s) { unsigned spins = 0;
                while (__hip_atomic_load(flag0 + threadIdx.x * 16, __ATOMIC_RELAXED, __HIP_MEMORY_SCOPE_AGENT) < epoch) { __builtin_amdgcn_s_sleep(2); if (++spins > (1u << 22)) break; } }
            __builtin_amdgcn_fence(__ATOMIC_ACQUIRE, "agent");
            asm volatile("s_waitcnt vmcnt(0)" ::: "memory");
        }
    }
    __syncthreads();
}

template <int TYPE, bool OUT, bool DRY = false>
__device__ __forceinline__ void pc_item(KP P, int l, int b, int h, int s, LAS unsigned char* lds) {
    if (!OUT && s == NSEG - 1) return;
    constexpr int DK = (TYPE == 0) ? 64 : 128, NDT = DK / 16, PQ = (DK == 128) ? 272 : 144, NKS = DK / 32;
    const int tid = opaque_tid(), lane = tid & 63, w = __builtin_amdgcn_readfirstlane(tid >> 6), r = lane & 15, qd = lane >> 4;
    const int cp = lane, g = w;
    constexpr int NTK = (TYPE == 0) ? 4 : 8;
    const int ck = (TYPE == 0) ? (lane & 31) : lane, th = (TYPE == 0) ? (lane >> 5) : 0;
    const bool kact = true;
    bf16* proj = (bf16*)(P->ws + WS_PROJ);
    LAS float* vtot = (LAS float*)(lds + L_VEC + V_TOT); LAS float* vpre = (LAS float*)(lds + L_VEC + V_PRE); LAS float* vpost = (LAS float*)(lds + L_VEC + V_POST);
    const int QCOL = (TYPE == 0) ? AQc(h) : CQc(h), KCOL = (TYPE == 0) ? AKc(h) : CFc(h), VCOL = (TYPE == 0) ? AVc(h) : CIc(h), ZCOL = ((TYPE == 0) ? ZA : ZC) + h * 128;
    const float qscale = (TYPE == 0) ? 0.125f : 0.08838834764831845f;
    const int idx = (b * 4 + h) * NSEG + s;
    bf16* stbase = (bf16*)((unsigned char*)P->out + DO_STATE) + ((TYPE == 0) ? ST_GLA : ST_HGRN);
    float* dsbase = (float*)(P->ws + WS_MISC) + ((TYPE == 0) ? DS_GLA : DS_HGRN);
    float lb0 = 0.f, lb1 = 0.f, gb0 = 0.f, gb1 = 0.f, gw0[16], gw1[16];
#pragma unroll
    for (int rr = 0; rr < 16; ++rr) { gw0[rr] = 0.f; gw1[rr] = 0.f; }
    if (kact) {
        if (TYPE == 2) {
#pragma unroll
            for (int c2 = 0; c2 < 2; ++c2) { const int ch = h * 128 + 2 * ck + c2;
                float mx_ = -1e30f; for (int i = 0; i < DEPTH; ++i) mx_ = fmaxf(mx_, P->hg_lb[i * 512 + ch]);
                float den = 0.f, num = 0.f; for (int i = 0; i < DEPTH; ++i) { const float e = fexp(P->hg_lb[i * 512 + ch] - mx_); den += e; if (i >= 1 && i <= l) num += e; }
                if (c2 == 0) lb0 = num / den; else lb1 = num / den; }
        } else {
#pragma unroll
            for (int rr = 0; rr < 16; ++rr) { gw0[rr] = P->gla_gate_w[((size_t)l * 16 + rr) * 256 + h * 64 + 2 * ck]; gw1[rr] = P->gla_gate_w[((size_t)l * 16 + rr) * 256 + h * 64 + 2 * ck + 1]; }
            gb0 = P->gla_gate_b[l * 256 + h * 64 + 2 * ck]; gb1 = P->gla_gate_b[l * 256 + h * 64 + 2 * ck + 1];
        }
    }
    unsigned rq[8], rk[8], rv[8]; f32x4 grv = (f32x4){0.f, 0.f, 0.f, 0.f};
#define PC_LOAD(cc) do { const size_t rw_ = (size_t)b * SEQ + (size_t)s * SEGL + (size_t)(cc) * CH + 8 * g; \
        _Pragma("unroll") for (int jj = 0; jj < 8; ++jj) rv[jj] = *(const unsigned*)(proj + (rw_ + jj) * PP + VCOL + 2 * cp); \
        _Pragma("unroll") for (int jj = 0; jj < NTK; ++jj) { const bf16* pr = proj + (rw_ + NTK * th + jj) * PP; \
            rk[jj] = *(const unsigned*)(pr + KCOL + 2 * ck); rq[jj] = OUT ? *(const unsigned*)(pr + QCOL + 2 * ck) : 0u; } \
        if (TYPE == 0) { if (lane < 32) grv = *(const f32x4*)((const float*)(P->ws + WS_GATES) + (rw_ + (lane >> 2)) * 32 + G_GR + (lane & 3) * 4); } } while (0)
    PC_LOAD(0);
    f32x4 S[NDT];
#pragma unroll
    for (int dt = 0; dt < NDT; ++dt) S[dt] = (f32x4){0.f, 0.f, 0.f, 0.f};
    if (OUT) {
        wait_predecessors(flag_ptr(P, (TYPE == 0) ? FLAG_GLA : FLAG_HG, idx - s), s, (unsigned)l + 1u);
        LAS float* vds = (LAS float*)(lds + L_QT);
        for (int i = tid; i < s * DK; i += 512) vds[i] = dsbase[(size_t)(idx - s) * DK + i];
        __syncthreads();
        for (int sp0 = 0; sp0 < s; sp0 += 4) {
            u32x2v raw[4][NDT];
#pragma unroll
            for (int u = 0; u < 4; ++u) { const int sp = (sp0 + u < s) ? sp0 + u : s - 1; const bf16* sb = stbase + (size_t)(idx - s + sp) * (DK * 128);
#pragma unroll
                for (int dt = 0; dt < NDT; ++dt) raw[u][dt] = *(const u32x2v*)(sb + ((size_t)(w * NDT + dt) * 64 + lane) * 4); }
#pragma unroll
            for (int u = 0; u < 4; ++u) if (sp0 + u < s) {
#pragma unroll
                for (int dt = 0; dt < NDT; ++dt) { const f32x4 d4 = *(const LAS f32x4*)(vds + (sp0 + u) * DK + 16 * dt + 4 * qd);
                    const f32x4 ds = (f32x4){lo2f(raw[u][dt].x), hi2f(raw[u][dt].x), lo2f(raw[u][dt].y), hi2f(raw[u][dt].y)}; S[dt] = S[dt] * d4 + ds; } }
        }
        __syncthreads();
    }
    float gsum0 = 0.f, gsum1 = 0.f;
    const int ei = tid >> 3, ecc = tid & 7;
    float nw[16];
#pragma unroll
    for (int k = 0; k < 16; ++k) nw[k] = OUT ? ((TYPE == 0) ? P->gla_norm_w : P->hg_norm_w)[l * 512 + h * 128 + 16 * ecc + k] : 0.f;

    constexpr int L_OB = L_VVT;
    float lg0[8], lg1[8], kk0[8], kk1[8];
#define PC_A1() do { \
        if (TYPE == 0) { if (lane < 32) *(LAS f32x4*)((LAS float*)(lds + L_VEC + V_MISC) + g * 128 + (lane >> 2) * 16 + (lane & 3) * 4) = grv; } \
        if (kact) { \
            if (TYPE == 2) { \
                _Pragma("unroll") for (int jj = 0; jj < 8; ++jj) { const float f0 = lo2f(rk[jj]), f1 = hi2f(rk[jj]); \
                    const float s0 = fsigmoid(f0), s1 = fsigmoid(f1); \
                    lg0[jj] = flog(fmaxf(lb0 + (1.f - lb0) * s0, 1e-30f)); lg1[jj] = flog(fmaxf(lb1 + (1.f - lb1) * s1, 1e-30f)); \
                    kk0[jj] = (1.f - lb0) * (1.f - s0); kk1[jj] = (1.f - lb1) * (1.f - s1); } \
            } else { \
                LAS float* vgr = (LAS float*)(lds + L_VEC + V_MISC) + g * 128; \
                _Pragma("unroll") for (int jj = 0; jj < NTK; ++jj) { const LAS f32x4* gr4 = (const LAS f32x4*)(vgr + (NTK * th + jj) * 16); float a0 = gb0, a1 = gb1; \
                    _Pragma("unroll") for (int r4 = 0; r4 < 4; ++r4) { const f32x4 x = gr4[r4]; \
                        _Pragma("unroll") for (int e = 0; e < 4; ++e) { a0 += x[e] * gw0[4 * r4 + e]; a1 += x[e] * gw1[4 * r4 + e]; } } \
                    lg0[jj] = flogsigmoid(a0) * (1.0f / 16.0f); lg1[jj] = flogsigmoid(a1) * (1.0f / 16.0f); \
                    kk0[jj] = lo2f(rk[jj]); kk1[jj] = hi2f(rk[jj]); } \
            } \
            _Pragma("unroll") for (int jj = 1; jj < NTK; ++jj) { lg0[jj] += lg0[jj - 1]; lg1[jj] += lg1[jj - 1]; } \
            if (TYPE == 0) { const float o0 = __shfl_xor(lg0[NTK - 1], 32), o1 = __shfl_xor(lg1[NTK - 1], 32);       \
                if (th) { _Pragma("unroll") for (int jj = 0; jj < NTK; ++jj) { lg0[jj] += o0; lg1[jj] += o1; } } \
                else { vtot[g * 128 + 2 * ck] = lg0[NTK - 1] + o0; vtot[g * 128 + 2 * ck + 1] = lg1[NTK - 1] + o1; } } \
            else { vtot[g * 128 + 2 * ck] = lg0[NTK - 1]; vtot[g * 128 + 2 * ck + 1] = lg1[NTK - 1]; } \
        } } while (0)
#define PC_A2(cc) do { \
        if (kact) { \
            float base0 = 0.f, base1 = 0.f, ref0 = 0.f, ref1 = 0.f, end0 = 0.f, end1 = 0.f; \
            _Pragma("unroll") for (int gg = 0; gg < 8; ++gg) { const float t0 = vtot[gg * 128 + 2 * ck], t1 = vtot[gg * 128 + 2 * ck + 1]; \
                if (gg < g) { base0 += t0; base1 += t1; } if (gg < 4) { ref0 += t0; ref1 += t1; } end0 += t0; end1 += t1; } \
            float kt0[8], kt1[8]; \
            _Pragma("unroll") for (int jj = 0; jj < NTK; ++jj) { const float G0 = base0 + lg0[jj], G1 = base1 + lg1[jj]; \
                kt0[jj] = kk0[jj] * fexp(fminf(ref0 - G0, 80.f)); kt1[jj] = kk1[jj] * fexp(fminf(ref1 - G1, 80.f)); \
                if (OUT) { *(LAS unsigned*)(lds + L_QT + offp<PQ>(8 * g + NTK * th + jj, 4 * ck)) = cvtpk(lo2f(rq[jj]) * qscale * fexp(fminf(G0 - ref0, 80.f)), hi2f(rq[jj]) * qscale * fexp(fminf(G1 - ref1, 80.f))); \
                           *(LAS unsigned*)(lds + L_KT + offp<PQ>(8 * g + NTK * th + jj, 4 * ck)) = cvtpk(kt0[jj], kt1[jj]); } } \
            if (TYPE == 0) { u32x2v t2; \
                t2.x = cvtpk(kt0[0], kt0[1]); t2.y = cvtpk(kt0[2], kt0[3]); *(LAS u32x2v*)(lds + L_KTT + sw64(2 * ck, 16 * g + 8 * th)) = t2; \
                t2.x = cvtpk(kt1[0], kt1[1]); t2.y = cvtpk(kt1[2], kt1[3]); *(LAS u32x2v*)(lds + L_KTT + sw64(2 * ck + 1, 16 * g + 8 * th)) = t2; \
            } else { u32x4v t; \
                t.x = cvtpk(kt0[0], kt0[1]); t.y = cvtpk(kt0[2], kt0[3]); t.z = cvtpk(kt0[4], kt0[5]); t.w = cvtpk(kt0[6], kt0[7]); *(LAS u32x4v*)(lds + L_KTT + (2 * ck) * 128 + ((g ^ (ck & 7)) << 4)) = t; \
                t.x = cvtpk(kt1[0], kt1[1]); t.y = cvtpk(kt1[2], kt1[3]); t.z = cvtpk(kt1[4], kt1[5]); t.w = cvtpk(kt1[6], kt1[7]); *(LAS u32x4v*)(lds + L_KTT + (2 * ck + 1) * 128 + ((g ^ (ck & 7)) << 4)) = t; } \
            if (g == 0 && th == 0) { vpre[2 * ck] = fexp(ref0); vpre[2 * ck + 1] = fexp(ref1); vpost[2 * ck] = fexp(end0 - ref0); vpost[2 * ck + 1] = fexp(end1 - ref1); gsum0 += end0; gsum1 += end1; } \
        } \
        { u32x4v t; \
          t.x = (rv[0] & 0xffffu) | (rv[1] << 16); t.y = (rv[2] & 0xffffu) | (rv[3] << 16); t.z = (rv[4] & 0xffffu) | (rv[5] << 16); t.w = (rv[6] & 0xffffu) | (rv[7] << 16); \
          *(LAS u32x4v*)(lds + L_VT + (2 * cp) * 128 + ((g ^ (cp & 7)) << 4)) = t; \
          t.x = (rv[0] >> 16) | (rv[1] & 0xffff0000u); t.y = (rv[2] >> 16) | (rv[3] & 0xffff0000u); t.z = (rv[4] >> 16) | (rv[5] & 0xffff0000u); t.w = (rv[6] >> 16) | (rv[7] & 0xffff0000u); \
          *(LAS u32x4v*)(lds + L_VT + (2 * cp + 1) * 128 + ((g ^ (cp & 7)) << 4)) = t; } \
        if ((cc) + 1 < NCH) PC_LOAD((cc) + 1); } while (0)
    PC_A1();
    __syncthreads();
    PC_A2(0);
    __syncthreads();
    for (int c = 0; c < NCH; ++c) {
        const size_t rowc = (size_t)b * SEQ + (size_t)s * SEGL + (size_t)c * CH;
        bf16* zp = proj + (rowc + ei) * PP + ZCOL + 16 * ecc;
        u32x4v za = (u32x4v){0u, 0u, 0u, 0u}, zb = za;
        if (OUT) { za = *(const u32x4v*)zp; zb = *(const u32x4v*)(zp + 8); }
#pragma unroll
        for (int dt = 0; dt < NDT; ++dt) { const f32x4 p4 = *(const LAS f32x4*)(vpre + 16 * dt + 4 * qd); S[dt] = S[dt] * p4;
            if (OUT) *(LAS u32x2v*)(lds + L_ST + offp<PQ>(16 * w + r, (16 * dt + 4 * qd) * 2)) = pack4(S[dt]); }
        if (OUT) {
            const int it = w & 3;
#pragma unroll
            for (int j2 = 0; j2 < 2; ++j2) { const int jt = 2 * (w >> 2) + j2; f32x4 acc = (f32x4){0.f, 0.f, 0.f, 0.f};
                if (jt <= it) {
#pragma unroll
                    for (int ks = 0; ks < NKS; ++ks) acc = MFMA16(fragp<PQ>(lds + L_KT, 16 * jt + r, ks, qd), fragp<PQ>(lds + L_QT, 16 * it + r, ks, qd), acc);
                    if (jt == it) {
#pragma unroll
                        for (int rg = 0; rg < 4; ++rg) if (4 * qd + rg > r) acc[rg] = 0.f; }
                }
                *(LAS u32x2v*)(lds + L_PM + sw64(16 * it + r, (16 * jt + 4 * qd) * 2)) = pack4(acc); }
            __syncthreads();
        }
        f32x4 o[4];
        if (OUT) {
#pragma unroll
            for (int it = 0; it < 4; ++it) { o[it] = (f32x4){0.f, 0.f, 0.f, 0.f};
#pragma unroll
                for (int ks = 0; ks < 2; ++ks) if (ks == 0 || it >= 2) o[it] = MFMA16(frag64(lds + L_VT, 16 * w + r, ks, qd), frag64(lds + L_PM, 16 * it + r, ks, qd), o[it]);
#pragma unroll
                for (int ks = 0; ks < NKS; ++ks) o[it] = MFMA16(fragp<PQ>(lds + L_ST, 16 * w + r, ks, qd), fragp<PQ>(lds + L_QT, 16 * it + r, ks, qd), o[it]); }
        }
#pragma unroll
        for (int dt = 0; dt < NDT; ++dt) {
#pragma unroll
            for (int ks = 0; ks < 2; ++ks) S[dt] = MFMA16(frag64(lds + L_KTT, 16 * dt + r, ks, qd), frag64(lds + L_VT, 16 * w + r, ks, qd), S[dt]);
            const f32x4 q4 = *(const LAS f32x4*)(vpost + 16 * dt + 4 * qd); S[dt] = S[dt] * q4; }
        if (c + 1 < NCH) PC_A1();
        if (OUT) {
#pragma unroll
            for (int it = 0; it < 4; ++it) *(LAS u32x2v*)(lds + L_OB + (16 * it + r) * 272 + (16 * w + 4 * qd) * 2) = pack4(o[it]);
        }
        __syncthreads();
        if (c + 1 < NCH) PC_A2(c + 1);
        if (OUT) {
            const u32x4v oa = *(const LAS u32x4v*)(lds + L_OB + ei * 272 + ecc * 32), ob = *(const LAS u32x4v*)(lds + L_OB + ei * 272 + ecc * 32 + 16);
            float ov[16] = {lo2f(oa.x), hi2f(oa.x), lo2f(oa.y), hi2f(oa.y), lo2f(oa.z), hi2f(oa.z), lo2f(oa.w), hi2f(oa.w), lo2f(ob.x), hi2f(ob.x), lo2f(ob.y), hi2f(ob.y), lo2f(ob.z), hi2f(ob.z), lo2f(ob.w), hi2f(ob.w)};
            float ss = 0.f;
#pragma unroll
            for (int k = 0; k < 16; ++k) ss += ov[k] * ov[k];
            ss += __shfl_xor(ss, 1); ss += __shfl_xor(ss, 2); ss += __shfl_xor(ss, 4);
            const float rs = frsq(ss * (1.0f / 128.0f) + EPS);
            const float zv[16] = {lo2f(za.x), hi2f(za.x), lo2f(za.y), hi2f(za.y), lo2f(za.z), hi2f(za.z), lo2f(za.w), hi2f(za.w), lo2f(zb.x), hi2f(zb.x), lo2f(zb.y), hi2f(zb.y), lo2f(zb.z), hi2f(zb.z), lo2f(zb.w), hi2f(zb.w)};
            float y[16];
#pragma unroll
            for (int k = 0; k < 16; ++k) y[k] = ov[k] * rs * nw[k] * fsilu(zv[k]);
            u32x4v ya, yb; ya.x = cvtpk(y[0], y[1]); ya.y = cvtpk(y[2], y[3]); ya.z = cvtpk(y[4], y[5]); ya.w = cvtpk(y[6], y[7]); yb.x = cvtpk(y[8], y[9]); yb.y = cvtpk(y[10], y[11]); yb.z = cvtpk(y[12], y[13]); yb.w = cvtpk(y[14], y[15]);
            if (DRY) { asm volatile("" :: "v"(ya.x), "v"(ya.y), "v"(ya.z), "v"(ya.w), "v"(yb.x), "v"(yb.y), "v"(yb.z), "v"(yb.w)); } else { *(u32x4v*)zp = ya; *(u32x4v*)(zp + 8) = yb; }
        }
        __syncthreads();
    }
    if (!OUT) {
        bf16* sb = stbase + (size_t)idx * (DK * 128);
#pragma unroll
        for (int dt = 0; dt < NDT; ++dt) st_wt(sb + ((size_t)(w * NDT + dt) * 64 + lane) * 4, pack4(S[dt]));
        if (g == 0 && th == 0) { st_wt_f(dsbase + (size_t)idx * DK + 2 * ck, fexp(gsum0)); st_wt_f(dsbase + (size_t)idx * DK + 2 * ck + 1, fexp(gsum1)); }
        publish_item(flag_ptr(P, (TYPE == 0) ? FLAG_GLA : FLAG_HG, idx), (unsigned)l + 1u);
    }
    __syncthreads();
#undef PC_LOAD
#undef PC_A1
#undef PC_A2
}

template <int TYPE>
__device__ __forceinline__ void pc_pass1(KP P, int l, int b, int h, int s, LAS unsigned char* lds) {
    if (s == NSEG - 1) return;
    constexpr int DK = (TYPE == 0) ? 64 : 128, NDT = DK / 16;
    const int tid = opaque_tid(), lane = tid & 63, w = __builtin_amdgcn_readfirstlane(tid >> 6), r = lane & 15, qd = lane >> 4;
    const int cp = lane, g = w;
    constexpr int NTK = (TYPE == 0) ? 4 : 8;
    const int ck = (TYPE == 0) ? (lane & 31) : lane, th = (TYPE == 0) ? (lane >> 5) : 0;
    bf16* proj = (bf16*)(P->ws + WS_PROJ);
    const int KCOL = (TYPE == 0) ? AKc(h) : CFc(h), VCOL = (TYPE == 0) ? AVc(h) : CIc(h);
    const int idx = (b * 4 + h) * NSEG + s;
    bf16* stbase = (bf16*)((unsigned char*)P->out + DO_STATE) + ((TYPE == 0) ? ST_GLA : ST_HGRN);
    float* dsbase = (float*)(P->ws + WS_MISC) + ((TYPE == 0) ? DS_GLA : DS_HGRN);
    float lb0 = 0.f, lb1 = 0.f, gb0 = 0.f, gb1 = 0.f, gw0[16], gw1[16];
#pragma unroll
    for (int rr = 0; rr < 16; ++rr) { gw0[rr] = 0.f; gw1[rr] = 0.f; }
    if (TYPE == 2) {
#pragma unroll
        for (int c2 = 0; c2 < 2; ++c2) { const int ch = h * 128 + 2 * ck + c2;
            float mx_ = -1e30f; for (int i = 0; i < DEPTH; ++i) mx_ = fmaxf(mx_, P->hg_lb[i * 512 + ch]);
            float den = 0.f, num = 0.f; for (int i = 0; i < DEPTH; ++i) { const float e = fexp(P->hg_lb[i * 512 + ch] - mx_); den += e; if (i >= 1 && i <= l) num += e; }
            if (c2 == 0) lb0 = num / den; else lb1 = num / den; }
    } else {
#pragma unroll
        for (int rr = 0; rr < 16; ++rr) { gw0[rr] = P->gla_gate_w[((size_t)l * 16 + rr) * 256 + h * 64 + 2 * ck]; gw1[rr] = P->gla_gate_w[((size_t)l * 16 + rr) * 256 + h * 64 + 2 * ck + 1]; }
        gb0 = P->gla_gate_b[l * 256 + h * 64 + 2 * ck]; gb1 = P->gla_gate_b[l * 256 + h * 64 + 2 * ck + 1];
    }
    f32x4 S[NDT];
#pragma unroll
    for (int dt = 0; dt < NDT; ++dt) S[dt] = (f32x4){0.f, 0.f, 0.f, 0.f};
    float gsum0 = 0.f, gsum1 = 0.f;
#define P1_KTT(par) ((par) ? L_ST : L_KTT)
#define P1_VT(par) ((par) ? L_ST + 16384 : L_VT)
#define P1_TOT(par) ((LAS float*)(lds + ((par) ? L_QT : L_VEC + V_TOT)))
#define P1_PRE(par) ((LAS float*)(lds + ((par) ? L_QT + 4096 : L_VEC + V_PRE)))
#define P1_POST(par) ((LAS float*)(lds + ((par) ? L_QT + 4608 : L_VEC + V_POST)))
    unsigned rk[8], rv[2][8]; f32x4 grv = (f32x4){0.f, 0.f, 0.f, 0.f};
    float lg0[8], lg1[8], kk0[8], kk1[8];
#define P1_LOAD(cc, par) do { const size_t rw_ = (size_t)b * SEQ + (size_t)s * SEGL + (size_t)(cc) * CH + 8 * g; \
        _Pragma("unroll") for (int jj = 0; jj < 8; ++jj) rv[par][jj] = *(const unsigned*)(proj + (rw_ + jj) * PP + VCOL + 2 * cp); \
        _Pragma("unroll") for (int jj = 0; jj < NTK; ++jj) rk[jj] = *(const unsigned*)(proj + (rw_ + NTK * th + jj) * PP + KCOL + 2 * ck); \
        if (TYPE == 0) { if (lane < 32) grv = *(const f32x4*)((const float*)(P->ws + WS_GATES) + (rw_ + (lane >> 2)) * 32 + G_GR + (lane & 3) * 4); } } while (0)
#define P1_A1(par) do { LAS float* vtot_ = P1_TOT(par); \
        if (TYPE == 0) { if (lane < 32) *(LAS f32x4*)((LAS float*)(lds + L_VEC + V_MISC) + g * 128 + (lane >> 2) * 16 + (lane & 3) * 4) = grv; } \
        if (TYPE == 2) { \
            _Pragma("unroll") for (int jj = 0; jj < 8; ++jj) { const float f0 = lo2f(rk[jj]), f1 = hi2f(rk[jj]); \
                const float s0 = fsigmoid(f0), s1 = fsigmoid(f1); \
                lg0[jj] = flog(fmaxf(lb0 + (1.f - lb0) * s0, 1e-30f)); lg1[jj] = flog(fmaxf(lb1 + (1.f - lb1) * s1, 1e-30f)); \
                kk0[jj] = (1.f - lb0) * (1.f - s0); kk1[jj] = (1.f - lb1) * (1.f - s1); } \
        } else { \
            LAS float* vgr = (LAS float*)(lds + L_VEC + V_MISC) + g * 128; \
            _Pragma("unroll") for (int jj = 0; jj < NTK; ++jj) { const LAS f32x4* gr4 = (const LAS f32x4*)(vgr + (NTK * th + jj) * 16); float a0 = gb0, a1 = gb1; \
                _Pragma("unroll") for (int r4 = 0; r4 < 4; ++r4) { const f32x4 x = gr4[r4]; \
                    _Pragma("unroll") for (int e = 0; e < 4; ++e) { a0 += x[e] * gw0[4 * r4 + e]; a1 += x[e] * gw1[4 * r4 + e]; } } \
                lg0[jj] = flogsigmoid(a0) * (1.0f / 16.0f); lg1[jj] = flogsigmoid(a1) * (1.0f / 16.0f); \
                kk0[jj] = lo2f(rk[jj]); kk1[jj] = hi2f(rk[jj]); } \
        } \
        _Pragma("unroll") for (int jj = 1; jj < NTK; ++jj) { lg0[jj] += lg0[jj - 1]; lg1[jj] += lg1[jj - 1]; } \
        if (TYPE == 0) { const float o0 = __shfl_xor(lg0[NTK - 1], 32), o1 = __shfl_xor(lg1[NTK - 1], 32); \
            if (th) { _Pragma("unroll") for (int jj = 0; jj < NTK; ++jj) { lg0[jj] += o0; lg1[jj] += o1; } } \
            else { vtot_[g * 128 + 2 * ck] = lg0[NTK - 1] + o0; vtot_[g * 128 + 2 * ck + 1] = lg1[NTK - 1] + o1; } } \
        else { vtot_[g * 128 + 2 * ck] = lg0[NTK - 1]; vtot_[g * 128 + 2 * ck + 1] = lg1[NTK - 1]; } } while (0)
#define P1_A2(par) do { const LAS float* vtot_ = P1_TOT(par); \
        float base0 = 0.f, base1 = 0.f, ref0 = 0.f, ref1 = 0.f, end0 = 0.f, end1 = 0.f; \
        _Pragma("unroll") for (int gg = 0; gg < 8; ++gg) { const float t0 = vtot_[gg * 128 + 2 * ck], t1 = vtot_[gg * 128 + 2 * ck + 1]; \
            if (gg < g) { base0 += t0; base1 += t1; } if (gg < 4) { ref0 += t0; ref1 += t1; } end0 += t0; end1 += t1; } \
        float kt0[8], kt1[8]; \
        _Pragma("unroll") for (int jj = 0; jj < NTK; ++jj) { const float G0 = base0 + lg0[jj], G1 = base1 + lg1[jj]; \
            kt0[jj] = kk0[jj] * fexp(fminf(ref0 - G0, 80.f)); kt1[jj] = kk1[jj] * fexp(fminf(ref1 - G1, 80.f)); } \
        if (TYPE == 0) { u32x2v t2; \
            t2.x = cvtpk(kt0[0], kt0[1]); t2.y = cvtpk(kt0[2], kt0[3]); *(LAS u32x2v*)(lds + P1_KTT(par) + sw64(2 * ck, 16 * g + 8 * th)) = t2; \
            t2.x = cvtpk(kt1[0], kt1[1]); t2.y = cvtpk(kt1[2], kt1[3]); *(LAS u32x2v*)(lds + P1_KTT(par) + sw64(2 * ck + 1, 16 * g + 8 * th)) = t2; \
        } else { u32x4v t; \
            t.x = cvtpk(kt0[0], kt0[1]); t.y = cvtpk(kt0[2], kt0[3]); t.z = cvtpk(kt0[4], kt0[5]); t.w = cvtpk(kt0[6], kt0[7]); *(LAS u32x4v*)(lds + P1_KTT(par) + (2 * ck) * 128 + ((g ^ (ck & 7)) << 4)) = t; \
            t.x = cvtpk(kt1[0], kt1[1]); t.y = cvtpk(kt1[2], kt1[3]); t.z = cvtpk(kt1[4], kt1[5]); t.w = cvtpk(kt1[6], kt1[7]); *(LAS u32x4v*)(lds + P1_KTT(par) + (2 * ck + 1) * 128 + ((g ^ (ck & 7)) << 4)) = t; } \
        if (g == 0 && th == 0) { LAS float* vpre_ = P1_PRE(par); LAS float* vpost_ = P1_POST(par); \
            vpre_[2 * ck] = fexp(ref0); vpre_[2 * ck + 1] = fexp(ref1); vpost_[2 * ck] = fexp(end0 - ref0); vpost_[2 * ck + 1] = fexp(end1 - ref1); gsum0 += end0; gsum1 += end1; } \
        { u32x4v t; \
          t.x = (rv[par][0] & 0xffffu) | (rv[par][1] << 16); t.y = (rv[par][2] & 0xffffu) | (rv[par][3] << 16); t.z = (rv[par][4] & 0xffffu) | (rv[par][5] << 16); t.w = (rv[par][6] & 0xffffu) | (rv[par][7] << 16); \
          *(LAS u32x4v*)(lds + P1_VT(par) + (2 * cp) * 128 + ((g ^ (cp & 7)) << 4)) = t; \
          t.x = (rv[par][0] >> 16) | (rv[par][1] & 0xffff0000u); t.y = (rv[par][2] >> 16) | (rv[par][3] & 0xffff0000u); t.z = (rv[par][4] >> 16) | (rv[par][5] & 0xffff0000u); t.w = (rv[par][6] >> 16) | (rv[par][7] & 0xffff0000u); \
          *(LAS u32x4v*)(lds + P1_VT(par) + (2 * cp + 1) * 128 + ((g ^ (cp & 7)) << 4)) = t; } } while (0)
#define P1_E(par) do { const LAS float* vpre_ = P1_PRE(par); const LAS float* vpost_ = P1_POST(par); \
        _Pragma("unroll") for (int dt = 0; dt < NDT; ++dt) { const f32x4 p4 = *(const LAS f32x4*)(vpre_ + 16 * dt + 4 * qd); S[dt] = S[dt] * p4; } \
        _Pragma("unroll") for (int dt = 0; dt < NDT; ++dt) { \
            _Pragma("unroll") for (int ks = 0; ks < 2; ++ks) S[dt] = MFMA16(frag64(lds + P1_KTT(par), 16 * dt + r, ks, qd), frag64(lds + P1_VT(par), 16 * w + r, ks, qd), S[dt]); \
            const f32x4 q4 = *(const LAS f32x4*)(vpost_ + 16 * dt + 4 * qd); S[dt] = S[dt] * q4; } } while (0)
    P1_LOAD(0, 0);
    P1_A1(0);
    P1_LOAD(1, 1);
    __syncthreads();
    P1_A2(0);
    P1_A1(1);
    P1_LOAD(2, 0);
    __syncthreads();
    for (int c = 0; c < NCH; c += 2) {
        P1_E(0);
        P1_A2(1);
        if (c + 2 < NCH) P1_A1(0);
        if (c + 3 < NCH) P1_LOAD(c + 3, 1);
        __syncthreads();
        P1_E(1);
        if (c + 2 < NCH) P1_A2(0);
        if (c + 3 < NCH) P1_A1(1);
        if (c + 4 < NCH) P1_LOAD(c + 4, 0);
        __syncthreads();
    }
    {
        bf16* sb = stbase + (size_t)idx * (DK * 128);
#pragma unroll
        for (int dt = 0; dt < NDT; ++dt) st_wt(sb + ((size_t)(w * NDT + dt) * 64 + lane) * 4, pack4(S[dt]));
        if (g == 0 && th == 0) { st_wt_f(dsbase + (size_t)idx * DK + 2 * ck, fexp(gsum0)); st_wt_f(dsbase + (size_t)idx * DK + 2 * ck + 1, fexp(gsum1)); }
        publish_item(flag_ptr(P, (TYPE == 0) ? FLAG_GLA : FLAG_HG, idx), (unsigned)l + 1u);
    }
    __syncthreads();
#undef P1_KTT
#undef P1_VT
#undef P1_TOT
#undef P1_PRE
#undef P1_POST
#undef P1_LOAD
#undef P1_A1
#undef P1_A2
#undef P1_E
}

template <bool OUT, bool DRY = false>
__device__ __forceinline__ void ml_item(KP P, int l, int b, int h, int s, LAS unsigned char* lds) {
    if (!OUT && s == NSEG - 1) return;
    constexpr int PQ = 272;
    const int tid = opaque_tid(), lane = tid & 63, w = __builtin_amdgcn_readfirstlane(tid >> 6), r = lane & 15, qd = lane >> 4;
    const int cp = lane, g = w;
    bf16* proj = (bf16*)(P->ws + WS_PROJ); const float* gts = (const float*)(P->ws + WS_GATES);
    LAS float* vg = (LAS float*)(lds + L_VEC + V_TOT);
    LAS float* vemr = (LAS float*)(lds + L_VEC + V_MISC);
    LAS float* vden = vemr + 64;
    const int idx = (b * 4 + h) * NSEG + s;
    bf16* stbase = (bf16*)((unsigned char*)P->out + DO_STATE) + ST_ML;
    float* dsbase = (float*)(P->ws + WS_MISC) + DS_ML;
    float wq[4][2], wk[4][2], bq[2], bk[2];
#pragma unroll
    for (int c2 = 0; c2 < 2; ++c2) { const int ch = h * 128 + 2 * cp + c2;
#pragma unroll
        for (int kk = 0; kk < 4; ++kk) { wq[kk][c2] = P->ml_conv_w[((size_t)l * 4 + kk) * 1024 + ch]; wk[kk][c2] = P->ml_conv_w[((size_t)l * 4 + kk) * 1024 + 512 + ch]; }
        bq[c2] = P->ml_conv_b[l * 1024 + ch]; bk[c2] = P->ml_conv_b[l * 1024 + 512 + ch]; }
    const float ib = P->ml_i_b[l * 4 + h], fb = P->ml_f_b[l * 4 + h];
    unsigned rq[11], rk[11], rv[8]; float gpre = 0.f;
#define ML_LOAD(cc) do { const size_t rw_ = (size_t)b * SEQ + (size_t)s * SEGL + (size_t)(cc) * CH + 8 * g; const int ts_ = s * SEGL + (cc) * CH + 8 * g; \
        _Pragma("unroll") for (int jj = 0; jj < 11; ++jj) { const bool ok = (ts_ + jj - 3) >= 0; const bf16* pr = proj + (rw_ + jj - 3) * PP; \
            rk[jj] = ok ? *(const unsigned*)(pr + BKc(h) + 2 * cp) : 0u; rq[jj] = (ok && OUT) ? *(const unsigned*)(pr + BQc(h) + 2 * cp) : 0u; } \
        _Pragma("unroll") for (int jj = 0; jj < 8; ++jj) rv[jj] = *(const unsigned*)(proj + (rw_ + jj) * PP + BVc(h) + 2 * cp); \
        if (lane < 16) gpre = gts[(rw_ + (lane >> 1)) * 32 + ((lane & 1) ? G_BF : G_BI) + h]; } while (0)
    ML_LOAD(0);
    f32x4 S[8], Sx = (f32x4){0.f, 0.f, 0.f, 0.f};
#pragma unroll
    for (int dt = 0; dt < 8; ++dt) S[dt] = (f32x4){0.f, 0.f, 0.f, 0.f};
    float m = 0.f, bsum = 0.f;
    if (OUT) {
        wait_predecessors(flag_ptr(P, FLAG_ML, idx - s), s, (unsigned)l + 1u);
        LAS float* vds = (LAS float*)(lds + L_QT);
        for (int i = tid; i < s * 4; i += 512) vds[i] = dsbase[(size_t)(idx - s) * 4 + i];
        __syncthreads();
        for (int sp0 = 0; sp0 < s; sp0 += 4) {
            u32x2v raw[4][9];
#pragma unroll
            for (int u = 0; u < 4; ++u) { const int sp = (sp0 + u < s) ? sp0 + u : s - 1; const bf16* sb = stbase + (size_t)(idx - s + sp) * 18432;
#pragma unroll
                for (int dt = 0; dt < 9; ++dt) raw[u][dt] = *(const u32x2v*)(sb + ((size_t)(w * 9 + dt) * 64 + lane) * 4); }
#pragma unroll
            for (int u = 0; u < 4; ++u) if (sp0 + u < s) {
                const float ml_ = vds[(sp0 + u) * 4], bs = vds[(sp0 + u) * 4 + 1];
                const float mn = fmaxf(bs + m, ml_), f1 = fexp(bs + m - mn), f2 = fexp(ml_ - mn); m = mn;
#pragma unroll
                for (int dt = 0; dt < 9; ++dt) { const f32x4 ds = (f32x4){lo2f(raw[u][dt].x), hi2f(raw[u][dt].x), lo2f(raw[u][dt].y), hi2f(raw[u][dt].y)};
                    if (dt < 8) S[dt] = S[dt] * f1 + ds * f2; else Sx = Sx * f1 + ds * f2; } }
        }
        __syncthreads();
    }
    if (tid < 128) { const int rr = tid >> 3, ck = tid & 7; const unsigned one2 = (rr == 0) ? 0x3f803f80u : 0u; u32x4v t; t.x = one2; t.y = one2; t.z = one2; t.w = one2; *(LAS u32x4v*)(lds + L_VT + (128 + rr) * 128 + 16 * ck) = t; }
    const int ei = tid >> 3, ecc = tid & 7;
    float nw[16];
#pragma unroll
    for (int k = 0; k < 16; ++k) nw[k] = OUT ? P->ml_norm_w[l * 512 + h * 128 + 16 * ecc + k] : 0.f;

    for (int c = 0; c < NCH; ++c) {
        const size_t rowc = (size_t)b * SEQ + (size_t)s * SEGL + (size_t)c * CH;
        float ig[8], bl[8];
        const float gval = (lane & 1) ? flogsigmoid(gpre + fb) : gpre + ib;
#pragma unroll
        for (int jj = 0; jj < 8; ++jj) { ig[jj] = __int_as_float(__builtin_amdgcn_readlane(__float_as_int(gval), 2 * jj)); bl[jj] = __int_as_float(__builtin_amdgcn_readlane(__float_as_int(gval), 2 * jj + 1)); }
#pragma unroll
        for (int jj = 1; jj < 8; ++jj) bl[jj] += bl[jj - 1];
        float lpm[8];
        lpm[0] = ig[0] - bl[0];
#pragma unroll
        for (int jj = 1; jj < 8; ++jj) lpm[jj] = fmaxf(lpm[jj - 1], ig[jj] - bl[jj]);
        if (lane == 0) { vg[g] = bl[7]; vg[8 + g] = lpm[7]; }
        __syncthreads();
        float base = 0.f, cmprev = -1e30f, blast = 0.f, M = m;
#pragma unroll
        for (int gg = 0; gg < 8; ++gg) { const float t = vg[gg], lm = vg[8 + gg]; const float ag = lm - blast;
            if (gg < g) cmprev = fmaxf(cmprev, ag); M = fmaxf(M, ag); if (gg < g) base += t; blast += t; }
        float kt0[8], kt1[8];
#pragma unroll
        for (int jj = 0; jj < 8; ++jj) {
            const float bj = base + bl[jj]; const float cmj = fmaxf(cmprev, lpm[jj] - base); const float mu = fmaxf(cmj, m);
            const float ek = fexp(ig[jj] - bj - M), eq = fexp(M - mu);
            float yk0 = bk[0], yk1 = bk[1], yq0 = bq[0], yq1 = bq[1];
#pragma unroll
            for (int kk = 0; kk < 4; ++kk) { yk0 += wk[kk][0] * lo2f(rk[jj + kk]); yk1 += wk[kk][1] * hi2f(rk[jj + kk]); yq0 += wq[kk][0] * lo2f(rq[jj + kk]); yq1 += wq[kk][1] * hi2f(rq[jj + kk]); }
            kt0[jj] = fsilu(yk0) * 0.08838834764831845f * ek; kt1[jj] = fsilu(yk1) * 0.08838834764831845f * ek;
            if (OUT) { *(LAS unsigned*)(lds + L_QT + (8 * g + jj) * PQ + 4 * cp) = cvtpk(fsilu(yq0) * eq, fsilu(yq1) * eq);
                       *(LAS unsigned*)(lds + L_KT + (8 * g + jj) * PQ + 4 * cp) = cvtpk(kt0[jj], kt1[jj]);
                       if (lane == 0) vemr[8 * g + jj] = fexp(-bj - mu); } }
        { u32x4v t;
          t.x = cvtpk(kt0[0], kt0[1]); t.y = cvtpk(kt0[2], kt0[3]); t.z = cvtpk(kt0[4], kt0[5]); t.w = cvtpk(kt0[6], kt0[7]); *(LAS u32x4v*)(lds + L_KTT + (2 * cp) * 128 + ((g ^ (cp & 7)) << 4)) = t;
          t.x = cvtpk(kt1[0], kt1[1]); t.y = cvtpk(kt1[2], kt1[3]); t.z = cvtpk(kt1[4], kt1[5]); t.w = cvtpk(kt1[6], kt1[7]); *(LAS u32x4v*)(lds + L_KTT + (2 * cp + 1) * 128 + ((g ^ (cp & 7)) << 4)) = t;
          t.x = (rv[0] & 0xffffu) | (rv[1] << 16); t.y = (rv[2] & 0xffffu) | (rv[3] << 16); t.z = (rv[4] & 0xffffu) | (rv[5] << 16); t.w = (rv[6] & 0xffffu) | (rv[7] << 16);
          *(LAS u32x4v*)(lds + L_VT + (2 * cp) * 128 + ((g ^ (cp & 7)) << 4)) = t;
          t.x = (rv[0] >> 16) | (rv[1] & 0xffff0000u); t.y = (rv[2] >> 16) | (rv[3] & 0xffff0000u); t.z = (rv[4] >> 16) | (rv[5] & 0xffff0000u); t.w = (rv[6] >> 16) | (rv[7] & 0xffff0000u);
          *(LAS u32x4v*)(lds + L_VT + (2 * cp + 1) * 128 + ((g ^ (cp & 7)) << 4)) = t; }
        const float pre = fexp(m - M);
        m = blast + M; bsum += blast;
        if (c + 1 < NCH) ML_LOAD(c + 1);
        __syncthreads();
        bf16* zp = proj + (rowc + ei) * PP + ZB + h * 128 + 16 * ecc; const bf16* gp = proj + (rowc + ei) * PP + BOc(h) + 16 * ecc;
        u32x4v za = (u32x4v){0u, 0u, 0u, 0u}, zb = za, ga = za, gb_ = za;
        if (OUT) { za = *(const u32x4v*)zp; zb = *(const u32x4v*)(zp + 8); ga = *(const u32x4v*)gp; gb_ = *(const u32x4v*)(gp + 8); }
#pragma unroll
        for (int dt = 0; dt < 8; ++dt) { S[dt] = S[dt] * pre; if (OUT) *(LAS u32x2v*)(lds + L_ST + (16 * w + r) * PQ + (16 * dt + 4 * qd) * 2) = pack4(S[dt]); }
        Sx = Sx * pre; if (OUT) *(LAS u32x2v*)(lds + L_ST + (128 + r) * PQ + (16 * w + 4 * qd) * 2) = pack4(Sx);
        if (OUT) {
            const int it = w & 3;
#pragma unroll
            for (int j2 = 0; j2 < 2; ++j2) { const int jt = 2 * (w >> 2) + j2; f32x4 acc = (f32x4){0.f, 0.f, 0.f, 0.f};
                if (jt <= it) {
#pragma unroll
                    for (int ks = 0; ks < 4; ++ks) acc = MFMA16(frag(lds + L_KT, 16 * jt + r, PQ, ks, qd), frag(lds + L_QT, 16 * it + r, PQ, ks, qd), acc);
                    if (jt == it) {
#pragma unroll
                        for (int rg = 0; rg < 4; ++rg) if (4 * qd + rg > r) acc[rg] = 0.f; }
                }
                *(LAS u32x2v*)(lds + L_PM + sw64(16 * it + r, (16 * jt + 4 * qd) * 2)) = pack4(acc); }
            __syncthreads();
        }
        f32x4 o[4], ox = (f32x4){0.f, 0.f, 0.f, 0.f};
        if (OUT) {
#pragma unroll
            for (int it = 0; it < 4; ++it) { o[it] = (f32x4){0.f, 0.f, 0.f, 0.f};
#pragma unroll
                for (int ks = 0; ks < 2; ++ks) if (ks == 0 || it >= 2) o[it] = MFMA16(frag64(lds + L_VT, 16 * w + r, ks, qd), frag64(lds + L_PM, 16 * it + r, ks, qd), o[it]);
#pragma unroll
                for (int ks = 0; ks < 4; ++ks) o[it] = MFMA16(frag(lds + L_ST, 16 * w + r, PQ, ks, qd), frag(lds + L_QT, 16 * it + r, PQ, ks, qd), o[it]); }
            const int itx = w & 3;
#pragma unroll
            for (int ks = 0; ks < 2; ++ks) ox = MFMA16(frag64(lds + L_VT, 128 + r, ks, qd), frag64(lds + L_PM, 16 * itx + r, ks, qd), ox);
#pragma unroll
            for (int ks = 0; ks < 4; ++ks) ox = MFMA16(frag(lds + L_ST, 128 + r, PQ, ks, qd), frag(lds + L_QT, 16 * itx + r, PQ, ks, qd), ox);
            if (w < 4 && qd == 0) vden[16 * itx + r] = ox[0];
        }
#pragma unroll
        for (int dt = 0; dt < 8; ++dt)
#pragma unroll
            for (int ks = 0; ks < 2; ++ks) S[dt] = MFMA16(frag64(lds + L_KTT, 16 * dt + r, ks, qd), frag64(lds + L_VT, 16 * w + r, ks, qd), S[dt]);
#pragma unroll
        for (int ks = 0; ks < 2; ++ks) Sx = MFMA16(frag64(lds + L_KTT, 16 * w + r, ks, qd), frag64(lds + L_VT, 128 + r, ks, qd), Sx);
        if (OUT) {
#pragma unroll
            for (int it = 0; it < 4; ++it) *(LAS u32x2v*)(lds + L_KT + (16 * it + r) * 272 + (16 * w + 4 * qd) * 2) = pack4(o[it]);
            __syncthreads();
            const u32x4v oa = *(const LAS u32x4v*)(lds + L_KT + ei * 272 + ecc * 32), ob = *(const LAS u32x4v*)(lds + L_KT + ei * 272 + ecc * 32 + 16);
            float ov[16] = {lo2f(oa.x), hi2f(oa.x), lo2f(oa.y), hi2f(oa.y), lo2f(oa.z), hi2f(oa.z), lo2f(oa.w), hi2f(oa.w), lo2f(ob.x), hi2f(ob.x), lo2f(ob.y), hi2f(ob.y), lo2f(ob.z), hi2f(ob.z), lo2f(ob.w), hi2f(ob.w)};
            const float dinv = frcp(fmaxf(fabsf(vden[ei]), vemr[ei]));
            const float zv[16] = {lo2f(za.x), hi2f(za.x), lo2f(za.y), hi2f(za.y), lo2f(za.z), hi2f(za.z), lo2f(za.w), hi2f(za.w), lo2f(zb.x), hi2f(zb.x), lo2f(zb.y), hi2f(zb.y), lo2f(zb.z), hi2f(zb.z), lo2f(zb.w), hi2f(zb.w)};
            const float gv[16] = {lo2f(ga.x), hi2f(ga.x), lo2f(ga.y), hi2f(ga.y), lo2f(ga.z), hi2f(ga.z), lo2f(ga.w), hi2f(ga.w), lo2f(gb_.x), hi2f(gb_.x), lo2f(gb_.y), hi2f(gb_.y), lo2f(gb_.z), hi2f(gb_.z), lo2f(gb_.w), hi2f(gb_.w)};
            float ss = 0.f;
#pragma unroll
            for (int k = 0; k < 16; ++k) { ov[k] = ov[k] * dinv * fsigmoid(gv[k]); ss += ov[k] * ov[k]; }
            ss += __shfl_xor(ss, 1); ss += __shfl_xor(ss, 2); ss += __shfl_xor(ss, 4);
            const float rs = frsq(ss * (1.0f / 128.0f) + EPS);
            float y[16];
#pragma unroll
            for (int k = 0; k < 16; ++k) y[k] = ov[k] * rs * nw[k] * fsilu(zv[k]);
            u32x4v ya, yb; ya.x = cvtpk(y[0], y[1]); ya.y = cvtpk(y[2], y[3]); ya.z = cvtpk(y[4], y[5]); ya.w = cvtpk(y[6], y[7]); yb.x = cvtpk(y[8], y[9]); yb.y = cvtpk(y[10], y[11]); yb.z = cvtpk(y[12], y[13]); yb.w = cvtpk(y[14], y[15]);
            if (DRY) { asm volatile("" :: "v"(ya.x), "v"(ya.y), "v"(ya.z), "v"(ya.w), "v"(yb.x), "v"(yb.y), "v"(yb.z), "v"(yb.w)); } else { *(u32x4v*)zp = ya; *(u32x4v*)(zp + 8) = yb; }
        }
    }
    if (!OUT) {
        bf16* sb = stbase + (size_t)idx * 18432;
#pragma unroll
        for (int dt = 0; dt < 8; ++dt) st_wt(sb + ((size_t)(w * 9 + dt) * 64 + lane) * 4, pack4(S[dt]));
        st_wt(sb + ((size_t)(w * 9 + 8) * 64 + lane) * 4, pack4(Sx));
        if (tid == 0) { st_wt_f(dsbase + (size_t)idx * 4, m); st_wt_f(dsbase + (size_t)idx * 4 + 1, bsum); }
        publish_item(flag_ptr(P, FLAG_ML, idx), (unsigned)l + 1u);
    }
    __syncthreads();
#undef ML_LOAD
}

template <bool OUT, bool DRY = false>
__device__ __forceinline__ void ssd_item(KP P, int l, int b, int gq, int s, LAS unsigned char* lds) {
    constexpr int PQ = 272;
    const int tid = opaque_tid(), lane = tid & 63, w = __builtin_amdgcn_readfirstlane(tid >> 6);
    const int g = w, hsub = lane >> 5;
    bf16* proj = (bf16*)(P->ws + WS_PROJ); const float* gts = (const float*)(P->ws + WS_GATES);
    LAS float* vg = (LAS float*)(lds + L_VEC + V_TOT);
    LAS float* vaend = vg + 32;
    LAS float* vacs = (LAS float*)(lds + L_VEC + 256);
    LAS float* veacs = vacs + 256;
    LAS float* vdti = veacs + 256;
    LAS float* vcw = (LAS float*)(lds + L_VEC + 3328);
    const int idx = (b * 2 + gq) * NSEG + s;
    bf16* stbase = (bf16*)((unsigned char*)P->out + DO_STATE) + ST_SSD;
    float* dsbase = (float*)(P->ws + WS_MISC) + DS_SSD;
    { const int cp = lane; (void)cp; const int ch = tid;
      const int src = (ch < 128) ? 512 + gq * 128 + ch : (ch < 256) ? 768 + gq * 128 + (ch - 128) : gq * 256 + (ch - 256);
#pragma unroll
      for (int kk = 0; kk < 4; ++kk) vcw[ch * 5 + kk] = P->ssd_conv_w[((size_t)l * 4 + kk) * 1024 + src];
      vcw[ch * 5 + 4] = P->ssd_conv_b[l * 1024 + src]; }
    const int qd0 = lane >> 4, r0 = lane & 15; (void)qd0; (void)r0;
    float dtb[2], An[2], iAn[2];
#pragma unroll
    for (int k = 0; k < 2; ++k) { const int hh = gq * 4 + 2 * k + hsub; dtb[k] = P->ssd_dt_bias[l * 8 + hh]; An[k] = -fexp(P->ssd_A_log[l * 8 + hh]); iAn[k] = 1.0f / An[k]; }
    const float dtb_l = P->ssd_dt_bias[l * 8 + gq * 4 + (lane & 3)], An_l = -fexp(P->ssd_A_log[l * 8 + gq * 4 + (lane & 3)]);
    const int hw0 = (w >> 2), hw1 = 2 + (w >> 2);
    const float Dh[2][2] = {{P->ssd_D[l * 8 + gq * 4 + 0], P->ssd_D[l * 8 + gq * 4 + 1]}, {P->ssd_D[l * 8 + gq * 4 + 2], P->ssd_D[l * 8 + gq * 4 + 3]}};
    f32x4 S[2][8];
#pragma unroll
    for (int R = 0; R < 2; ++R)
#pragma unroll
        for (int dt = 0; dt < 8; ++dt) S[R][dt] = (f32x4){0.f, 0.f, 0.f, 0.f};
    if (OUT) {
        wait_predecessors(flag_ptr(P, FLAG_SSD, idx - s), s, (unsigned)l + 1u);
        LAS float* vds = (LAS float*)(lds + L_QT);
        for (int i = tid; i < s * 4; i += 512) vds[i] = dsbase[(size_t)(idx - s) * 4 + i];
        __syncthreads();
        for (int sp0 = 0; sp0 < s; sp0 += 2) {
            u32x2v raw[2][16];
#pragma unroll
            for (int u = 0; u < 2; ++u) { const int sp = (sp0 + u < s) ? sp0 + u : s - 1; const bf16* sb = stbase + (size_t)(idx - s + sp) * 32768;
#pragma unroll
                for (int t = 0; t < 16; ++t) raw[u][t] = *(const u32x2v*)(sb + ((size_t)(w * 16 + t) * 64 + lane) * 4); }
#pragma unroll
            for (int u = 0; u < 2; ++u) if (sp0 + u < s) {
                const float f0 = fexp(vds[(sp0 + u) * 4 + hw0]), f1 = fexp(vds[(sp0 + u) * 4 + hw1]);
#pragma unroll
                for (int R = 0; R < 2; ++R)
#pragma unroll
                    for (int dt = 0; dt < 8; ++dt) { const u32x2v rw = raw[u][R * 8 + dt];
                        const f32x4 ds = (f32x4){lo2f(rw.x), hi2f(rw.x), lo2f(rw.y), hi2f(rw.y)}; S[R][dt] = S[R][dt] * (R == 0 ? f0 : f1) + ds; } }
        }
        __syncthreads();
    }
    float asum[2] = {0.f, 0.f};

    unsigned rC[11], rB[11], rx[2][11]; float gdt = 0.f;
    const bf16* halo = (const bf16*)(P->ws + WS_HALO);
    LAS unsigned* hxch = (LAS unsigned*)(lds + L_ST);
#define SSD_LOAD(cc) do { const int cl_ = opq(lane); const size_t rw_ = (size_t)b * SEQ + (size_t)s * SEGL + (size_t)(cc) * CH + 8 * g; \
        if (OUT) { \
            _Pragma("unroll") for (int jj = 0; jj < 8; ++jj) { const bf16* pr = proj + (rw_ + jj) * PP; \
                rB[jj] = *(const unsigned*)(pr + DBc(gq) + 2 * cl_); rC[jj] = *(const unsigned*)(pr + DCc(gq) + 2 * cl_); \
                rx[0][jj] = *(const unsigned*)(pr + DXc(gq) + 2 * cl_); rx[1][jj] = *(const unsigned*)(pr + DXc(gq) + 128 + 2 * cl_); } \
        } else { \
            _Pragma("unroll") for (int jj = 0; jj < 11; ++jj) { \
                if (jj < 3 && g == 0) {       \
                    if ((cc) == 0) { const bool ok = s > 0; const bf16* hr = halo + ((size_t)((b * NSEG + s - 1) * 3 + jj)) * 1024; \
                        rB[jj] = ok ? *(const unsigned*)(hr + (DBc(gq) - DSSD) + 2 * cl_) : 0u; rC[jj] = ok ? *(const unsigned*)(hr + (DCc(gq) - DSSD) + 2 * cl_) : 0u; \
                        rx[0][jj] = ok ? *(const unsigned*)(hr + (DXc(gq) - DSSD) + 2 * cl_) : 0u; rx[1][jj] = ok ? *(const unsigned*)(hr + (DXc(gq) - DSSD) + 128 + 2 * cl_) : 0u; } \
                } else { const bf16* pr = proj + (rw_ + jj - 3) * PP; \
                    rB[jj] = *(const unsigned*)(pr + DBc(gq) + 2 * cl_); rC[jj] = *(const unsigned*)(pr + DCc(gq) + 2 * cl_); \
                    rx[0][jj] = *(const unsigned*)(pr + DXc(gq) + 2 * cl_); rx[1][jj] = *(const unsigned*)(pr + DXc(gq) + 128 + 2 * cl_); } } \
        } \
        if (cl_ < 32) gdt = gts[(rw_ + (cl_ >> 2)) * 32 + G_DT + gq * 4 + (cl_ & 3)]; } while (0)
    SSD_LOAD(0);
    for (int c = 0; c < NCH; ++c) {
        const size_t rowc = (size_t)b * SEQ + (size_t)s * SEGL + (size_t)c * CH;
        const int cp = opq(lane);
        LAS float* vsl = vacs + (cp >> 5) * 64 + 8 * g;
        const float a_l = fsoftplus(gdt + dtb_l) * An_l;
        float al[2][8];
#pragma unroll
        for (int k = 0; k < 2; ++k) {
#pragma unroll
            for (int jj = 0; jj < 8; ++jj) { const float pa = __int_as_float(__builtin_amdgcn_readlane(__float_as_int(a_l), 4 * jj + 2 * k)), pb = __int_as_float(__builtin_amdgcn_readlane(__float_as_int(a_l), 4 * jj + 2 * k + 1));
                al[k][jj] = hsub ? pb : pa; }
#pragma unroll
            for (int jj = 1; jj < 8; ++jj) al[k][jj] += al[k][jj - 1];
            if ((lane & 31) == 0) vg[(2 * k + hsub) * 8 + g] = al[k][7];
        }
        __syncthreads();
        float base[2] = {0.f, 0.f}, aend[2] = {0.f, 0.f};
#pragma unroll
        for (int k = 0; k < 2; ++k)
#pragma unroll
            for (int gg = 0; gg < 8; ++gg) { const float t = vg[(2 * k + hsub) * 8 + gg]; if (gg < g) base[k] += t; aend[k] += t; }
#define SSD_PUT_T(region, src) do { u32x4v t_; \
          t_.x = (src[0] & 0xffffu) | (src[1] << 16); t_.y = (src[2] & 0xffffu) | (src[3] << 16); t_.z = (src[4] & 0xffffu) | (src[5] << 16); t_.w = (src[6] & 0xffffu) | (src[7] << 16); \
          *(LAS u32x4v*)(lds + (region) + (2 * cp) * 128 + ((g ^ (cp & 7)) << 4)) = t_; \
          t_.x = (src[0] >> 16) | (src[1] & 0xffff0000u); t_.y = (src[2] >> 16) | (src[3] & 0xffff0000u); t_.z = (src[4] >> 16) | (src[5] & 0xffff0000u); t_.w = (src[6] >> 16) | (src[7] & 0xffff0000u); \
          *(LAS u32x4v*)(lds + (region) + (2 * cp + 1) * 128 + ((g ^ (cp & 7)) << 4)) = t_; } while (0)
        unsigned x1a[8], x1s[8];
        unsigned Bp[8], Cp[8], x0p[8];
        if (OUT) {
#pragma unroll
            for (int jj = 0; jj < 8; ++jj) { *(LAS unsigned*)(lds + L_KT + (8 * g + jj) * PQ + 4 * cp) = rB[jj]; *(LAS unsigned*)(lds + L_QT + (8 * g + jj) * PQ + 4 * cp) = rC[jj]; }
            SSD_PUT_T(L_KTT, rB);
            { unsigned x0s[8];
#pragma unroll
              for (int jj = 0; jj < 8; ++jj) { const float a0 = base[0] + al[0][jj]; const float dtj = (al[0][jj] - (jj ? al[0][jj - 1] : 0.f)) * iAn[0], e0 = fexp(aend[0] - a0);
                  x0s[jj] = cvtpk(lo2f(rx[0][jj]) * e0, hi2f(rx[0][jj]) * e0);
                  if ((cp & 31) == 0) { vsl[jj] = a0; vsl[256 + jj] = fexp(a0); vsl[512 + jj] = frcp(dtj); } }
              SSD_PUT_T(L_VVT, x0s); SSD_PUT_T(L_VT, rx[0]); }
#pragma unroll
            for (int jj = 0; jj < 8; ++jj) { const float a1 = base[1] + al[1][jj]; const float dtj = (al[1][jj] - (jj ? al[1][jj - 1] : 0.f)) * iAn[1];
                x1a[jj] = rx[1][jj];
                if ((cp & 31) == 0) { vsl[128 + jj] = a1; vsl[128 + 256 + jj] = fexp(a1); vsl[128 + 512 + jj] = frcp(dtj); } }
        } else {
            LAS unsigned* hw_ = hxch + (c & 1) * 768; LAS unsigned* hr_ = hxch + ((c + 1) & 1) * 768;
            if (g == 7) {
#pragma unroll
                for (int jj = 0; jj < 3; ++jj) { hw_[(0 * 3 + jj) * 64 + cp] = rB[8 + jj]; hw_[(1 * 3 + jj) * 64 + cp] = rC[8 + jj]; hw_[(2 * 3 + jj) * 64 + cp] = rx[0][8 + jj]; hw_[(3 * 3 + jj) * 64 + cp] = rx[1][8 + jj]; } }
            if (g == 0 && c > 0) {
#pragma unroll
                for (int jj = 0; jj < 3; ++jj) { rB[jj] = hr_[(0 * 3 + jj) * 64 + cp]; rC[jj] = hr_[(1 * 3 + jj) * 64 + cp]; rx[0][jj] = hr_[(2 * 3 + jj) * 64 + cp]; rx[1][jj] = hr_[(3 * 3 + jj) * 64 + cp]; } }
#define SSD_TAPS(chan) float w0_[5], w1_[5]; _Pragma("unroll") for (int kk = 0; kk < 5; ++kk) { w0_[kk] = vcw[(chan) * 5 + kk]; w1_[kk] = vcw[((chan) + 1) * 5 + kk]; }
#define SSD_CONV(raw, jj, y0, y1) float y0 = w0_[4], y1 = w1_[4]; _Pragma("unroll") for (int kk = 0; kk < 4; ++kk) { y0 += w0_[kk] * lo2f(raw[jj + kk]); y1 += w1_[kk] * hi2f(raw[jj + kk]); }
            { SSD_TAPS(2 * cp)
#pragma unroll
              for (int jj = 0; jj < 8; ++jj) { SSD_CONV(rB, jj, y0, y1) Bp[jj] = cvtpk(fsilu(y0), fsilu(y1)); }
              SSD_PUT_T(L_KTT, Bp); }
            { SSD_TAPS(128 + 2 * cp)
#pragma unroll
              for (int jj = 0; jj < 8; ++jj) { SSD_CONV(rC, jj, y0, y1) Cp[jj] = cvtpk(fsilu(y0), fsilu(y1)); } }
            { SSD_TAPS(256 + 2 * cp)
              unsigned x0s[8];
#pragma unroll
              for (int jj = 0; jj < 8; ++jj) { SSD_CONV(rx[0], jj, y0, y1) const float a0 = base[0] + al[0][jj]; const float dtj = (al[0][jj] - (jj ? al[0][jj - 1] : 0.f)) * iAn[0], e0 = fexp(aend[0] - a0);
                  x0p[jj] = cvtpk(fsilu(y0) * dtj, fsilu(y1) * dtj); x0s[jj] = cvtpk(lo2f(x0p[jj]) * e0, hi2f(x0p[jj]) * e0); }
              SSD_PUT_T(L_VVT, x0s); }
            { SSD_TAPS(256 + 128 + 2 * cp)
#pragma unroll
              for (int jj = 0; jj < 8; ++jj) { SSD_CONV(rx[1], jj, y0, y1) const float a1 = base[1] + al[1][jj]; const float dtj = (al[1][jj] - (jj ? al[1][jj - 1] : 0.f)) * iAn[1], e1 = fexp(aend[1] - a1);
                  x1a[jj] = cvtpk(fsilu(y0) * dtj, fsilu(y1) * dtj); x1s[jj] = cvtpk(lo2f(x1a[jj]) * e1, hi2f(x1a[jj]) * e1); } }
#undef SSD_TAPS
#undef SSD_CONV
        }
        if (g == 0 && (lane & 31) == 0) { vaend[hsub] = fexp(aend[0]); vaend[2 + hsub] = fexp(aend[1]); }
        asum[0] += aend[0]; asum[1] += aend[1];
        if (!OUT) SSD_PUT_T(L_VT, x1s);
        if (c + 1 < NCH) SSD_LOAD(c + 1);
        __syncthreads();
        const int lc = opq(lane), r = lc & 15, qd = lc >> 4;
        if (!OUT) {
#pragma unroll
            for (int jj = 0; jj < 8; ++jj) { bf16* pr = proj + (rowc + 8 * g + jj) * PP;
                *(unsigned*)(pr + DBc(gq) + 2 * cp) = Bp[jj]; *(unsigned*)(pr + DCc(gq) + 2 * cp) = Cp[jj];
                *(unsigned*)(pr + DXc(gq) + 2 * cp) = x0p[jj]; *(unsigned*)(pr + DXc(gq) + 128 + 2 * cp) = x1a[jj]; }
            const float fe0 = vaend[hw0], fe1 = vaend[hw1];
#pragma unroll
            for (int dt = 0; dt < 8; ++dt) { S[0][dt] = S[0][dt] * fe0; S[1][dt] = S[1][dt] * fe1;
#pragma unroll
                for (int ks = 0; ks < 2; ++ks) { const bf16x8 a = frag64(lds + L_KTT, 16 * dt + r, ks, qd);
                    S[0][dt] = MFMA16(a, frag64(lds + L_VVT, 16 * w + r, ks, qd), S[0][dt]); S[1][dt] = MFMA16(a, frag64(lds + L_VT, 16 * w + r, ks, qd), S[1][dt]); } }
        } else {
            const int it = w & 3;
            f32x4 cb[2];
#pragma unroll
            for (int j2 = 0; j2 < 2; ++j2) { const int jt = 2 * (w >> 2) + j2; cb[j2] = (f32x4){0.f, 0.f, 0.f, 0.f};
                if (jt <= it) {
#pragma unroll
                    for (int ks = 0; ks < 4; ++ks) cb[j2] = MFMA16(frag(lds + L_KT, 16 * jt + r, PQ, ks, qd), frag(lds + L_QT, 16 * it + r, PQ, ks, qd), cb[j2]); } }
            unsigned uA[8]; float ssq = 0.f;
#pragma unroll
            for (int R = 0; R < 2; ++R) {
#pragma unroll
                for (int hs = 0; hs < 2; ++hs) { const int hd = 2 * R + hs; const float ai = vacs[hd * 64 + 16 * it + r]; const float dgi = Dh[R][hs] * vdti[hd * 64 + 16 * it + r];
#pragma unroll
                    for (int j2 = 0; j2 < 2; ++j2) { const int jt = 2 * (w >> 2) + j2; f32x4 pv = (f32x4){0.f, 0.f, 0.f, 0.f};
                        if (jt <= it) { const f32x4 aj = *(const LAS f32x4*)(vacs + hd * 64 + 16 * jt + 4 * qd);
#pragma unroll
                            for (int rg = 0; rg < 4; ++rg) { float v = cb[j2][rg] * fexp(fminf(ai - aj[rg], 0.f));
                                if (jt == it) { if (4 * qd + rg > r) v = 0.f; else if (4 * qd + rg == r) v += dgi; }
                                pv[rg] = v; } }
                        *(LAS u32x2v*)(lds + L_PM + hs * 9216 + sw64(16 * it + r, (16 * jt + 4 * qd) * 2)) = pack4(pv); } }
#pragma unroll
                for (int dt = 0; dt < 8; ++dt) *(LAS u32x2v*)(lds + L_ST + (16 * w + r) * PQ + (16 * dt + 4 * qd) * 2) = pack4(S[R][dt]);
                if (R == 1) {
#pragma unroll
                    for (int jj = 0; jj < 8; ++jj) { const float e1 = fexp(aend[1] - vsl[128 + jj]); x1s[jj] = cvtpk(lo2f(x1a[jj]) * e1, hi2f(x1a[jj]) * e1); }
                    SSD_PUT_T(L_VVT, x1s); SSD_PUT_T(L_VT, x1a); }
                __syncthreads();
                const int le_ = opq(lane), r = le_ & 15, qd = le_ >> 4;
                const int hd = 2 * R + (w >> 2);
                const int te = opq(tid), ei = te >> 3, ecc = te & 7;
                bf16* zp = proj + (rowc + ei) * PP + ZD + gq * 256 + R * 128 + 16 * ecc;
                const u32x4v za = *(const u32x4v*)zp, zb = *(const u32x4v*)(zp + 8);
                f32x4 o[4];
#pragma unroll
                for (int it2 = 0; it2 < 4; ++it2) { f32x4 o1 = (f32x4){0.f, 0.f, 0.f, 0.f}, o2 = (f32x4){0.f, 0.f, 0.f, 0.f};
#pragma unroll
                    for (int ks = 0; ks < 2; ++ks) if (ks == 0 || it2 >= 2) o1 = MFMA16(frag64(lds + L_VT, 16 * w + r, ks, qd), frag64(lds + L_PM + (w >> 2) * 9216, 16 * it2 + r, ks, qd), o1);
#pragma unroll
                    for (int ks = 0; ks < 4; ++ks) o2 = MFMA16(frag(lds + L_ST, 16 * w + r, PQ, ks, qd), frag(lds + L_QT, 16 * it2 + r, PQ, ks, qd), o2);
                    const float ea = veacs[hd * 64 + 16 * it2 + r]; o[it2] = o1 + o2 * ea; }
                const float fe = vaend[hd];
#pragma unroll
                for (int dt = 0; dt < 8; ++dt) { S[R][dt] = S[R][dt] * fe;
#pragma unroll
                    for (int ks = 0; ks < 2; ++ks) S[R][dt] = MFMA16(frag64(lds + L_KTT, 16 * dt + r, ks, qd), frag64(lds + L_VVT, 16 * w + r, ks, qd), S[R][dt]); }
#pragma unroll
                for (int it2 = 0; it2 < 4; ++it2) *(LAS u32x2v*)(lds + L_KT + (16 * it2 + r) * 272 + (16 * w + 4 * qd) * 2) = pack4(o[it2]);
                __syncthreads();
                const u32x4v oa = *(const LAS u32x4v*)(lds + L_KT + ei * 272 + ecc * 32), ob = *(const LAS u32x4v*)(lds + L_KT + ei * 272 + ecc * 32 + 16);
                const float ov[16] = {lo2f(oa.x), hi2f(oa.x), lo2f(oa.y), hi2f(oa.y), lo2f(oa.z), hi2f(oa.z), lo2f(oa.w), hi2f(oa.w), lo2f(ob.x), hi2f(ob.x), lo2f(ob.y), hi2f(ob.y), lo2f(ob.z), hi2f(ob.z), lo2f(ob.w), hi2f(ob.w)};
                const float zv[16] = {lo2f(za.x), hi2f(za.x), lo2f(za.y), hi2f(za.y), lo2f(za.z), hi2f(za.z), lo2f(za.w), hi2f(za.w), lo2f(zb.x), hi2f(zb.x), lo2f(zb.y), hi2f(zb.y), lo2f(zb.z), hi2f(zb.z), lo2f(zb.w), hi2f(zb.w)};
                if (R == 0) {
#pragma unroll
                    for (int k = 0; k < 8; ++k) { const float u0 = ov[2 * k] * fsilu(zv[2 * k]), u1 = ov[2 * k + 1] * fsilu(zv[2 * k + 1]); uA[k] = cvtpk(u0, u1); ssq += lo2f(uA[k]) * lo2f(uA[k]) + hi2f(uA[k]) * hi2f(uA[k]); }
                } else {
                    float uB[16];
#pragma unroll
                    for (int k = 0; k < 16; ++k) { uB[k] = ov[k] * fsilu(zv[k]); ssq += uB[k] * uB[k]; }
                    ssq += __shfl_xor(ssq, 1); ssq += __shfl_xor(ssq, 2); ssq += __shfl_xor(ssq, 4);
                    const float rs = frsq(ssq * (1.0f / 256.0f) + EPS);
                    const float* nwp = P->ssd_norm_w + l * 512 + gq * 256 + 16 * ecc;
                    u32x4v ya, yb;
                    ya.x = cvtpk(lo2f(uA[0]) * rs * nwp[0], hi2f(uA[0]) * rs * nwp[1]); ya.y = cvtpk(lo2f(uA[1]) * rs * nwp[2], hi2f(uA[1]) * rs * nwp[3]); ya.z = cvtpk(lo2f(uA[2]) * rs * nwp[4], hi2f(uA[2]) * rs * nwp[5]); ya.w = cvtpk(lo2f(uA[3]) * rs * nwp[6], hi2f(uA[3]) * rs * nwp[7]);
                    yb.x = cvtpk(lo2f(uA[4]) * rs * nwp[8], hi2f(uA[4]) * rs * nwp[9]); yb.y = cvtpk(lo2f(uA[5]) * rs * nwp[10], hi2f(uA[5]) * rs * nwp[11]); yb.z = cvtpk(lo2f(uA[6]) * rs * nwp[12], hi2f(uA[6]) * rs * nwp[13]); yb.w = cvtpk(lo2f(uA[7]) * rs * nwp[14], hi2f(uA[7]) * rs * nwp[15]);
                    if (DRY) { asm volatile("" :: "v"(ya.x), "v"(ya.y), "v"(ya.z), "v"(ya.w), "v"(yb.x), "v"(yb.y), "v"(yb.z), "v"(yb.w)); } else { *(u32x4v*)(zp - 128) = ya; *(u32x4v*)(zp - 128 + 8) = yb; }
                    nwp += 128;
                    ya.x = cvtpk(uB[0] * rs * nwp[0], uB[1] * rs * nwp[1]); ya.y = cvtpk(uB[2] * rs * nwp[2], uB[3] * rs * nwp[3]); ya.z = cvtpk(uB[4] * rs * nwp[4], uB[5] * rs * nwp[5]); ya.w = cvtpk(uB[6] * rs * nwp[6], uB[7] * rs * nwp[7]);
                    yb.x = cvtpk(uB[8] * rs * nwp[8], uB[9] * rs * nwp[9]); yb.y = cvtpk(uB[10] * rs * nwp[10], uB[11] * rs * nwp[11]); yb.z = cvtpk(uB[12] * rs * nwp[12], uB[13] * rs * nwp[13]); yb.w = cvtpk(uB[14] * rs * nwp[14], uB[15] * rs * nwp[15]);
                    if (DRY) { asm volatile("" :: "v"(ya.x), "v"(ya.y), "v"(ya.z), "v"(ya.w), "v"(yb.x), "v"(yb.y), "v"(yb.z), "v"(yb.w)); } else { *(u32x4v*)zp = ya; *(u32x4v*)(zp + 8) = yb; }
                }
            }
        }
    }
    if (!OUT) {
        bf16* sb = stbase + (size_t)idx * 32768;
#pragma unroll
        for (int R = 0; R < 2; ++R)
#pragma unroll
            for (int dt = 0; dt < 8; ++dt) st_wt(sb + ((size_t)(w * 16 + R * 8 + dt) * 64 + lane) * 4, pack4(S[R][dt]));
        if (g == 0 && (lane & 31) == 0) { st_wt_f(dsbase + (size_t)idx * 4 + hsub, asum[0]); st_wt_f(dsbase + (size_t)idx * 4 + 2 + hsub, asum[1]); }
        publish_item(flag_ptr(P, FLAG_SSD, idx), (unsigned)l + 1u);
    }
    __syncthreads();
#undef SSD_PUT_T
#undef SSD_LOAD
}
}
#define GAS __attribute__((address_space(1)))
typedef GAS unsigned gu32;
#define XB_TMO      128
#define XB_XCNT(j)  (256  + 64 * (j))
#define XB_XSUB(j)  (1280 + 64 * (j))
#define XB_XGEN(j)  (2304 + 64 * (j))
#define XB_TOP      3328
#define XB_TOPGEN   3392
#define XCD_BAR_WORDS 3456
#define XB_SPIN_CAP (1u << 18)

__device__ __forceinline__ unsigned xb_ld(unsigned* p)              { return __hip_atomic_load(p, __ATOMIC_RELAXED, __HIP_MEMORY_SCOPE_AGENT); }
__device__ __forceinline__ unsigned xb_add(unsigned* p, unsigned v) { return __hip_atomic_fetch_add(p, v, __ATOMIC_RELAXED, __HIP_MEMORY_SCOPE_AGENT); }
__device__ __forceinline__ unsigned xb_xcc_id() { return (unsigned)__builtin_amdgcn_s_getreg((3 << 11) | 20) & 0xFu; }
#define XB_SPIN(cond, bar) do { unsigned _sp = 0; while (cond) { __builtin_amdgcn_s_sleep(1); \
    if ((++_sp & 255u) == 0u) { if (xb_ld(&(bar)[XB_TMO])) break; if (_sp > XB_SPIN_CAP) { atomicAdd(&(bar)[XB_TMO], 1u); break; } } } } while (0)

struct XcdBarrier {
    unsigned* bar; unsigned x;
    volatile LAS unsigned* st;
};

__device__ __forceinline__ XcdBarrier xcd_barrier_post(unsigned* bar, volatile LAS unsigned* st) {
    XcdBarrier b; b.bar = bar; b.x = xb_xcc_id(); b.st = st;
    if (threadIdx.x == 0) (void)xb_add(&bar[XB_XCNT(b.x)], 1u);
    return b;
}
__device__ __forceinline__ void xcd_barrier_complete(unsigned* bar, unsigned x, unsigned& nloc, unsigned& nx) {
    const unsigned G = gridDim.x * gridDim.y * gridDim.z;
    unsigned sum, cnt, mine, sp = 0u;
    for (;;) {
        sum = 0u; cnt = 0u; mine = 0u;
#pragma unroll
        for (unsigned j = 0; j < 16; ++j) { const unsigned c = xb_ld(&bar[XB_XCNT(j)]); sum += c; cnt += (c > 0u) ? 1u : 0u; mine = (j == x) ? c : mine; }
        if (sum == G) break;
        __builtin_amdgcn_s_sleep(1);
        if ((++sp & 255u) == 0u) { if (xb_ld(&bar[XB_TMO])) break; if (sp > XB_SPIN_CAP) { atomicAdd(&bar[XB_TMO], 1u); break; } }
    }
    nloc = mine > 0u ? mine : 1u; nx = cnt > 0u ? cnt : 1u;
}

__device__ __forceinline__ void xcd_barrier(const XcdBarrier& b) {
    asm volatile("s_waitcnt vmcnt(0)" ::: "memory");
    __syncthreads();
    if (threadIdx.x == 0) {
        unsigned* bar = b.bar;
        __builtin_amdgcn_s_waitcnt(0);
        unsigned nloc = b.st[0], nx = b.st[1];
        if (nloc == 0u) { xcd_barrier_complete(bar, b.x, nloc, nx); b.st[0] = nloc; b.st[1] = nx; }
        const unsigned old = xb_add(&bar[XB_XSUB(b.x)], 1u);
        const unsigned gen = old / nloc;
        if (old + 1u == (gen + 1u) * nloc) {
            __builtin_amdgcn_fence(__ATOMIC_RELEASE, "agent");
            asm volatile("s_waitcnt vmcnt(0)" ::: "memory");
            const unsigned og = xb_add(&bar[XB_TOP], 1u);
            const unsigned tg = og / nx;
            if (og + 1u == (tg + 1u) * nx) xb_add(&bar[XB_TOPGEN], 1u);
            else XB_SPIN(xb_ld(&bar[XB_TOPGEN]) == tg, bar);
            __builtin_amdgcn_fence(__ATOMIC_ACQUIRE, "agent");
            xb_add(&bar[XB_XGEN(b.x)], 1u);
            asm volatile("s_waitcnt vmcnt(0)" ::: "memory");
        } else {
            XB_SPIN(xb_ld(&bar[XB_XGEN(b.x)]) == gen, bar);
            __builtin_amdgcn_fence(__ATOMIC_ACQUIRE, "agent");
            asm volatile("s_waitcnt vmcnt(0)" ::: "memory");
        }
    }
    __syncthreads();
}
constexpr int LDS_BYTES = 163840;
constexpr int LDS_BARST = 163832;
constexpr int CTL_BYTES = 65536;
template <bool OUT>
__device__ __forceinline__ void engine_items(KP P, int l, int bid, int nblk, LAS unsigned char* lds) {
    if (nblk == 256) {
        if (bid < 64) { const int s = bid & 15, bg = bid >> 4; mx::ssd_item<OUT>(P, l, bg >> 1, bg & 1, s, lds); }
        else if (bid < 192) { const int ii = bid - 64, s = ii & 15, bh = ii >> 4;
            mx::ml_item<OUT>(P, l, bh >> 2, bh & 3, s, lds); if (OUT) mx::pc_item<0, true>(P, l, bh >> 2, bh & 3, 15 - s, lds); else mx::pc_pass1<0>(P, l, bh >> 2, bh & 3, 15 - s, lds); }
        else { const int ii = bid - 192, sh = ii & 7, bh = ii >> 3;
            if (OUT) { mx::pc_item<2, true>(P, l, bh >> 2, bh & 3, sh, lds); mx::pc_item<2, true>(P, l, bh >> 2, bh & 3, 15 - sh, lds); }
            else { mx::pc_pass1<2>(P, l, bh >> 2, bh & 3, sh, lds); mx::pc_pass1<2>(P, l, bh >> 2, bh & 3, 15 - sh, lds); } }
    } else {
        for (int ii = bid; ii < 448; ii += nblk) {
            if (ii < 64) { const int s = ii & 15, bg = ii >> 4; mx::ssd_item<OUT>(P, l, bg >> 1, bg & 1, s, lds); }
            else if (ii < 192) { const int i2 = ii - 64, s = i2 & 15, bh = i2 >> 4; mx::ml_item<OUT>(P, l, bh >> 2, bh & 3, s, lds); }
            else if (ii < 320) { const int i2 = ii - 192, s = i2 & 15, bh = i2 >> 4; mx::pc_item<2, OUT>(P, l, bh >> 2, bh & 3, s, lds); }
            else { const int i2 = ii - 320, s = i2 & 15, bh = i2 >> 4; mx::pc_item<0, OUT>(P, l, bh >> 2, bh & 3, s, lds); }
        }
    }
}
__global__ void __launch_bounds__(512, 2) fwd_mega(Params Pval) {
    extern __shared__ __attribute__((aligned(16))) unsigned char lds_raw[]; LAS unsigned char* lds = (LAS unsigned char*)lds_raw;
    (void)Pval; KP P = (KP)__builtin_amdgcn_kernarg_segment_ptr();
#define LAUNDER() asm volatile("" : "+s"(P))
    const int bid = blockIdx.x, nblk = gridDim.x;
    if (threadIdx.x < 2) ((LAS unsigned*)(lds + LDS_BARST))[threadIdx.x] = 0u;
    __syncthreads();
    LAUNDER();
    XcdBarrier bar = xcd_barrier_post((unsigned*)(P->ws + WS_CTL) + 1024, (volatile LAS unsigned*)(lds + LDS_BARST));
    LAUNDER(); phase_prologue(P, bid, nblk, lds);
    xcd_barrier(bar);
#define LAYER_BODY(l) do { \
        LAUNDER(); phase_gemm_in(P, l, bid, nblk, lds); \
        xcd_barrier(bar); \
        LAUNDER(); engine_items<false>(P, l, bid, nblk, lds); \
        LAUNDER(); engine_items<true>(P, l, bid, nblk, lds); \
        LAUNDER(); convert_weights_queue(P, l, lds); \
        xcd_barrier(bar); \
        LAUNDER(); phase_gemm_out(P, l, bid, nblk, lds); \
        xcd_barrier(bar); } while (0)
    LAYER_BODY(0);
    LAYER_BODY(1);
    static_assert(DEPTH == 2, "layer bodies are written out");
    LAUNDER(); phase_final(P, bid, nblk);
}

extern "C" void kernel_launch(void* const* d_in, const int* in_sizes, int n_in, void* d_out, int out_size, void* d_ws, size_t ws_size, hipStream_t stream) {
    static int grid_blocks = 0;
    if (!grid_blocks) {
        if (n_in != 21 || out_size != NTOK * DM || ws_size < WS_END) { fprintf(stderr, "kernel_launch: unexpected shapes (n_in %d out %d ws %zu)\n", n_in, out_size, ws_size); grid_blocks = -1; return; }
        if (hipFuncSetAttribute((const void*)fwd_mega, hipFuncAttributeMaxDynamicSharedMemorySize, LDS_BYTES) != hipSuccess) { fprintf(stderr, "hipFuncSetAttribute failed\n"); grid_blocks = -1; return; }
        int dev = 0, cus = 0, per_cu = 0;
        (void)hipGetDevice(&dev); (void)hipDeviceGetAttribute(&cus, hipDeviceAttributeMultiprocessorCount, dev);
        (void)hipOccupancyMaxActiveBlocksPerMultiprocessor(&per_cu, (const void*)fwd_mega, 512, LDS_BYTES);
        if (per_cu < 1) { fprintf(stderr, "kernel_launch: occupancy query says %d blocks per CU\n", per_cu); grid_blocks = -1; return; }
        grid_blocks = cus;
    }
    if (grid_blocks < 0) return;
    (void)hipMemsetAsync((unsigned char*)d_ws + WS_CTL, 0, CTL_BYTES, stream);
    Params P{};
    const float** pp = (const float**)&P;
    for (int i = 0; i < 21; ++i) pp[i] = (const float*)d_in[i];
    P.out = (float*)d_out; P.ws = (unsigned char*)d_ws;
    void* args[] = {&P};
    hipError_t e = hipLaunchCooperativeKernel((const void*)fwd_mega, dim3(grid_blocks), dim3(512), args, LDS_BYTES, stream);
    if (e != hipSuccess) fprintf(stderr, "cooperative launch failed: %s (grid %d)\n", hipGetErrorString(e), grid_blocks);
}
```

```cpp
#include <hip/hip_runtime.h>
#include <hip/hip_cooperative_groups.h>
#include <cstdio>
#include <cstdint>
namespace cg = cooperative_groups;

constexpr int NTOK = 16384, SEQ = 8192, DM = 1024, DEPTH = 2, DPROJ = 7712, DINNER = 2048;
constexpr int PP = 7680;
constexpr int NPAD = 7936;
constexpr float EPS = 1e-6f;
constexpr int ZA = 0, ZB = 512, ZC = 1024, ZD = 1536;
__host__ __device__ constexpr int AQc(int h) { return 2048 + h * 256; }
__host__ __device__ constexpr int AKc(int h) { return 2048 + h * 256 + 64; }
__host__ __device__ constexpr int AVc(int h) { return 2048 + h * 256 + 128; }
__host__ __device__ constexpr int BQc(int h) { return 3072 + h * 512; }
__host__ __device__ constexpr int BKc(int h) { return 3072 + h * 512 + 128; }
__host__ __device__ constexpr int BVc(int h) { return 3072 + h * 512 + 256; }
__host__ __device__ constexpr int BOc(int h) { return 3072 + h * 512 + 384; }
__host__ __device__ constexpr int CQc(int h) { return 5120 + h * 384; }
__host__ __device__ constexpr int CFc(int h) { return 5120 + h * 384 + 128; }
__host__ __device__ constexpr int CIc(int h) { return 5120 + h * 384 + 256; }
constexpr int DSSD = 6656;
__host__ __device__ constexpr int DXc(int g) { return DSSD + g * 512; }
__host__ __device__ constexpr int DBc(int g) { return DSSD + g * 512 + 256; }
__host__ __device__ constexpr int DCc(int g) { return DSSD + g * 512 + 384; }
constexpr int G_GR = 0, G_BI = 16, G_BF = 20, G_DT = 24;

__host__ __device__ __forceinline__ int win_src_col(int n) {
    if (n < 2048) { const int g = n >> 9, r = n & 511; const int base = (g == 0) ? 1040 : (g == 1) ? 3608 : (g == 2) ? 5656 : 7200; return base + r; }
    if (n < 3072) { const int j = n - 2048, h = j >> 8, r = j & 255; return (r < 64) ? h * 64 + r : (r < 128) ? 256 + h * 64 + (r - 64) : 512 + h * 128 + (r - 128); }
    if (n < 5120) { const int j = n - 3072, h = j >> 9, r = j & 511, part = r >> 7, c = r & 127; return ((part == 0) ? 1552 : (part == 1) ? 2064 : (part == 2) ? 2576 : 3096) + h * 128 + c; }
    if (n < 6656) { const int j = n - 5120, h = j / 384, r = j % 384, part = r >> 7, c = r & 127; return ((part == 0) ? 4120 : (part == 1) ? 4632 : 5144) + h * 128 + c; }
    if (n < 7680) { const int j = n - 6656, g = j >> 9, r = j & 511; return (r < 256) ? 6168 + g * 256 + r : (r < 384) ? 6680 + g * 128 + (r - 256) : 6936 + g * 128 + (r - 384); }
    const int j = n - 7680;
    if (j < 16) return 1024 + j;
    if (j < 20) return 3088 + (j - 16);
    if (j < 24) return 3092 + (j - 20);
    if (j < 32) return 7192 + (j - 24);
    return -1;
}

constexpr size_t MiB = 1u << 20;
constexpr size_t WS_CTL = 0;
constexpr size_t WS_PROJ = 1 * MiB;
constexpr size_t WS_GATES = 241 * MiB;
constexpr size_t WS_WOUT = 243 * MiB;
constexpr size_t WS_SSQ = 251 * MiB;
constexpr size_t WS_RSTD0 = 252 * MiB;
constexpr size_t WS_MISC = 252 * MiB + 65536;
constexpr size_t WS_HALO = 253 * MiB;
constexpr size_t WS_END = 256 * MiB;
constexpr size_t DO_HB = 0;
constexpr size_t DO_WIN = 32 * MiB;
constexpr size_t DO_WIN_STRIDE = 15 * MiB + MiB / 2;
constexpr size_t DO_STATE = 32 * MiB;

typedef unsigned short bf16;
typedef float f32x4v __attribute__((ext_vector_type(4)));
typedef unsigned u32x4v __attribute__((ext_vector_type(4)));
typedef unsigned u32x2v __attribute__((ext_vector_type(2)));
#define LAS __attribute__((address_space(3)))

__device__ __forceinline__ float bf2f(unsigned short u) { return __uint_as_float(((unsigned)u) << 16); }
__device__ __forceinline__ unsigned f2bf(float f) { unsigned u = __float_as_uint(f); return (u + 0x7fffu + ((u >> 16) & 1u)) >> 16; }
__device__ __forceinline__ unsigned pk2(float lo, float hi) { return f2bf(lo) | (f2bf(hi) << 16); }
__device__ __forceinline__ float sigmoidf_(float x) { return 1.f / (1.f + __expf(-x)); }
__device__ __forceinline__ float siluf_(float x) { return x / (1.f + __expf(-x)); }
__device__ __forceinline__ float softplusf_(float x) { return fmaxf(x, 0.f) + log1pf(__expf(-fabsf(x))); }
__device__ __forceinline__ float logsigmoidf_(float x) { return fminf(x, 0.f) - log1pf(__expf(-fabsf(x))); }
__device__ __forceinline__ float wave_sum(float v) {
#pragma unroll
    for (int o = 1; o < 64; o <<= 1) v += __shfl_xor(v, o);
    return v;
}

typedef float f32x2c __attribute__((ext_vector_type(2)));
typedef __bf16 bf16x2c __attribute__((ext_vector_type(2)));
__device__ __forceinline__ unsigned cvt_pk2(float lo, float hi) { f32x2c v = {lo, hi}; bf16x2c r = __builtin_convertvector(v, bf16x2c); return __builtin_bit_cast(unsigned, r); }
__device__ __forceinline__ int opaque_tid() { int t = threadIdx.x; asm volatile("" : "+v"(t)); return t; }

struct Params {
    const float* x; const float* norm_w; const float* w_in; const float* gla_gate_w; const float* gla_gate_b; const float* gla_norm_w;
    const float* ml_conv_w; const float* ml_conv_b; const float* ml_i_b; const float* ml_f_b; const float* ml_norm_w;
    const float* hg_lb; const float* hg_norm_w; const float* ssd_conv_w; const float* ssd_conv_b; const float* ssd_dt_bias;
    const float* ssd_A_log; const float* ssd_D; const float* ssd_norm_w; const float* w_out; const float* final_norm_w;
    float* out; unsigned char* ws;
};
typedef const __attribute__((address_space(4))) Params* KP;
namespace pg8 {
#define PG8_LAS __attribute__((address_space(3)))
typedef unsigned short bf16_t;
typedef short bf16x8 __attribute__((ext_vector_type(8)));
typedef float f32x4 __attribute__((ext_vector_type(4)));
typedef unsigned u32x4 __attribute__((ext_vector_type(4)));
constexpr int BM = 256, BK = 64, HALF = 128, HTB = HALF * BK * 2  , STAGE_BYTES = 8 * HTB, NXCD = 8, WGM = 4;

__host__ __device__ __forceinline__ int lds_byte(int r, int c) { const int st = (r >> 4) * 2 + (c >> 5), rr = r & 15, cc = c & 31, ob = rr * 64 + cc * 2; return st * 1024 + (ob ^ (((ob >> 9) & 1) << 5)); }
__host__ __device__ __forceinline__ void stage_rc(int b, int& R, int& C) { const int st = b / 1024, sb = b % 1024, swz = sb ^ (((sb >> 9) & 1) << 5); R = (st >> 1) * 16 + swz / 64; C = (st & 1) * 32 + (swz % 64) / 2; }
__host__ __device__ __forceinline__ int perm32(int rho) { const int n = rho >> 4, i = rho & 15; return 8 * (i >> 2) + 4 * n + (i & 3); }

struct Unit { int pm, pn, idx; };
struct Gemm { const bf16_t* A; const bf16_t* Bt; int M, N, K, lda; };

struct StaticOrder {
    int nM, nN, nwg, G, c;
    __host__ __device__ void init(int M, int N, int G_, int c_) { nM = M / BM; nN = N / BM; nwg = nM * nN; G = G_; c = c_; }
    __host__ __device__ bool next(int i, Unit& u) const {
        const long L = (long)i * G + c; if (L >= nwg) return false;
        int wgid = (int)L; { const int q = nwg / NXCD, r = nwg % NXCD, xcd = wgid % NXCD, off = wgid / NXCD; wgid = (xcd < r ? xcd * (q + 1) : r * (q + 1) + (xcd - r) * q) + off; }
        const int nig = WGM * nN, gid = wgid / nig, fm = gid * WGM, gsz = (nM - fm) < WGM ? (nM - fm) : WGM;
        u.pm = fm + ((wgid % nig) % gsz); u.pn = (wgid % nig) / gsz; u.idx = i; return true;
    }
    __device__ __forceinline__ void a_ready(const Unit&) const {}
    __device__ __forceinline__ void done(const Unit&) const {}
};

__device__ __forceinline__ unsigned cvt_pk_bf16(float lo, float hi) { return cvt_pk2(lo, hi); }

template <class Epi, class Sched, bool ALIGN_EPI = false, bool SP2 = false>
__device__ __forceinline__ void gemm_phase(PG8_LAS unsigned char* lds, const Gemm g, const Sched& S, const Epi& E) {
    const int tid = opaque_tid(), wid = __builtin_amdgcn_readfirstlane(tid >> 6), lane = tid & 63, wr = wid >> 2, wc = wid & 3, fr = lane & 15, fq = lane >> 4;
    const int K = g.K, nt = K / BK, lda = g.lda;
    unsigned voffA[2], voffB[2];
#pragma unroll
    for (int i = 0; i < 2; ++i) { int R, C; stage_rc(tid * 16 + i * 8192, R, C); const int Rb = Epi::PERM ? ((R & ~31) + perm32(R & 31)) : R;
        voffA[i] = (unsigned)(R * lda + C) * 2u; voffB[i] = (unsigned)(Rb * K + C) * 2u; }
    const size_t kstep = (size_t)(BK * 2);
    const size_t hsA = (size_t)HALF * lda * 2, hsB = (size_t)HALF * K * 2;
    const size_t tsA = 2 * hsA, tsB = 2 * hsB;
    const unsigned ldsw = (unsigned)wid * 1024u;
    const int aoff = lds_byte(wr * 64 + fr, fq * 8), boff = lds_byte(wc * 32 + fr, fq * 8);
#define PG8_SA(b, h) (((b) * 2 + (h)) * HTB)
#define PG8_SB(b, h) ((4 + (b) * 2 + (h)) * HTB)
#define PG8_STAGE(bufoff, gbase, voff) do { _Pragma("unroll") for (int _i = 0; _i < 2; ++_i) \
        __builtin_amdgcn_global_load_lds((const unsigned*)((const char*)(gbase) + (voff)[_i]), (PG8_LAS unsigned*)(lds + (bufoff) + ldsw + _i * 8192), 16, 0, 0); } while (0)
#define PG8_LDA(dst, b, h) do { _Pragma("unroll") for (int m = 0; m < 4; ++m) _Pragma("unroll") for (int k = 0; k < 2; ++k) dst[m][k] = *(const PG8_LAS bf16x8*)(lds + PG8_SA(b, h) + aoff + m * 2048 + k * 1024); } while (0)
#define PG8_LDB(dst, b, h) do { _Pragma("unroll") for (int n = 0; n < 2; ++n) _Pragma("unroll") for (int k = 0; k < 2; ++k) dst[n][k] = *(const PG8_LAS bf16x8*)(lds + PG8_SB(b, h) + boff + n * 2048 + k * 1024); } while (0)
#define PG8_MMA(ai, bj, At, Bt) do { __builtin_amdgcn_s_setprio(1); _Pragma("unroll") for (int m = 0; m < 4; ++m) _Pragma("unroll") for (int n = 0; n < 2; ++n) _Pragma("unroll") for (int k = 0; k < 2; ++k) \
        acc[ai][bj][m][n] = __builtin_amdgcn_mfma_f32_16x16x32_bf16(Bt[n][k], At[m][k], acc[ai][bj][m][n], 0, 0, 0); __builtin_amdgcn_s_setprio(0); } while (0)
#define PG8_WAIT_V(n) asm volatile("s_waitcnt vmcnt(" #n ")" ::: "memory")
#define PG8_WAIT_L(n) asm volatile("s_waitcnt lgkmcnt(" #n ")" ::: "memory")
#define PG8_BAR __builtin_amdgcn_s_barrier()
#define PG8_SCHED __builtin_amdgcn_sched_barrier(0)
    Unit cur, nxt; int ui = 0;
    if (!S.next(0, cur)) return;
    f32x4 acc[2][2][4][2];
#pragma unroll
    for (int a = 0; a < 2; ++a)
#pragma unroll
        for (int b = 0; b < 2; ++b)
#pragma unroll
            for (int m = 0; m < 4; ++m)
#pragma unroll
                for (int n = 0; n < 2; ++n) acc[a][b][m][n] = (f32x4){0.f, 0.f, 0.f, 0.f};
    bf16x8 At[4][2], B0[2][2], B1[2][2];
    const char* cA = (const char*)g.A + (size_t)cur.pm * tsA; const char* cB = (const char*)g.Bt + (size_t)cur.pn * tsB;
    S.a_ready(cur);
    if constexpr (SP2) {
        PG8_STAGE(PG8_SB(0, 0), cB, voffB); PG8_STAGE(PG8_SB(0, 1), cB + hsB, voffB); PG8_STAGE(PG8_SA(0, 0), cA, voffA); PG8_STAGE(PG8_SA(0, 1), cA + hsA, voffA);
        if (wr == 1) PG8_BAR;
        PG8_WAIT_V(2); PG8_BAR;
        PG8_STAGE(PG8_SB(1, 0), cB + kstep, voffB); PG8_STAGE(PG8_SA(1, 0), cA + kstep, voffA); PG8_STAGE(PG8_SB(1, 1), cB + hsB + kstep, voffB);
        PG8_WAIT_V(6); PG8_BAR;
    } else {
        PG8_STAGE(PG8_SB(0, 0), cB, voffB); PG8_STAGE(PG8_SA(0, 0), cA, voffA); PG8_STAGE(PG8_SB(0, 1), cB + hsB, voffB); PG8_STAGE(PG8_SA(0, 1), cA + hsA, voffA);
        if (wr == 1) PG8_BAR;
        PG8_WAIT_V(4); PG8_BAR;
        PG8_STAGE(PG8_SB(1, 0), cB + kstep, voffB); PG8_STAGE(PG8_SA(1, 0), cA + kstep, voffA); PG8_STAGE(PG8_SB(1, 1), cB + hsB + kstep, voffB);
        PG8_WAIT_V(6); PG8_BAR;
    }
    u32x4 held[4]; bool have_held = false; Unit hu = cur;
    for (;;) {
        const bool has_next = S.next(ui + 1, nxt);
        const char* nA = has_next ? (const char*)g.A + (size_t)nxt.pm * tsA : cA; const char* nB = has_next ? (const char*)g.Bt + (size_t)nxt.pn * tsB : cB;
        for (int t = 0; t < nt; t += 2) {
            const bool last = (t == nt - 2);
            const char* a1 = cA + (size_t)(t + 1) * kstep;
            const char* a2 = last ? nA : cA + (size_t)(t + 2) * kstep; const char* b2 = last ? nB : cB + (size_t)(t + 2) * kstep;
            const char* a3 = a2 + kstep; const char* b3 = b2 + kstep;
            if (last && has_next) S.a_ready(nxt);
            if constexpr (Epi::DEFER) { if (have_held && (t == 2 || t == 6)) E.store_held(held, hu, (t - 2) >> 2, wr, wc, fr, fq); }
            if constexpr (SP2) {
            PG8_LDB(B0, 0, 0); PG8_LDB(B1, 0, 1); PG8_SCHED; PG8_LDA(At, 0, 0); PG8_STAGE(PG8_SA(1, 1), a1 + hsA, voffA);
            PG8_WAIT_V(8); PG8_WAIT_L(0); PG8_BAR; PG8_MMA(0, 0, At, B0); PG8_MMA(0, 1, At, B1); PG8_BAR; PG8_SCHED;
            PG8_LDA(At, 0, 1); PG8_STAGE(PG8_SB(0, 0), b2, voffB); PG8_STAGE(PG8_SB(0, 1), b2 + hsB, voffB); PG8_STAGE(PG8_SA(0, 0), a2, voffA);
            PG8_WAIT_V(8); PG8_WAIT_L(0); PG8_BAR; PG8_MMA(1, 0, At, B0); PG8_MMA(1, 1, At, B1); PG8_BAR; PG8_SCHED;
            PG8_LDB(B0, 1, 0); PG8_LDB(B1, 1, 1); PG8_SCHED; PG8_LDA(At, 1, 0); PG8_STAGE(PG8_SA(0, 1), a2 + hsA, voffA);
            PG8_WAIT_V(8); PG8_WAIT_L(0); PG8_BAR; PG8_MMA(0, 0, At, B0); PG8_MMA(0, 1, At, B1); PG8_BAR; PG8_SCHED;
            PG8_LDA(At, 1, 1); PG8_STAGE(PG8_SB(1, 0), b3, voffB); PG8_STAGE(PG8_SB(1, 1), b3 + hsB, voffB); PG8_STAGE(PG8_SA(1, 0), a3, voffA);
            PG8_WAIT_V(8); PG8_WAIT_L(0); PG8_BAR; PG8_MMA(1, 0, At, B0); PG8_MMA(1, 1, At, B1); PG8_BAR; PG8_SCHED;
            } else {
            PG8_LDB(B0, 0, 0); PG8_SCHED; PG8_LDA(At, 0, 0); PG8_STAGE(PG8_SA(1, 1), a1 + hsA, voffA);
            PG8_WAIT_L(8); PG8_BAR; PG8_WAIT_L(0); PG8_MMA(0, 0, At, B0); PG8_BAR; PG8_SCHED;
            PG8_LDB(B1, 0, 1); PG8_STAGE(PG8_SB(0, 0), b2, voffB);
            PG8_BAR; PG8_WAIT_L(0); PG8_MMA(0, 1, At, B1); PG8_BAR;
            PG8_LDA(At, 0, 1); PG8_STAGE(PG8_SA(0, 0), a2, voffA);
            PG8_BAR; PG8_WAIT_L(0); PG8_MMA(1, 0, At, B0); PG8_BAR; PG8_SCHED;
            PG8_STAGE(PG8_SB(0, 1), b2 + hsB, voffB);
            PG8_WAIT_V(6); PG8_BAR; PG8_MMA(1, 1, At, B1); PG8_BAR;
            PG8_LDB(B0, 1, 0); PG8_SCHED; PG8_LDA(At, 1, 0); PG8_STAGE(PG8_SA(0, 1), a2 + hsA, voffA);
            PG8_WAIT_L(8); PG8_BAR; PG8_WAIT_L(0); PG8_MMA(0, 0, At, B0); PG8_BAR; PG8_SCHED;
            PG8_LDB(B1, 1, 1); PG8_STAGE(PG8_SB(1, 0), b3, voffB);
            PG8_BAR; PG8_WAIT_L(0); PG8_MMA(0, 1, At, B1); PG8_BAR;
            PG8_LDA(At, 1, 1); PG8_STAGE(PG8_SA(1, 0), a3, voffA);
            PG8_BAR; PG8_WAIT_L(0); PG8_MMA(1, 0, At, B0); PG8_BAR; PG8_SCHED;
            PG8_STAGE(PG8_SB(1, 1), b3 + hsB, voffB);
            PG8_WAIT_V(6); PG8_BAR; PG8_MMA(1, 1, At, B1); PG8_BAR;
            }
        }
        if constexpr (ALIGN_EPI) { if (wr == 0) PG8_BAR; }
        if constexpr (Epi::DEFER) {
            have_held = E.first_half_and_pack(acc, cur, wr, wc, fr, fq, held); hu = cur;
            if (!has_next) { if (have_held) { for (int q = 0; q < 2; ++q) E.store_held(held, hu, q, wr, wc, fr, fq); } S.done(cur); break; }
            S.done(cur);
        } else {
            E(acc, cur, wr, wc, fr, fq); S.done(cur);
            if (!has_next) break;
        }
#pragma unroll
        for (int a = 0; a < 2; ++a)
#pragma unroll
            for (int b = 0; b < 2; ++b)
#pragma unroll
                for (int m = 0; m < 4; ++m)
#pragma unroll
                    for (int n = 0; n < 2; ++n) acc[a][b][m][n] = (f32x4){0.f, 0.f, 0.f, 0.f};
        cur = nxt; cA = nA; cB = nB; ++ui;
        if constexpr (ALIGN_EPI) { if (wr == 1) PG8_BAR; }
    }
    PG8_WAIT_V(0);
    if constexpr (!ALIGN_EPI) { if (wr == 0) PG8_BAR; }
    PG8_BAR;
#undef PG8_SA
#undef PG8_SB
#undef PG8_STAGE
#undef PG8_LDA
#undef PG8_LDB
#undef PG8_MMA
#undef PG8_WAIT_V
#undef PG8_WAIT_L
#undef PG8_BAR
#undef PG8_SCHED
}
}
struct EpiProj {
    static constexpr bool PERM = true;
    static constexpr bool DEFER = true;
    bf16* proj; float* gates; const LAS float* rstd_tab; bf16* halo;
    __device__ __forceinline__ u32x4v pack8(const pg8::f32x4& a0, const pg8::f32x4& a1, float rs) const {
        const pg8::f32x4 v0 = a0 * rs, v1 = a1 * rs;
        u32x4v w; w.x = pg8::cvt_pk_bf16(v0[0], v0[1]); w.y = pg8::cvt_pk_bf16(v0[2], v0[3]); w.z = pg8::cvt_pk_bf16(v1[0], v1[1]); w.w = pg8::cvt_pk_bf16(v1[2], v1[3]); return w; }
    __device__ __forceinline__ bool first_half_and_pack(const pg8::f32x4 (&acc)[2][2][4][2], const pg8::Unit& u, int wr, int wc, int fr, int fq, pg8::u32x4 (&held)[4]) const {
        const int row0 = u.pm * 256 + wr * 64 + fr;
        if (u.pn < 30) {
#pragma unroll
            for (int ai = 0; ai < 2; ++ai)
#pragma unroll
                for (int m = 0; m < 4; ++m) {
                    const int row = row0 + ai * 128 + m * 16;
                    const float rs = rstd_tab[u.idx * 256 + (row & 255)];
#pragma unroll
                    for (int bj = 0; bj < 2; ++bj) { const u32x4v w = pack8(acc[ai][bj][m][0], acc[ai][bj][m][1], rs);
                        if (ai == 1 && m >= 2) held[(m - 2) * 2 + bj] = w;
                        else *(u32x4v*)(proj + (size_t)row * PP + u.pn * 256 + bj * 128 + wc * 32 + 8 * fq) = w;
                        if (u.pn >= 26 && (row & 511) >= 509)
                            *(u32x4v*)(halo + ((size_t)((row >> 9) * 3 + ((row & 511) - 509))) * 1024 + (u.pn - 26) * 256 + bj * 128 + wc * 32 + 8 * fq) = w; }
                }
            return true;
        }
        if (wc == 0) {
#pragma unroll
            for (int ai = 0; ai < 2; ++ai)
#pragma unroll
                for (int m = 0; m < 4; ++m) { const int row = row0 + ai * 128 + m * 16; const float rs = rstd_tab[u.idx * 256 + (row & 255)];
                    float* gp = gates + (size_t)row * 32 + 8 * fq;
                    *(pg8::f32x4*)(gp) = acc[ai][0][m][0] * rs; *(pg8::f32x4*)(gp + 4) = acc[ai][0][m][1] * rs; }
        }
        return false;
    }
    __device__ __forceinline__ void store_held(const pg8::u32x4 (&held)[4], const pg8::Unit& u, int q, int wr, int wc, int fr, int fq) const {
        bf16* base = proj + (size_t)(u.pm * 256 + wr * 64 + fr + 128) * PP + u.pn * 256 + wc * 32 + 8 * fq;
#pragma unroll
        for (int m = 2; m < 4; ++m) if (m - 2 == q) {
#pragma unroll
            for (int bj = 0; bj < 2; ++bj) *(u32x4v*)(base + (size_t)(m * 16) * PP + bj * 128) = held[(m - 2) * 2 + bj]; }
    }
};
struct EpiRes {
    static constexpr bool PERM = true;
    static constexpr bool DEFER = false;
    bf16* hb; float* ssq; bf16* h2; int last;
    __device__ __forceinline__ void operator()(const pg8::f32x4 (&acc)[2][2][4][2], const pg8::Unit& u, int wr, int wc, int fr, int fq) const {
        const int row0 = u.pm * 256 + wr * 64 + fr, col0 = u.pn * 256 + wc * 32 + 8 * fq;
        u32x4v res[2][4][2];
#pragma unroll
        for (int ai = 0; ai < 2; ++ai)
#pragma unroll
            for (int m = 0; m < 4; ++m)
#pragma unroll
                for (int bj = 0; bj < 2; ++bj) res[ai][m][bj] = *(const u32x4v*)(hb + (size_t)(row0 + ai * 128 + m * 16) * DM + col0 + bj * 128);
#pragma unroll
        for (int ai = 0; ai < 2; ++ai)
#pragma unroll
            for (int m = 0; m < 4; ++m) {
                const int row = row0 + ai * 128 + m * 16;
                float sq = 0.f;
#pragma unroll
                for (int bj = 0; bj < 2; ++bj) {
                    const int col = col0 + bj * 128;
                    const u32x4v rw = res[ai][m][bj];
                    const pg8::f32x4 r0 = (pg8::f32x4){__uint_as_float(rw.x << 16), __uint_as_float(rw.x & 0xffff0000u), __uint_as_float(rw.y << 16), __uint_as_float(rw.y & 0xffff0000u)};
                    const pg8::f32x4 r1 = (pg8::f32x4){__uint_as_float(rw.z << 16), __uint_as_float(rw.z & 0xffff0000u), __uint_as_float(rw.w << 16), __uint_as_float(rw.w & 0xffff0000u)};
                    const pg8::f32x4 v0 = acc[ai][bj][m][0] + r0, v1 = acc[ai][bj][m][1] + r1;
                    u32x4v w; w.x = pg8::cvt_pk_bf16(v0[0], v0[1]); w.y = pg8::cvt_pk_bf16(v0[2], v0[3]); w.z = pg8::cvt_pk_bf16(v1[0], v1[1]); w.w = pg8::cvt_pk_bf16(v1[2], v1[3]);
                    bf16* dst = last ? (bf16*)((char*)h2 + (size_t)row * (PP * 2)) + col : hb + (size_t)row * DM + col;
                    *(u32x4v*)dst = w;
                    sq += (v0[0] * v0[0] + v0[1] * v0[1]) + (v0[2] * v0[2] + v0[3] * v0[3]) + (v1[0] * v1[0] + v1[1] * v1[1]) + (v1[2] * v1[2] + v1[3] * v1[3]);
                }
                sq += __shfl_xor(sq, 16); sq += __shfl_xor(sq, 32);
                if (fq == 0) ssq[(size_t)(u.pn * 4 + wc) * NTOK + row] = sq;
            }
    }
};

constexpr int NIT_WIN = (DM / 64) * (NPAD / 32), NIT_WOUT = (DINNER / 64) * (DM / 32);
template <int NR>
__device__ __forceinline__ void rows_to_bf16_rstd(const float* x, bf16* hb, float* rstd, int m0, int mstride, int lane) {
    f32x4v v[NR][4];
#pragma unroll
    for (int q = 0; q < NR; ++q) { const f32x4v* xr = (const f32x4v*)(x + (size_t)(m0 + q * mstride) * DM) + lane;
#pragma unroll
        for (int j = 0; j < 4; ++j) v[q][j] = __builtin_nontemporal_load(xr + 64 * j); }
#pragma unroll
    for (int q = 0; q < NR; ++q) { float s = 0.f;
#pragma unroll
        for (int j = 0; j < 4; ++j) s += (v[q][j].x * v[q][j].x + v[q][j].y * v[q][j].y) + (v[q][j].z * v[q][j].z + v[q][j].w * v[q][j].w);
        s = wave_sum(s);
        if (lane == 0) rstd[m0 + q * mstride] = 1.0f / sqrtf(s * (1.0f / DM) + EPS);
        u32x2v* o8 = (u32x2v*)(hb + (size_t)(m0 + q * mstride) * DM) + lane;
#pragma unroll
        for (int j = 0; j < 4; ++j) { u32x2v w; w.x = cvt_pk2(v[q][j].x, v[q][j].y); w.y = cvt_pk2(v[q][j].z, v[q][j].w); o8[64 * j] = w; } }
}
template <bool WIN>
__device__ __forceinline__ void transpose_item(const float* W, int K, int Nsrc, int Ndst, bf16* WT, LAS float* scr, int item, int lane, const float* kscale) {
    const int nb_n = Ndst / 32, kb = item / nb_n, nb = item % nb_n, k0 = 64 * kb, n0 = 32 * nb;
    const int n4 = (lane & 7) * 4; const int src = WIN ? win_src_col(n0 + n4) : (n0 + n4);
#pragma unroll
    for (int i = 0; i < 8; ++i) { const int kk = 8 * i + (lane >> 3);
        f32x4v v = (f32x4v){0.f, 0.f, 0.f, 0.f}; if (src >= 0) { v = *(const f32x4v*)(W + (size_t)(k0 + kk) * Nsrc + src); if (WIN) v = v * kscale[k0 + kk]; }
        scr[kk * 33 + n4] = v.x; scr[kk * 33 + n4 + 1] = v.y; scr[kk * 33 + n4 + 2] = v.z; scr[kk * 33 + n4 + 3] = v.w; }
    asm volatile("s_waitcnt lgkmcnt(0)" ::: "memory");
    const int c = lane & 7;
#pragma unroll
    for (int j = 0; j < 4; ++j) { const int n = (lane >> 3) + 8 * j; const LAS float* s = scr + (8 * c) * 33 + n;
        u32x4v o; o.x = cvt_pk2(s[0 * 33], s[1 * 33]); o.y = cvt_pk2(s[2 * 33], s[3 * 33]); o.z = cvt_pk2(s[4 * 33], s[5 * 33]); o.w = cvt_pk2(s[6 * 33], s[7 * 33]);
        *(u32x4v*)(WT + (size_t)(n0 + n) * K + k0 + 8 * c) = o; }
    asm volatile("s_waitcnt lgkmcnt(0)" ::: "memory");
}
struct TItem { const float* W; bf16* WT; const float* kscale; int K, Nsrc, k0, n0, src; bool win; };
__device__ __forceinline__ TItem cvt_item(KP P, int l, int it, int lane) {
    const int n_in = (l + 1 < DEPTH) ? NIT_WIN : 0; TItem t;
    if (it < n_in) { t.W = P->w_in + (size_t)(l + 1) * DM * DPROJ; t.K = DM; t.Nsrc = DPROJ; t.WT = (bf16*)((unsigned char*)P->out + DO_WIN + (size_t)(l + 1) * DO_WIN_STRIDE); t.kscale = P->norm_w + (l + 1) * DM; t.win = true;
        const int nb_n = NPAD / 32; t.k0 = 64 * (it / nb_n); t.n0 = 32 * (it % nb_n); t.src = win_src_col(t.n0 + (lane & 7) * 4); }
    else { const int i2 = it - n_in; t.W = P->w_out + (size_t)l * DINNER * DM; t.K = DINNER; t.Nsrc = DM; t.WT = (bf16*)(P->ws + WS_WOUT) + (size_t)l * DM * DINNER; t.kscale = nullptr; t.win = false;
        const int nb_n = DM / 32; t.k0 = 64 * (i2 / nb_n); t.n0 = 32 * (i2 % nb_n); t.src = t.n0 + (lane & 7) * 4; }
    return t;
}
__device__ __forceinline__ void cvt_load(const TItem& t, int lane, f32x4v (&v)[8]) {
#pragma unroll
    for (int i = 0; i < 8; ++i) { const int kk = 8 * i + (lane >> 3);
        v[i] = (f32x4v){0.f, 0.f, 0.f, 0.f}; if (t.src >= 0) { v[i] = *(const f32x4v*)(t.W + (size_t)(t.k0 + kk) * t.Nsrc + t.src); if (t.win) v[i] = v[i] * t.kscale[t.k0 + kk]; } }
}
__device__ __forceinline__ void cvt_finish(const TItem& t, int lane, const f32x4v (&v)[8], LAS float* scr) {
    const int n4 = (lane & 7) * 4;
#pragma unroll
    for (int i = 0; i < 8; ++i) { const int kk = 8 * i + (lane >> 3);
        scr[kk * 33 + n4] = v[i].x; scr[kk * 33 + n4 + 1] = v[i].y; scr[kk * 33 + n4 + 2] = v[i].z; scr[kk * 33 + n4 + 3] = v[i].w; }
    asm volatile("s_waitcnt lgkmcnt(0)" ::: "memory");
    const int c = lane & 7;
#pragma unroll
    for (int j = 0; j < 4; ++j) { const int n = (lane >> 3) + 8 * j; const LAS float* sp = scr + (8 * c) * 33 + n;
        u32x4v o; o.x = cvt_pk2(sp[0 * 33], sp[1 * 33]); o.y = cvt_pk2(sp[2 * 33], sp[3 * 33]); o.z = cvt_pk2(sp[4 * 33], sp[5 * 33]); o.w = cvt_pk2(sp[6 * 33], sp[7 * 33]);
        *(u32x4v*)(t.WT + (size_t)(t.n0 + n) * t.K + t.k0 + 8 * c) = o; }
    asm volatile("s_waitcnt lgkmcnt(0)" ::: "memory");
}
__device__ __forceinline__ void phase_prologue(KP P, int bid, int nblk, LAS unsigned char* lds) {
    const int tid = opaque_tid(), lane = tid & 63, wave = tid >> 6;
    const int gw = bid * 8 + wave, ngw = nblk * 8;
    LAS float* scr = (LAS float*)(lds + wave * 16384);
    bf16* hb = (bf16*)((unsigned char*)P->out + DO_HB); float* rstd0 = (float*)(P->ws + WS_RSTD0);
    { int m = gw;
      for (; m + 7 * ngw < NTOK; m += 8 * ngw) rows_to_bf16_rstd<8>(P->x, hb, rstd0, m, ngw, lane);
      for (; m + 3 * ngw < NTOK; m += 4 * ngw) rows_to_bf16_rstd<4>(P->x, hb, rstd0, m, ngw, lane);
      for (; m < NTOK; m += ngw) rows_to_bf16_rstd<1>(P->x, hb, rstd0, m, 0, lane); }
    for (int it = gw; it < NIT_WIN; it += ngw)
        transpose_item<true>(P->w_in, DM, DPROJ, NPAD, (bf16*)((unsigned char*)P->out + DO_WIN), scr, it, lane, P->norm_w);
}
constexpr int CVT_BATCH = 1;
__device__ __forceinline__ void convert_weights_late(KP P, int l, int gw, int ngw, LAS unsigned char* lds) {
    const int tid = opaque_tid(), lane = tid & 63, wave = tid >> 6;
    LAS float* scr = (LAS float*)(lds + wave * 16384);
    const int n_in = (l + 1 < DEPTH) ? NIT_WIN : 0;
    for (int it = gw; it < n_in + NIT_WOUT; it += ngw) {
        if (it < n_in) transpose_item<true>(P->w_in + (size_t)(l + 1) * DM * DPROJ, DM, DPROJ, NPAD, (bf16*)((unsigned char*)P->out + DO_WIN + (size_t)(l + 1) * DO_WIN_STRIDE), scr, it, lane, P->norm_w + (l + 1) * DM);
        else transpose_item<false>(P->w_out + (size_t)l * DINNER * DM, DINNER, DM, DM, (bf16*)(P->ws + WS_WOUT) + (size_t)l * DM * DINNER, scr, it - n_in, lane, nullptr);
    }
}
__device__ __forceinline__ void convert_weights_queue(KP P, int l, LAS unsigned char* lds) {
    const int tid = opaque_tid(), lane = tid & 63, wave = tid >> 6;
    LAS float* scr = (LAS float*)(lds + wave * 16384);
    volatile LAS int* slot = (volatile LAS int*)(lds + 8 * 16384);
    const int ntot = ((l + 1 < DEPTH) ? NIT_WIN : 0) + NIT_WOUT;
    unsigned* ctr = (unsigned*)(P->ws + WS_CTL) + 64 + 32 * l;
    for (;;) {
        if (tid == 0) *slot = (int)__hip_atomic_fetch_add(ctr, 16u, __ATOMIC_RELAXED, __HIP_MEMORY_SCOPE_AGENT);
        __syncthreads();
        const int base = __builtin_amdgcn_readfirstlane(*slot);
        __syncthreads();
        if (base >= ntot) break;
        const int i0 = base + wave, i1 = base + 8 + wave;
        f32x4v va[8], vb[8]; TItem ta, tb;
        if (i0 < ntot) { ta = cvt_item(P, l, i0, lane); cvt_load(ta, lane, va); }
        if (i1 < ntot) { tb = cvt_item(P, l, i1, lane); cvt_load(tb, lane, vb); }
        if (i0 < ntot) cvt_finish(ta, lane, va, scr);
        if (i1 < ntot) cvt_finish(tb, lane, vb, scr);
    }
}
__device__ __forceinline__ void phase_gemm_in(KP P, int l, int bid, int nblk, LAS unsigned char* lds) {
    pg8::Gemm g{(const bf16*)((unsigned char*)P->out + DO_HB), (const bf16*)((unsigned char*)P->out + DO_WIN + (size_t)l * DO_WIN_STRIDE), NTOK, NPAD, DM, DM};
    pg8::StaticOrder S; S.init(NTOK, NPAD, nblk, bid);
    LAS float* rtab = (LAS float*)(lds + 131072);
    { const int tid = opaque_tid(); const float* rstd0 = (const float*)(P->ws + WS_RSTD0); const float* ssq = (const float*)(P->ws + WS_SSQ);
      const int nunit = min(((NTOK / 256) * (NPAD / 256) + nblk - 1) / nblk, 31);
      for (int e = tid; e < nunit * 256; e += 512) { pg8::Unit u; const int i = e >> 8;
          if (S.next(i, u)) { const int row = u.pm * 256 + (e & 255); float r;
              if (l == 0) r = rstd0[row];
              else { float sum = 0.f;
#pragma unroll
                  for (int p = 0; p < 16; ++p) sum += ssq[(size_t)p * NTOK + row];
                  r = 1.0f / sqrtf(sum * (1.0f / DM) + EPS); }
              rtab[e] = r; } }
      __syncthreads(); }
    EpiProj E{(bf16*)(P->ws + WS_PROJ), (float*)(P->ws + WS_GATES), rtab, (bf16*)(P->ws + WS_HALO)};
    pg8::gemm_phase<EpiProj, pg8::StaticOrder, true, true>(lds, g, S, E);
}
__device__ __forceinline__ void phase_gemm_out(KP P, int l, int bid, int nblk, LAS unsigned char* lds) {
    pg8::Gemm g{(const bf16*)(P->ws + WS_PROJ), (const bf16*)(P->ws + WS_WOUT) + (size_t)l * DM * DINNER, NTOK, DM, DINNER, PP};
    pg8::StaticOrder S; S.init(NTOK, DM, nblk, bid);
    EpiRes E{(bf16*)((unsigned char*)P->out + DO_HB), (float*)(P->ws + WS_SSQ), (bf16*)(P->ws + WS_PROJ + 4096), (l == DEPTH - 1) ? 1 : 0};
    pg8::gemm_phase<EpiRes, pg8::StaticOrder, false, true>(lds, g, S, E);
}
__device__ __forceinline__ void phase_final(KP P, int bid, int nblk) {
    const int tid = opaque_tid(), lane = tid & 63, wave = tid >> 6;
    const int gw = bid * 8 + wave, ngw = nblk * 8;
    const float* ssq = (const float*)(P->ws + WS_SSQ);
    f32x4v wv[4];
#pragma unroll
    for (int j = 0; j < 4; ++j) wv[j] = *((const f32x4v*)P->final_norm_w + 2 * lane + (j & 1) + 128 * (j >> 1));
    for (int m0 = gw; m0 < NTOK; m0 += 2 * ngw) {
        u32x4v ha[2], hb_[2]; float sp[2];
#pragma unroll
        for (int q = 0; q < 2; ++q) { const int m = m0 + q * ngw; const u32x4v* hr = (const u32x4v*)(P->ws + WS_PROJ + 4096 + (size_t)m * (PP * 2));
            ha[q] = hr[lane]; hb_[q] = hr[64 + lane]; sp[q] = (lane < 16) ? ssq[(size_t)lane * NTOK + m] : 0.f; }
#pragma unroll
        for (int q = 0; q < 2; ++q) { const int m = m0 + q * ngw;
            const float rs = 1.0f / sqrtf(wave_sum(sp[q]) * (1.0f / DM) + EPS);
            f32x4v* o = (f32x4v*)(P->out + (size_t)m * DM);
            f32x4v v;
            v = (f32x4v){__uint_as_float(ha[q].x << 16), __uint_as_float(ha[q].x & 0xffff0000u), __uint_as_float(ha[q].y << 16), __uint_as_float(ha[q].y & 0xffff0000u)}; o[2 * lane] = v * rs * wv[0];
            v = (f32x4v){__uint_as_float(ha[q].z << 16), __uint_as_float(ha[q].z & 0xffff0000u), __uint_as_float(ha[q].w << 16), __uint_as_float(ha[q].w & 0xffff0000u)}; o[2 * lane + 1] = v * rs * wv[1];
            v = (f32x4v){__uint_as_float(hb_[q].x << 16), __uint_as_float(hb_[q].x & 0xffff0000u), __uint_as_float(hb_[q].y << 16), __uint_as_float(hb_[q].y & 0xffff0000u)}; o[128 + 2 * lane] = v * rs * wv[2];
            v = (f32x4v){__uint_as_float(hb_[q].z << 16), __uint_as_float(hb_[q].z & 0xffff0000u), __uint_as_float(hb_[q].w << 16), __uint_as_float(hb_[q].w & 0xffff0000u)}; o[128 + 2 * lane + 1] = v * rs * wv[3]; }
    }
}
namespace mx {
typedef short bf16x8 __attribute__((ext_vector_type(8)));
typedef float f32x4 __attribute__((ext_vector_type(4)));
constexpr int SEGL = 512, NSEG = SEQ / SEGL, CH = 64, NCH = SEGL / CH;
constexpr int L_QT = 0, L_KT = 17408, L_KTT = 34816, L_VT = 53248, L_PM = 73984, L_ST = 92416, L_VVT = 131584, L_VEC = 150016;
constexpr int V_TOT = 0, V_PRE = 4096, V_POST = 4608, V_MISC = 5120;
constexpr size_t ST_GLA = 0, ST_HGRN = 1048576, ST_ML = 3145728, ST_SSD = 5505024;
constexpr int DS_GLA = 0, DS_HGRN = 8192, DS_ML = 24576, DS_SSD = 25600;

__device__ __forceinline__ int opq(int v) { asm volatile("" : "+v"(v)); return v; }
#define MFMA16(a, b, c) __builtin_amdgcn_mfma_f32_16x16x32_bf16((a), (b), (c), 0, 0, 0)
__device__ __forceinline__ bf16x8 frag(LAS unsigned char* base, int row, int pitch, int ks, int qd) { return *(const LAS bf16x8*)(base + row * pitch + ks * 64 + qd * 16); }
__device__ __forceinline__ int sw64(int row, int byteoff) { return row * 128 + ((((byteoff >> 4) ^ ((row >> 1) & 7)) << 4) | (byteoff & 15)); }
__device__ __forceinline__ bf16x8 frag64(LAS unsigned char* base, int row, int ks, int qd) { return *(const LAS bf16x8*)(base + row * 128 + (((4 * ks + qd) ^ ((row >> 1) & 7)) << 4)); }
template <int PQ> __device__ __forceinline__ int offp(int row, int byteoff) { return PQ == 272 ? row * 272 + byteoff : sw64(row, byteoff); }
template <int PQ> __device__ __forceinline__ bf16x8 fragp(LAS unsigned char* base, int row, int ks, int qd) { return PQ == 272 ? frag(base, row, 272, ks, qd) : frag64(base, row, ks, qd); }
__device__ __forceinline__ unsigned cvtpk(float lo, float hi) { return cvt_pk2(lo, hi); }
__device__ __forceinline__ u32x2v pack4(f32x4 v) { u32x2v w; w.x = cvtpk(v[0], v[1]); w.y = cvtpk(v[2], v[3]); return w; }
__device__ __forceinline__ float lo2f(unsigned w) { return __uint_as_float(w << 16); }
__device__ __forceinline__ float hi2f(unsigned w) { return __uint_as_float(w & 0xffff0000u); }

__device__ __forceinline__ float fexp(float x) { return __builtin_amdgcn_exp2f(x * 1.4426950408889634f); }
__device__ __forceinline__ float flog(float x) { return __builtin_amdgcn_logf(x) * 0.6931471805599453f; }
__device__ __forceinline__ float frcp(float x) { return __builtin_amdgcn_rcpf(x); }
__device__ __forceinline__ float frsq(float x) { return __builtin_amdgcn_rsqf(x); }
__device__ __forceinline__ float fsigmoid(float x) { return frcp(1.f + fexp(-x)); }
__device__ __forceinline__ float fsilu(float x) { return x * frcp(1.f + fexp(-x)); }
__device__ __forceinline__ float flog1pexp(float nx) { return flog(1.f + fexp(nx)); }
__device__ __forceinline__ float flogsigmoid(float x) { return fminf(x, 0.f) - flog1pexp(-fabsf(x)); }
__device__ __forceinline__ float fsoftplus(float x) { return fmaxf(x, 0.f) + flog1pexp(-fabsf(x)); }

constexpr int FLAG_OFF = 8192, FLAG_SSD = 0, FLAG_ML = 64, FLAG_HG = 192, FLAG_GLA = 320;
__device__ __forceinline__ unsigned* flag_ptr(KP P, int fbase, int idx) { return (unsigned*)(P->ws + WS_CTL) + FLAG_OFF + (fbase + idx) * 16; }
__device__ __forceinline__ void st_wt(bf16* p, u32x2v v) { __hip_atomic_store((unsigned long long*)p, ((unsigned long long)v.y << 32) | v.x, __ATOMIC_RELAXED, __HIP_MEMORY_SCOPE_AGENT); }
__device__ __forceinline__ void st_wt_f(float* p, float v) { __hip_atomic_store(p, v, __ATOMIC_RELAXED, __HIP_MEMORY_SCOPE_AGENT); }
__device__ __forceinline__ void publish_item(unsigned* flag, unsigned epoch) {
    asm volatile("s_waitcnt vmcnt(0)" ::: "memory");
    __syncthreads();
    if (threadIdx.x == 0) __hip_atomic_store(flag, epoch, __ATOMIC_RELAXED, __HIP_MEMORY_SCOPE_AGENT);
}
__device__ __forceinline__ void wait_predecessors(unsigned* flag0, int s, unsigned epoch) {
    {
        if ((int)threadIdx.x < 64) {
            if ((int)threadIdx.x < s) { unsigned spins = 0;
                while (__hip_atomic_load(flag0 + threadIdx.x * 16, __ATOMIC_RELAXED, __HIP_MEMORY_SCOPE_AGENT) < epoch) { __builtin_amdgcn_s_sleep(2); if (++spins > (1u << 22)) break; } }
            __builtin_amdgcn_fence(__ATOMIC_ACQUIRE, "agent");
            asm volatile("s_waitcnt vmcnt(0)" ::: "memory");
        }
    }
    __syncthreads();
}

template <int TYPE, bool OUT, bool DRY = false>
__device__ __forceinline__ void pc_item(KP P, int l, int b, int h, int s, LAS unsigned char* lds) {
    if (!OUT && s == NSEG - 1) return;
    constexpr int DK = (TYPE == 0) ? 64 : 128, NDT = DK / 16, PQ = (DK == 128) ? 272 : 144, NKS = DK / 32;
    const int tid = opaque_tid(), lane = tid & 63, w = __builtin_amdgcn_readfirstlane(tid >> 6), r = lane & 15, qd = lane >> 4;
    const int cp = lane, g = w;
    constexpr int NTK = (TYPE == 0) ? 4 : 8;
    const int ck = (TYPE == 0) ? (lane & 31) : lane, th = (TYPE == 0) ? (lane >> 5) : 0;
    const bool kact = true;
    bf16* proj = (bf16*)(P->ws + WS_PROJ);
    LAS float* vtot = (LAS float*)(lds + L_VEC + V_TOT); LAS float* vpre = (LAS float*)(lds + L_VEC + V_PRE); LAS float* vpost = (LAS float*)(lds + L_VEC + V_POST);
    const int QCOL = (TYPE == 0) ? AQc(h) : CQc(h), KCOL = (TYPE == 0) ? AKc(h) : CFc(h), VCOL = (TYPE == 0) ? AVc(h) : CIc(h), ZCOL = ((TYPE == 0) ? ZA : ZC) + h * 128;
    const float qscale = (TYPE == 0) ? 0.125f : 0.08838834764831845f;
    const int idx = (b * 4 + h) * NSEG + s;
    bf16* stbase = (bf16*)((unsigned char*)P->out + DO_STATE) + ((TYPE == 0) ? ST_GLA : ST_HGRN);
    float* dsbase = (float*)(P->ws + WS_MISC) + ((TYPE == 0) ? DS_GLA : DS_HGRN);
    float lb0 = 0.f, lb1 = 0.f, gb0 = 0.f, gb1 = 0.f, gw0[16], gw1[16];
#pragma unroll
    for (int rr = 0; rr < 16; ++rr) { gw0[rr] = 0.f; gw1[rr] = 0.f; }
    if (kact) {
        if (TYPE == 2) {
#pragma unroll
            for (int c2 = 0; c2 < 2; ++c2) { const int ch = h * 128 + 2 * ck + c2;
                float mx_ = -1e30f; for (int i = 0; i < DEPTH; ++i) mx_ = fmaxf(mx_, P->hg_lb[i * 512 + ch]);
                float den = 0.f, num = 0.f; for (int i = 0; i < DEPTH; ++i) { const float e = fexp(P->hg_lb[i * 512 + ch] - mx_); den += e; if (i >= 1 && i <= l) num += e; }
                if (c2 == 0) lb0 = num / den; else lb1 = num / den; }
        } else {
#pragma unroll
            for (int rr = 0; rr < 16; ++rr) { gw0[rr] = P->gla_gate_w[((size_t)l * 16 + rr) * 256 + h * 64 + 2 * ck]; gw1[rr] = P->gla_gate_w[((size_t)l * 16 + rr) * 256 + h * 64 + 2 * ck + 1]; }
            gb0 = P->gla_gate_b[l * 256 + h * 64 + 2 * ck]; gb1 = P->gla_gate_b[l * 256 + h * 64 + 2 * ck + 1];
        }
    }
    unsigned rq[8], rk[8], rv[8]; f32x4 grv = (f32x4){0.f, 0.f, 0.f, 0.f};
#define PC_LOAD(cc) do { const size_t rw_ = (size_t)b * SEQ + (size_t)s * SEGL + (size_t)(cc) * CH + 8 * g; \
        _Pragma("unroll") for (int jj = 0; jj < 8; ++jj) rv[jj] = *(const unsigned*)(proj + (rw_ + jj) * PP + VCOL + 2 * cp); \
        _Pragma("unroll") for (int jj = 0; jj < NTK; ++jj) { const bf16* pr = proj + (rw_ + NTK * th + jj) * PP; \
            rk[jj] = *(const unsigned*)(pr + KCOL + 2 * ck); rq[jj] = OUT ? *(const unsigned*)(pr + QCOL + 2 * ck) : 0u; } \
        if (TYPE == 0) { if (lane < 32) grv = *(const f32x4*)((const float*)(P->ws + WS_GATES) + (rw_ + (lane >> 2)) * 32 + G_GR + (lane & 3) * 4); } } while (0)
    PC_LOAD(0);
    f32x4 S[NDT];
#pragma unroll
    for (int dt = 0; dt < NDT; ++dt) S[dt] = (f32x4){0.f, 0.f, 0.f, 0.f};
    if (OUT) {
        wait_predecessors(flag_ptr(P, (TYPE == 0) ? FLAG_GLA : FLAG_HG, idx - s), s, (unsigned)l + 1u);
        LAS float* vds = (LAS float*)(lds + L_QT);
        for (int i = tid; i < s * DK; i += 512) vds[i] = dsbase[(size_t)(idx - s) * DK + i];
        __syncthreads();
        for (int sp0 = 0; sp0 < s; sp0 += 4) {
            u32x2v raw[4][NDT];
#pragma unroll
            for (int u = 0; u < 4; ++u) { const int sp = (sp0 + u < s) ? sp0 + u : s - 1; const bf16* sb = stbase + (size_t)(idx - s + sp) * (DK * 128);
#pragma unroll
                for (int dt = 0; dt < NDT; ++dt) raw[u][dt] = *(const u32x2v*)(sb + ((size_t)(w * NDT + dt) * 64 + lane) * 4); }
#pragma unroll
            for (int u = 0; u < 4; ++u) if (sp0 + u < s) {
#pragma unroll
                for (int dt = 0; dt < NDT; ++dt) { const f32x4 d4 = *(const LAS f32x4*)(vds + (sp0 + u) * DK + 16 * dt + 4 * qd);
                    const f32x4 ds = (f32x4){lo2f(raw[u][dt].x), hi2f(raw[u][dt].x), lo2f(raw[u][dt].y), hi2f(raw[u][dt].y)}; S[dt] = S[dt] * d4 + ds; } }
        }
        __syncthreads();
    }
    float gsum0 = 0.f, gsum1 = 0.f;
    const int ei = tid >> 3, ecc = tid & 7;
    float nw[16];
#pragma unroll
    for (int k = 0; k < 16; ++k) nw[k] = OUT ? ((TYPE == 0) ? P->gla_norm_w : P->hg_norm_w)[l * 512 + h * 128 + 16 * ecc + k] : 0.f;

    constexpr int L_OB = L_VVT;
    float lg0[8], lg1[8], kk0[8], kk1[8];
#define PC_A1() do { \
        if (TYPE == 0) { if (lane < 32) *(LAS f32x4*)((LAS float*)(lds + L_VEC + V_MISC) + g * 128 + (lane >> 2) * 16 + (lane & 3) * 4) = grv; } \
        if (kact) { \
            if (TYPE == 2) { \
                _Pragma("unroll") for (int jj = 0; jj < 8; ++jj) { const float f0 = lo2f(rk[jj]), f1 = hi2f(rk[jj]); \
                    const float s0 = fsigmoid(f0), s1 = fsigmoid(f1); \
                    lg0[jj] = flog(fmaxf(lb0 + (1.f - lb0) * s0, 1e-30f)); lg1[jj] = flog(fmaxf(lb1 + (1.f - lb1) * s1, 1e-30f)); \
                    kk0[jj] = (1.f - lb0) * (1.f - s0); kk1[jj] = (1.f - lb1) * (1.f - s1); } \
            } else { \
                LAS float* vgr = (LAS float*)(lds + L_VEC + V_MISC) + g * 128; \
                _Pragma("unroll") for (int jj = 0; jj < NTK; ++jj) { const LAS f32x4* gr4 = (const LAS f32x4*)(vgr + (NTK * th + jj) * 16); float a0 = gb0, a1 = gb1; \
                    _Pragma("unroll") for (int r4 = 0; r4 < 4; ++r4) { const f32x4 x = gr4[r4]; \
                        _Pragma("unroll") for (int e = 0; e < 4; ++e) { a0 += x[e] * gw0[4 * r4 + e]; a1 += x[e] * gw1[4 * r4 + e]; } } \
                    lg0[jj] = flogsigmoid(a0) * (1.0f / 16.0f); lg1[jj] = flogsigmoid(a1) * (1.0f / 16.0f); \
                    kk0[jj] = lo2f(rk[jj]); kk1[jj] = hi2f(rk[jj]); } \
            } \
            _Pragma("unroll") for (int jj = 1; jj < NTK; ++jj) { lg0[jj] += lg0[jj - 1]; lg1[jj] += lg1[jj - 1]; } \
            if (TYPE == 0) { const float o0 = __shfl_xor(lg0[NTK - 1], 32), o1 = __shfl_xor(lg1[NTK - 1], 32);       \
                if (th) { _Pragma("unroll") for (int jj = 0; jj < NTK; ++jj) { lg0[jj] += o0; lg1[jj] += o1; } } \
                else { vtot[g * 128 + 2 * ck] = lg0[NTK - 1] + o0; vtot[g * 128 + 2 * ck + 1] = lg1[NTK - 1] + o1; } } \
            else { vtot[g * 128 + 2 * ck] = lg0[NTK - 1]; vtot[g * 128 + 2 * ck + 1] = lg1[NTK - 1]; } \
        } } while (0)
#define PC_A2(cc) do { \
        if (kact) { \
            float base0 = 0.f, base1 = 0.f, ref0 = 0.f, ref1 = 0.f, end0 = 0.f, end1 = 0.f; \
            _Pragma("unroll") for (int gg = 0; gg < 8; ++gg) { const float t0 = vtot[gg * 128 + 2 * ck], t1 = vtot[gg * 128 + 2 * ck + 1]; \
                if (gg < g) { base0 += t0; base1 += t1; } if (gg < 4) { ref0 += t0; ref1 += t1; } end0 += t0; end1 += t1; } \
            float kt0[8], kt1[8]; \
            _Pragma("unroll") for (int jj = 0; jj < NTK; ++jj) { const float G0 = base0 + lg0[jj], G1 = base1 + lg1[jj]; \
                kt0[jj] = kk0[jj] * fexp(fminf(ref0 - G0, 80.f)); kt1[jj] = kk1[jj] * fexp(fminf(ref1 - G1, 80.f)); \
                if (OUT) { *(LAS unsigned*)(lds + L_QT + offp<PQ>(8 * g + NTK * th + jj, 4 * ck)) = cvtpk(lo2f(rq[jj]) * qscale * fexp(fminf(G0 - ref0, 80.f)), hi2f(rq[jj]) * qscale * fexp(fminf(G1 - ref1, 80.f))); \
                           *(LAS unsigned*)(lds + L_KT + offp<PQ>(8 * g + NTK * th + jj, 4 * ck)) = cvtpk(kt0[jj], kt1[jj]); } } \
            if (TYPE == 0) { u32x2v t2; \
                t2.x = cvtpk(kt0[0], kt0[1]); t2.y = cvtpk(kt0[2], kt0[3]); *(LAS u32x2v*)(lds + L_KTT + sw64(2 * ck, 16 * g + 8 * th)) = t2; \
                t2.x = cvtpk(kt1[0], kt1[1]); t2.y = cvtpk(kt1[2], kt1[3]); *(LAS u32x2v*)(lds + L_KTT + sw64(2 * ck + 1, 16 * g + 8 * th)) = t2; \
            } else { u32x4v t; \
                t.x = cvtpk(kt0[0], kt0[1]); t.y = cvtpk(kt0[2], kt0[3]); t.z = cvtpk(kt0[4], kt0[5]); t.w = cvtpk(kt0[6], kt0[7]); *(LAS u32x4v*)(lds + L_KTT + (2 * ck) * 128 + ((g ^ (ck & 7)) << 4)) = t; \
                t.x = cvtpk(kt1[0], kt1[1]); t.y = cvtpk(kt1[2], kt1[3]); t.z = cvtpk(kt1[4], kt1[5]); t.w = cvtpk(kt1[6], kt1[7]); *(LAS u32x4v*)(lds + L_KTT + (2 * ck + 1) * 128 + ((g ^ (ck & 7)) << 4)) = t; } \
            if (g == 0 && th == 0) { vpre[2 * ck] = fexp(ref0); vpre[2 * ck + 1] = fexp(ref1); vpost[2 * ck] = fexp(end0 - ref0); vpost[2 * ck + 1] = fexp(end1 - ref1); gsum0 += end0; gsum1 += end1; } \
        } \
        { u32x4v t; \
          t.x = (rv[0] & 0xffffu) | (rv[1] << 16); t.y = (rv[2] & 0xffffu) | (rv[3] << 16); t.z = (rv[4] & 0xffffu) | (rv[5] << 16); t.w = (rv[6] & 0xffffu) | (rv[7] << 16); \
          *(LAS u32x4v*)(lds + L_VT + (2 * cp) * 128 + ((g ^ (cp & 7)) << 4)) = t; \
          t.x = (rv[0] >> 16) | (rv[1] & 0xffff0000u); t.y = (rv[2] >> 16) | (rv[3] & 0xffff0000u); t.z = (rv[4] >> 16) | (rv[5] & 0xffff0000u); t.w = (rv[6] >> 16) | (rv[7] & 0xffff0000u); \
          *(LAS u32x4v*)(lds + L_VT + (2 * cp + 1) * 128 + ((g ^ (cp & 7)) << 4)) = t; } \
        if ((cc) + 1 < NCH) PC_LOAD((cc) + 1); } while (0)
    PC_A1();
    __syncthreads();
    PC_A2(0);
    __syncthreads();
    for (int c = 0; c < NCH; ++c) {
        const size_t rowc = (size_t)b * SEQ + (size_t)s * SEGL + (size_t)c * CH;
        bf16* zp = proj + (rowc + ei) * PP + ZCOL + 16 * ecc;
        u32x4v za = (u32x4v){0u, 0u, 0u, 0u}, zb = za;
        if (OUT) { za = *(const u32x4v*)zp; zb = *(const u32x4v*)(zp + 8); }
#pragma unroll
        for (int dt = 0; dt < NDT; ++dt) { const f32x4 p4 = *(const LAS f32x4*)(vpre + 16 * dt + 4 * qd); S[dt] = S[dt] * p4;
            if (OUT) *(LAS u32x2v*)(lds + L_ST + offp<PQ>(16 * w + r, (16 * dt + 4 * qd) * 2)) = pack4(S[dt]); }
        if (OUT) {
            const int it = w & 3;
#pragma unroll
            for (int j2 = 0; j2 < 2; ++j2) { const int jt = 2 * (w >> 2) + j2; f32x4 acc = (f32x4){0.f, 0.f, 0.f, 0.f};
                if (jt <= it) {
#pragma unroll
                    for (int ks = 0; ks < NKS; ++ks) acc = MFMA16(fragp<PQ>(lds + L_KT, 16 * jt + r, ks, qd), fragp<PQ>(lds + L_QT, 16 * it + r, ks, qd), acc);
                    if (jt == it) {
#pragma unroll
                        for (int rg = 0; rg < 4; ++rg) if (4 * qd + rg > r) acc[rg] = 0.f; }
                }
                *(LAS u32x2v*)(lds + L_PM + sw64(16 * it + r, (16 * jt + 4 * qd) * 2)) = pack4(acc); }
            __syncthreads();
        }
        f32x4 o[4];
        if (OUT) {
#pragma unroll
            for (int it = 0; it < 4; ++it) { o[it] = (f32x4){0.f, 0.f, 0.f, 0.f};
#pragma unroll
                for (int ks = 0; ks < 2; ++ks) if (ks == 0 || it >= 2) o[it] = MFMA16(frag64(lds + L_VT, 16 * w + r, ks, qd), frag64(lds + L_PM, 16 * it + r, ks, qd), o[it]);
#pragma unroll
                for (int ks = 0; ks < NKS; ++ks) o[it] = MFMA16(fragp<PQ>(lds + L_ST, 16 * w + r, ks, qd), fragp<PQ>(lds + L_QT, 16 * it + r, ks, qd), o[it]); }
        }
#pragma unroll
        for (int dt = 0; dt < NDT; ++dt) {
#pragma unroll
            for (int ks = 0; ks < 2; ++ks) S[dt] = MFMA16(frag64(lds + L_KTT, 16 * dt + r, ks, qd), frag64(lds + L_VT, 16 * w + r, ks, qd), S[dt]);
            const f32x4 q4 = *(const LAS f32x4*)(vpost + 16 * dt + 4 * qd); S[dt] = S[dt] * q4; }
        if (c + 1 < NCH) PC_A1();
        if (OUT) {
#pragma unroll
            for (int it = 0; it < 4; ++it) *(LAS u32x2v*)(lds + L_OB + (16 * it + r) * 272 + (16 * w + 4 * qd) * 2) = pack4(o[it]);
        }
        __syncthreads();
        if (c + 1 < NCH) PC_A2(c + 1);
        if (OUT) {
            const u32x4v oa = *(const LAS u32x4v*)(lds + L_OB + ei * 272 + ecc * 32), ob = *(const LAS u32x4v*)(lds + L_OB + ei * 272 + ecc * 32 + 16);
            float ov[16] = {lo2f(oa.x), hi2f(oa.x), lo2f(oa.y), hi2f(oa.y), lo2f(oa.z), hi2f(oa.z), lo2f(oa.w), hi2f(oa.w), lo2f(ob.x), hi2f(ob.x), lo2f(ob.y), hi2f(ob.y), lo2f(ob.z), hi2f(ob.z), lo2f(ob.w), hi2f(ob.w)};
            float ss = 0.f;
#pragma unroll
            for (int k = 0; k < 16; ++k) ss += ov[k] * ov[k];
            ss += __shfl_xor(ss, 1); ss += __shfl_xor(ss, 2); ss += __shfl_xor(ss, 4);
            const float rs = frsq(ss * (1.0f / 128.0f) + EPS);
            const float zv[16] = {lo2f(za.x), hi2f(za.x), lo2f(za.y), hi2f(za.y), lo2f(za.z), hi2f(za.z), lo2f(za.w), hi2f(za.w), lo2f(zb.x), hi2f(zb.x), lo2f(zb.y), hi2f(zb.y), lo2f(zb.z), hi2f(zb.z), lo2f(zb.w), hi2f(zb.w)};
            float y[16];
#pragma unroll
            for (int k = 0; k < 16; ++k) y[k] = ov[k] * rs * nw[k] * fsilu(zv[k]);
            u32x4v ya, yb; ya.x = cvtpk(y[0], y[1]); ya.y = cvtpk(y[2], y[3]); ya.z = cvtpk(y[4], y[5]); ya.w = cvtpk(y[6], y[7]); yb.x = cvtpk(y[8], y[9]); yb.y = cvtpk(y[10], y[11]); yb.z = cvtpk(y[12], y[13]); yb.w = cvtpk(y[14], y[15]);
            if (DRY) { asm volatile("" :: "v"(ya.x), "v"(ya.y), "v"(ya.z), "v"(ya.w), "v"(yb.x), "v"(yb.y), "v"(yb.z), "v"(yb.w)); } else { *(u32x4v*)zp = ya; *(u32x4v*)(zp + 8) = yb; }
        }
        __syncthreads();
    }
    if (!OUT) {
        bf16* sb = stbase + (size_t)idx * (DK * 128);
#pragma unroll
        for (int dt = 0; dt < NDT; ++dt) st_wt(sb + ((size_t)(w * NDT + dt) * 64 + lane) * 4, pack4(S[dt]));
        if (g == 0 && th == 0) { st_wt_f(dsbase + (size_t)idx * DK + 2 * ck, fexp(gsum0)); st_wt_f(dsbase + (size_t)idx * DK + 2 * ck + 1, fexp(gsum1)); }
        publish_item(flag_ptr(P, (TYPE == 0) ? FLAG_GLA : FLAG_HG, idx), (unsigned)l + 1u);
    }
    __syncthreads();
#undef PC_LOAD
#undef PC_A1
#undef PC_A2
}

template <int TYPE>
__device__ __forceinline__ void pc_pass1(KP P, int l, int b, int h, int s, LAS unsigned char* lds) {
    if (s == NSEG - 1) return;
    constexpr int DK = (TYPE == 0) ? 64 : 128, NDT = DK / 16;
    const int tid = opaque_tid(), lane = tid & 63, w = __builtin_amdgcn_readfirstlane(tid >> 6), r = lane & 15, qd = lane >> 4;
    const int cp = lane, g = w;
    constexpr int NTK = (TYPE == 0) ? 4 : 8;
    const int ck = (TYPE == 0) ? (lane & 31) : lane, th = (TYPE == 0) ? (lane >> 5) : 0;
    bf16* proj = (bf16*)(P->ws + WS_PROJ);
    const int KCOL = (TYPE == 0) ? AKc(h) : CFc(h), VCOL = (TYPE == 0) ? AVc(h) : CIc(h);
    const int idx = (b * 4 + h) * NSEG + s;
    bf16* stbase = (bf16*)((unsigned char*)P->out + DO_STATE) + ((TYPE == 0) ? ST_GLA : ST_HGRN);
    float* dsbase = (float*)(P->ws + WS_MISC) + ((TYPE == 0) ? DS_GLA : DS_HGRN);
    float lb0 = 0.f, lb1 = 0.f, gb0 = 0.f, gb1 = 0.f, gw0[16], gw1[16];
#pragma unroll
    for (int rr = 0; rr < 16; ++rr) { gw0[rr] = 0.f; gw1[rr] = 0.f; }
    if (TYPE == 2) {
#pragma unroll
        for (int c2 = 0; c2 < 2; ++c2) { const int ch = h * 128 + 2 * ck + c2;
            float mx_ = -1e30f; for (int i = 0; i < DEPTH; ++i) mx_ = fmaxf(mx_, P->hg_lb[i * 512 + ch]);
            float den = 0.f, num = 0.f; for (int i = 0; i < DEPTH; ++i) { const float e = fexp(P->hg_lb[i * 512 + ch] - mx_); den += e; if (i >= 1 && i <= l) num += e; }
            if (c2 == 0) lb0 = num / den; else lb1 = num / den; }
    } else {
#pragma unroll
        for (int rr = 0; rr < 16; ++rr) { gw0[rr] = P->gla_gate_w[((size_t)l * 16 + rr) * 256 + h * 64 + 2 * ck]; gw1[rr] = P->gla_gate_w[((size_t)l * 16 + rr) * 256 + h * 64 + 2 * ck + 1]; }
        gb0 = P->gla_gate_b[l * 256 + h * 64 + 2 * ck]; gb1 = P->gla_gate_b[l * 256 + h * 64 + 2 * ck + 1];
    }
    f32x4 S[NDT];
#pragma unroll
    for (int dt = 0; dt < NDT; ++dt) S[dt] = (f32x4){0.f, 0.f, 0.f, 0.f};
    float gsum0 = 0.f, gsum1 = 0.f;
#define P1_KTT(par) ((par) ? L_ST : L_KTT)
#define P1_VT(par) ((par) ? L_ST + 16384 : L_VT)
#define P1_TOT(par) ((LAS float*)(lds + ((par) ? L_QT : L_VEC + V_TOT)))
#define P1_PRE(par) ((LAS float*)(lds + ((par) ? L_QT + 4096 : L_VEC + V_PRE)))
#define P1_POST(par) ((LAS float*)(lds + ((par) ? L_QT + 4608 : L_VEC + V_POST)))
    unsigned rk[8], rv[2][8]; f32x4 grv = (f32x4){0.f, 0.f, 0.f, 0.f};
    float lg0[8], lg1[8], kk0[8], kk1[8];
#define P1_LOAD(cc, par) do { const size_t rw_ = (size_t)b * SEQ + (size_t)s * SEGL + (size_t)(cc) * CH + 8 * g; \
        _Pragma("unroll") for (int jj = 0; jj < 8; ++jj) rv[par][jj] = *(const unsigned*)(proj + (rw_ + jj) * PP + VCOL + 2 * cp); \
        _Pragma("unroll") for (int jj = 0; jj < NTK; ++jj) rk[jj] = *(const unsigned*)(proj + (rw_ + NTK * th + jj) * PP + KCOL + 2 * ck); \
        if (TYPE == 0) { if (lane < 32) grv = *(const f32x4*)((const float*)(P->ws + WS_GATES) + (rw_ + (lane >> 2)) * 32 + G_GR + (lane & 3) * 4); } } while (0)
#define P1_A1(par) do { LAS float* vtot_ = P1_TOT(par); \
        if (TYPE == 0) { if (lane < 32) *(LAS f32x4*)((LAS float*)(lds + L_VEC + V_MISC) + g * 128 + (lane >> 2) * 16 + (lane & 3) * 4) = grv; } \
        if (TYPE == 2) { \
            _Pragma("unroll") for (int jj = 0; jj < 8; ++jj) { const float f0 = lo2f(rk[jj]), f1 = hi2f(rk[jj]); \
                const float s0 = fsigmoid(f0), s1 = fsigmoid(f1); \
                lg0[jj] = flog(fmaxf(lb0 + (1.f - lb0) * s0, 1e-30f)); lg1[jj] = flog(fmaxf(lb1 + (1.f - lb1) * s1, 1e-30f)); \
                kk0[jj] = (1.f - lb0) * (1.f - s0); kk1[jj] = (1.f - lb1) * (1.f - s1); } \
        } else { \
            LAS float* vgr = (LAS float*)(lds + L_VEC + V_MISC) + g * 128; \
            _Pragma("unroll") for (int jj = 0; jj < NTK; ++jj) { const LAS f32x4* gr4 = (const LAS f32x4*)(vgr + (NTK * th + jj) * 16); float a0 = gb0, a1 = gb1; \
                _Pragma("unroll") for (int r4 = 0; r4 < 4; ++r4) { const f32x4 x = gr4[r4]; \
                    _Pragma("unroll") for (int e = 0; e < 4; ++e) { a0 += x[e] * gw0[4 * r4 + e]; a1 += x[e] * gw1[4 * r4 + e]; } } \
                lg0[jj] = flogsigmoid(a0) * (1.0f / 16.0f); lg1[jj] = flogsigmoid(a1) * (1.0f / 16.0f); \
                kk0[jj] = lo2f(rk[jj]); kk1[jj] = hi2f(rk[jj]); } \
        } \
        _Pragma("unroll") for (int jj = 1; jj < NTK; ++jj) { lg0[jj] += lg0[jj - 1]; lg1[jj] += lg1[jj - 1]; } \
        if (TYPE == 0) { const float o0 = __shfl_xor(lg0[NTK - 1], 32), o1 = __shfl_xor(lg1[NTK - 1], 32); \
            if (th) { _Pragma("unroll") for (int jj = 0; jj < NTK; ++jj) { lg0[jj] += o0; lg1[jj] += o1; } } \
            else { vtot_[g * 128 + 2 * ck] = lg0[NTK - 1] + o0; vtot_[g * 128 + 2 * ck + 1] = lg1[NTK - 1] + o1; } } \
        else { vtot_[g * 128 + 2 * ck] = lg0[NTK - 1]; vtot_[g * 128 + 2 * ck + 1] = lg1[NTK - 1]; } } while (0)
#define P1_A2(par) do { const LAS float* vtot_ = P1_TOT(par); \
        float base0 = 0.f, base1 = 0.f, ref0 = 0.f, ref1 = 0.f, end0 = 0.f, end1 = 0.f; \
        _Pragma("unroll") for (int gg = 0; gg < 8; ++gg) { const float t0 = vtot_[gg * 128 + 2 * ck], t1 = vtot_[gg * 128 + 2 * ck + 1]; \
            if (gg < g) { base0 += t0; base1 += t1; } if (gg < 4) { ref0 += t0; ref1 += t1; } end0 += t0; end1 += t1; } \
        float kt0[8], kt1[8]; \
        _Pragma("unroll") for (int jj = 0; jj < NTK; ++jj) { const float G0 = base0 + lg0[jj], G1 = base1 + lg1[jj]; \
            kt0[jj] = kk0[jj] * fexp(fminf(ref0 - G0, 80.f)); kt1[jj] = kk1[jj] * fexp(fminf(ref1 - G1, 80.f)); } \
        if (TYPE == 0) { u32x2v t2; \
            t2.x = cvtpk(kt0[0], kt0[1]); t2.y = cvtpk(kt0[2], kt0[3]); *(LAS u32x2v*)(lds + P1_KTT(par) + sw64(2 * ck, 16 * g + 8 * th)) = t2; \
            t2.x = cvtpk(kt1[0], kt1[1]); t2.y = cvtpk(kt1[2], kt1[3]); *(LAS u32x2v*)(lds + P1_KTT(par) + sw64(2 * ck + 1, 16 * g + 8 * th)) = t2; \
        } else { u32x4v t; \
            t.x = cvtpk(kt0[0], kt0[1]); t.y = cvtpk(kt0[2], kt0[3]); t.z = cvtpk(kt0[4], kt0[5]); t.w = cvtpk(kt0[6], kt0[7]); *(LAS u32x4v*)(lds + P1_KTT(par) + (2 * ck) * 128 + ((g ^ (ck & 7)) << 4)) = t; \
            t.x = cvtpk(kt1[0], kt1[1]); t.y = cvtpk(kt1[2], kt1[3]); t.z = cvtpk(kt1[4], kt1[5]); t.w = cvtpk(kt1[6], kt1[7]); *(LAS u32x4v*)(lds + P1_KTT(par) + (2 * ck + 1) * 128 + ((g ^ (ck & 7)) << 4)) = t; } \
        if (g == 0 && th == 0) { LAS float* vpre_ = P1_PRE(par); LAS float* vpost_ = P1_POST(par); \
            vpre_[2 * ck] = fexp(ref0); vpre_[2 * ck + 1] = fexp(ref1); vpost_[2 * ck] = fexp(end0 - ref0); vpost_[2 * ck + 1] = fexp(end1 - ref1); gsum0 += end0; gsum1 += end1; } \
        { u32x4v t; \
          t.x = (rv[par][0] & 0xffffu) | (rv[par][1] << 16); t.y = (rv[par][2] & 0xffffu) | (rv[par][3] << 16); t.z = (rv[par][4] & 0xffffu) | (rv[par][5] << 16); t.w = (rv[par][6] & 0xffffu) | (rv[par][7] << 16); \
          *(LAS u32x4v*)(lds + P1_VT(par) + (2 * cp) * 128 + ((g ^ (cp & 7)) << 4)) = t; \
          t.x = (rv[par][0] >> 16) | (rv[par][1] & 0xffff0000u); t.y = (rv[par][2] >> 16) | (rv[par][3] & 0xffff0000u); t.z = (rv[par][4] >> 16) | (rv[par][5] & 0xffff0000u); t.w = (rv[par][6] >> 16) | (rv[par][7] & 0xffff0000u); \
          *(LAS u32x4v*)(lds + P1_VT(par) + (2 * cp + 1) * 128 + ((g ^ (cp & 7)) << 4)) = t; } } while (0)
#define P1_E(par) do { const LAS float* vpre_ = P1_PRE(par); const LAS float* vpost_ = P1_POST(par); \
        _Pragma("unroll") for (int dt = 0; dt < NDT; ++dt) { const f32x4 p4 = *(const LAS f32x4*)(vpre_ + 16 * dt + 4 * qd); S[dt] = S[dt] * p4; } \
        _Pragma("unroll") for (int dt = 0; dt < NDT; ++dt) { \
            _Pragma("unroll") for (int ks = 0; ks < 2; ++ks) S[dt] = MFMA16(frag64(lds + P1_KTT(par), 16 * dt + r, ks, qd), frag64(lds + P1_VT(par), 16 * w + r, ks, qd), S[dt]); \
            const f32x4 q4 = *(const LAS f32x4*)(vpost_ + 16 * dt + 4 * qd); S[dt] = S[dt] * q4; } } while (0)
    P1_LOAD(0, 0);
    P1_A1(0);
    P1_LOAD(1, 1);
    __syncthreads();
    P1_A2(0);
    P1_A1(1);
    P1_LOAD(2, 0);
    __syncthreads();
    for (int c = 0; c < NCH; c += 2) {
        P1_E(0);
        P1_A2(1);
        if (c + 2 < NCH) P1_A1(0);
        if (c + 3 < NCH) P1_LOAD(c + 3, 1);
        __syncthreads();
        P1_E(1);
        if (c + 2 < NCH) P1_A2(0);
        if (c + 3 < NCH) P1_A1(1);
        if (c + 4 < NCH) P1_LOAD(c + 4, 0);
        __syncthreads();
    }
    {
        bf16* sb = stbase + (size_t)idx * (DK * 128);
#pragma unroll
        for (int dt = 0; dt < NDT; ++dt) st_wt(sb + ((size_t)(w * NDT + dt) * 64 + lane) * 4, pack4(S[dt]));
        if (g == 0 && th == 0) { st_wt_f(dsbase + (size_t)idx * DK + 2 * ck, fexp(gsum0)); st_wt_f(dsbase + (size_t)idx * DK + 2 * ck + 1, fexp(gsum1)); }
        publish_item(flag_ptr(P, (TYPE == 0) ? FLAG_GLA : FLAG_HG, idx), (unsigned)l + 1u);
    }
    __syncthreads();
#undef P1_KTT
#undef P1_VT
#undef P1_TOT
#undef P1_PRE
#undef P1_POST
#undef P1_LOAD
#undef P1_A1
#undef P1_A2
#undef P1_E
}

template <bool OUT, bool DRY = false>
__device__ __forceinline__ void ml_item(KP P, int l, int b, int h, int s, LAS unsigned char* lds) {
    if (!OUT && s == NSEG - 1) return;
    constexpr int PQ = 272;
    const int tid = opaque_tid(), lane = tid & 63, w = __builtin_amdgcn_readfirstlane(tid >> 6), r = lane & 15, qd = lane >> 4;
    const int cp = lane, g = w;
    bf16* proj = (bf16*)(P->ws + WS_PROJ); const float* gts = (const float*)(P->ws + WS_GATES);
    LAS float* vg = (LAS float*)(lds + L_VEC + V_TOT);
    LAS float* vemr = (LAS float*)(lds + L_VEC + V_MISC);
    LAS float* vden = vemr + 64;
    const int idx = (b * 4 + h) * NSEG + s;
    bf16* stbase = (bf16*)((unsigned char*)P->out + DO_STATE) + ST_ML;
    float* dsbase = (float*)(P->ws + WS_MISC) + DS_ML;
    float wq[4][2], wk[4][2], bq[2], bk[2];
#pragma unroll
    for (int c2 = 0; c2 < 2; ++c2) { const int ch = h * 128 + 2 * cp + c2;
#pragma unroll
        for (int kk = 0; kk < 4; ++kk) { wq[kk][c2] = P->ml_conv_w[((size_t)l * 4 + kk) * 1024 + ch]; wk[kk][c2] = P->ml_conv_w[((size_t)l * 4 + kk) * 1024 + 512 + ch]; }
        bq[c2] = P->ml_conv_b[l * 1024 + ch]; bk[c2] = P->ml_conv_b[l * 1024 + 512 + ch]; }
    const float ib = P->ml_i_b[l * 4 + h], fb = P->ml_f_b[l * 4 + h];
    unsigned rq[11], rk[11], rv[8]; float gpre = 0.f;
#define ML_LOAD(cc) do { const size_t rw_ = (size_t)b * SEQ + (size_t)s * SEGL + (size_t)(cc) * CH + 8 * g; const int ts_ = s * SEGL + (cc) * CH + 8 * g; \
        _Pragma("unroll") for (int jj = 0; jj < 11; ++jj) { const bool ok = (ts_ + jj - 3) >= 0; const bf16* pr = proj + (rw_ + jj - 3) * PP; \
            rk[jj] = ok ? *(const unsigned*)(pr + BKc(h) + 2 * cp) : 0u; rq[jj] = (ok && OUT) ? *(const unsigned*)(pr + BQc(h) + 2 * cp) : 0u; } \
        _Pragma("unroll") for (int jj = 0; jj < 8; ++jj) rv[jj] = *(const unsigned*)(proj + (rw_ + jj) * PP + BVc(h) + 2 * cp); \
        if (lane < 16) gpre = gts[(rw_ + (lane >> 1)) * 32 + ((lane & 1) ? G_BF : G_BI) + h]; } while (0)
    ML_LOAD(0);
    f32x4 S[8], Sx = (f32x4){0.f, 0.f, 0.f, 0.f};
#pragma unroll
    for (int dt = 0; dt < 8; ++dt) S[dt] = (f32x4){0.f, 0.f, 0.f, 0.f};
    float m = 0.f, bsum = 0.f;
    if (OUT) {
        wait_predecessors(flag_ptr(P, FLAG_ML, idx - s), s, (unsigned)l + 1u);
        LAS float* vds = (LAS float*)(lds + L_QT);
        for (int i = tid; i < s * 4; i += 512) vds[i] = dsbase[(size_t)(idx - s) * 4 + i];
        __syncthreads();
        for (int sp0 = 0; sp0 < s; sp0 += 4) {
            u32x2v raw[4][9];
#pragma unroll
            for (int u = 0; u < 4; ++u) { const int sp = (sp0 + u < s) ? sp0 + u : s - 1; const bf16* sb = stbase + (size_t)(idx - s + sp) * 18432;
#pragma unroll
                for (int dt = 0; dt < 9; ++dt) raw[u][dt] = *(const u32x2v*)(sb + ((size_t)(w * 9 + dt) * 64 + lane) * 4); }
#pragma unroll
            for (int u = 0; u < 4; ++u) if (sp0 + u < s) {
                const float ml_ = vds[(sp0 + u) * 4], bs = vds[(sp0 + u) * 4 + 1];
                const float mn = fmaxf(bs + m, ml_), f1 = fexp(bs + m - mn), f2 = fexp(ml_ - mn); m = mn;
#pragma unroll
                for (int dt = 0; dt < 9; ++dt) { const f32x4 ds = (f32x4){lo2f(raw[u][dt].x), hi2f(raw[u][dt].x), lo2f(raw[u][dt].y), hi2f(raw[u][dt].y)};
                    if (dt < 8) S[dt] = S[dt] * f1 + ds * f2; else Sx = Sx * f1 + ds * f2; } }
        }
        __syncthreads();
    }
    if (tid < 128) { const int rr = tid >> 3, ck = tid & 7; const unsigned one2 = (rr == 0) ? 0x3f803f80u : 0u; u32x4v t; t.x = one2; t.y = one2; t.z = one2; t.w = one2; *(LAS u32x4v*)(lds + L_VT + (128 + rr) * 128 + 16 * ck) = t; }
    const int ei = tid >> 3, ecc = tid & 7;
    float nw[16];
#pragma unroll
    for (int k = 0; k < 16; ++k) nw[k] = OUT ? P->ml_norm_w[l * 512 + h * 128 + 16 * ecc + k] : 0.f;

    for (int c = 0; c < NCH; ++c) {
        const size_t rowc = (size_t)b * SEQ + (size_t)s * SEGL + (size_t)c * CH;
        float ig[8], bl[8];
        const float gval = (lane & 1) ? flogsigmoid(gpre + fb) : gpre + ib;
#pragma unroll
        for (int jj = 0; jj < 8; ++jj) { ig[jj] = __int_as_float(__builtin_amdgcn_readlane(__float_as_int(gval), 2 * jj)); bl[jj] = __int_as_float(__builtin_amdgcn_readlane(__float_as_int(gval), 2 * jj + 1)); }
#pragma unroll
        for (int jj = 1; jj < 8; ++jj) bl[jj] += bl[jj - 1];
        float lpm[8];
        lpm[0] = ig[0] - bl[0];
#pragma unroll
        for (int jj = 1; jj < 8; ++jj) lpm[jj] = fmaxf(lpm[jj - 1], ig[jj] - bl[jj]);
        if (lane == 0) { vg[g] = bl[7]; vg[8 + g] = lpm[7]; }
        __syncthreads();
        float base = 0.f, cmprev = -1e30f, blast = 0.f, M = m;
#pragma unroll
        for (int gg = 0; gg < 8; ++gg) { const float t = vg[gg], lm = vg[8 + gg]; const float ag = lm - blast;
            if (gg < g) cmprev = fmaxf(cmprev, ag); M = fmaxf(M, ag); if (gg < g) base += t; blast += t; }
        float kt0[8], kt1[8];
#pragma unroll
        for (int jj = 0; jj < 8; ++jj) {
            const float bj = base + bl[jj]; const float cmj = fmaxf(cmprev, lpm[jj] - base); const float mu = fmaxf(cmj, m);
            const float ek = fexp(ig[jj] - bj - M), eq = fexp(M - mu);
            float yk0 = bk[0], yk1 = bk[1], yq0 = bq[0], yq1 = bq[1];
#pragma unroll
            for (int kk = 0; kk < 4; ++kk) { yk0 += wk[kk][0] * lo2f(rk[jj + kk]); yk1 += wk[kk][1] * hi2f(rk[jj + kk]); yq0 += wq[kk][0] * lo2f(rq[jj + kk]); yq1 += wq[kk][1] * hi2f(rq[jj + kk]); }
            kt0[jj] = fsilu(yk0) * 0.08838834764831845f * ek; kt1[jj] = fsilu(yk1) * 0.08838834764831845f * ek;
            if (OUT) { *(LAS unsigned*)(lds + L_QT + (8 * g + jj) * PQ + 4 * cp) = cvtpk(fsilu(yq0) * eq, fsilu(yq1) * eq);
                       *(LAS unsigned*)(lds + L_KT + (8 * g + jj) * PQ + 4 * cp) = cvtpk(kt0[jj], kt1[jj]);
                       if (lane == 0) vemr[8 * g + jj] = fexp(-bj - mu); } }
        { u32x4v t;
          t.x = cvtpk(kt0[0], kt0[1]); t.y = cvtpk(kt0[2], kt0[3]); t.z = cvtpk(kt0[4], kt0[5]); t.w = cvtpk(kt0[6], kt0[7]); *(LAS u32x4v*)(lds + L_KTT + (2 * cp) * 128 + ((g ^ (cp & 7)) << 4)) = t;
          t.x = cvtpk(kt1[0], kt1[1]); t.y = cvtpk(kt1[2], kt1[3]); t.z = cvtpk(kt1[4], kt1[5]); t.w = cvtpk(kt1[6], kt1[7]); *(LAS u32x4v*)(lds + L_KTT + (2 * cp + 1) * 128 + ((g ^ (cp & 7)) << 4)) = t;
          t.x = (rv[0] & 0xffffu) | (rv[1] << 16); t.y = (rv[2] & 0xffffu) | (rv[3] << 16); t.z = (rv[4] & 0xffffu) | (rv[5] << 16); t.w = (rv[6] & 0xffffu) | (rv[7] << 16);
          *(LAS u32x4v*)(lds + L_VT + (2 * cp) * 128 + ((g ^ (cp & 7)) << 4)) = t;
          t.x = (rv[0] >> 16) | (rv[1] & 0xffff0000u); t.y = (rv[2] >> 16) | (rv[3] & 0xffff0000u); t.z = (rv[4] >> 16) | (rv[5] & 0xffff0000u); t.w = (rv[6] >> 16) | (rv[7] & 0xffff0000u);
          *(LAS u32x4v*)(lds + L_VT + (2 * cp + 1) * 128 + ((g ^ (cp & 7)) << 4)) = t; }
        const float pre = fexp(m - M);
        m = blast + M; bsum += blast;
        if (c + 1 < NCH) ML_LOAD(c + 1);
        __syncthreads();
        bf16* zp = proj + (rowc + ei) * PP + ZB + h * 128 + 16 * ecc; const bf16* gp = proj + (rowc + ei) * PP + BOc(h) + 16 * ecc;
        u32x4v za = (u32x4v){0u, 0u, 0u, 0u}, zb = za, ga = za, gb_ = za;
        if (OUT) { za = *(const u32x4v*)zp; zb = *(const u32x4v*)(zp + 8); ga = *(const u32x4v*)gp; gb_ = *(const u32x4v*)(gp + 8); }
#pragma unroll
        for (int dt = 0; dt < 8; ++dt) { S[dt] = S[dt] * pre; if (OUT) *(LAS u32x2v*)(lds + L_ST + (16 * w + r) * PQ + (16 * dt + 4 * qd) * 2) = pack4(S[dt]); }
        Sx = Sx * pre; if (OUT) *(LAS u32x2v*)(lds + L_ST + (128 + r) * PQ + (16 * w + 4 * qd) * 2) = pack4(Sx);
        if (OUT) {
            const int it = w & 3;
#pragma unroll
            for (int j2 = 0; j2 < 2; ++j2) { const int jt = 2 * (w >> 2) + j2; f32x4 acc = (f32x4){0.f, 0.f, 0.f, 0.f};
                if (jt <= it) {
#pragma unroll
                    for (int ks = 0; ks < 4; ++ks) acc = MFMA16(frag(lds + L_KT, 16 * jt + r, PQ, ks, qd), frag(lds + L_QT, 16 * it + r, PQ, ks, qd), acc);
                    if (jt == it) {
#pragma unroll
                        for (int rg = 0; rg < 4; ++rg) if (4 * qd + rg > r) acc[rg] = 0.f; }
                }
                *(LAS u32x2v*)(lds + L_PM + sw64(16 * it + r, (16 * jt + 4 * qd) * 2)) = pack4(acc); }
            __syncthreads();
        }
        f32x4 o[4], ox = (f32x4){0.f, 0.f, 0.f, 0.f};
        if (OUT) {
#pragma unroll
            for (int it = 0; it < 4; ++it) { o[it] = (f32x4){0.f, 0.f, 0.f, 0.f};
#pragma unroll
                for (int ks = 0; ks < 2; ++ks) if (ks == 0 || it >= 2) o[it] = MFMA16(frag64(lds + L_VT, 16 * w + r, ks, qd), frag64(lds + L_PM, 16 * it + r, ks, qd), o[it]);
#pragma unroll
                for (int ks = 0; ks < 4; ++ks) o[it] = MFMA16(frag(lds + L_ST, 16 * w + r, PQ, ks, qd), frag(lds + L_QT, 16 * it + r, PQ, ks, qd), o[it]); }
            const int itx = w & 3;
#pragma unroll
            for (int ks = 0; ks < 2; ++ks) ox = MFMA16(frag64(lds + L_VT, 128 + r, ks, qd), frag64(lds + L_PM, 16 * itx + r, ks, qd), ox);
#pragma unroll
            for (int ks = 0; ks < 4; ++ks) ox = MFMA16(frag(lds + L_ST, 128 + r, PQ, ks, qd), frag(lds + L_QT, 16 * itx + r, PQ, ks, qd), ox);
            if (w < 4 && qd == 0) vden[16 * itx + r] = ox[0];
        }
#pragma unroll
        for (int dt = 0; dt < 8; ++dt)
#pragma unroll
            for (int ks = 0; ks < 2; ++ks) S[dt] = MFMA16(frag64(lds + L_KTT, 16 * dt + r, ks, qd), frag64(lds + L_VT, 16 * w + r, ks, qd), S[dt]);
#pragma unroll
        for (int ks = 0; ks < 2; ++ks) Sx = MFMA16(frag64(lds + L_KTT, 16 * w + r, ks, qd), frag64(lds + L_VT, 128 + r, ks, qd), Sx);
        if (OUT) {
#pragma unroll
            for (int it = 0; it < 4; ++it) *(LAS u32x2v*)(lds + L_KT + (16 * it + r) * 272 + (16 * w + 4 * qd) * 2) = pack4(o[it]);
            __syncthreads();
            const u32x4v oa = *(const LAS u32x4v*)(lds + L_KT + ei * 272 + ecc * 32), ob = *(const LAS u32x4v*)(lds + L_KT + ei * 272 + ecc * 32 + 16);
            float ov[16] = {lo2f(oa.x), hi2f(oa.x), lo2f(oa.y), hi2f(oa.y), lo2f(oa.z), hi2f(oa.z), lo2f(oa.w), hi2f(oa.w), lo2f(ob.x), hi2f(ob.x), lo2f(ob.y), hi2f(ob.y), lo2f(ob.z), hi2f(ob.z), lo2f(ob.w), hi2f(ob.w)};
            const float dinv = frcp(fmaxf(fabsf(vden[ei]), vemr[ei]));
            const float zv[16] = {lo2f(za.x), hi2f(za.x), lo2f(za.y), hi2f(za.y), lo2f(za.z), hi2f(za.z), lo2f(za.w), hi2f(za.w), lo2f(zb.x), hi2f(zb.x), lo2f(zb.y), hi2f(zb.y), lo2f(zb.z), hi2f(zb.z), lo2f(zb.w), hi2f(zb.w)};
            const float gv[16] = {lo2f(ga.x), hi2f(ga.x), lo2f(ga.y), hi2f(ga.y), lo2f(ga.z), hi2f(ga.z), lo2f(ga.w), hi2f(ga.w), lo2f(gb_.x), hi2f(gb_.x), lo2f(gb_.y), hi2f(gb_.y), lo2f(gb_.z), hi2f(gb_.z), lo2f(gb_.w), hi2f(gb_.w)};
            float ss = 0.f;
#pragma unroll
            for (int k = 0; k < 16; ++k) { ov[k] = ov[k] * dinv * fsigmoid(gv[k]); ss += ov[k] * ov[k]; }
            ss += __shfl_xor(ss, 1); ss += __shfl_xor(ss, 2); ss += __shfl_xor(ss, 4);
            const float rs = frsq(ss * (1.0f / 128.0f) + EPS);
            float y[16];
#pragma unroll
            for (int k = 0; k < 16; ++k) y[k] = ov[k] * rs * nw[k] * fsilu(zv[k]);
            u32x4v ya, yb; ya.x = cvtpk(y[0], y[1]); ya.y = cvtpk(y[2], y[3]); ya.z = cvtpk(y[4], y[5]); ya.w = cvtpk(y[6], y[7]); yb.x = cvtpk(y[8], y[9]); yb.y = cvtpk(y[10], y[11]); yb.z = cvtpk(y[12], y[13]); yb.w = cvtpk(y[14], y[15]);
            if (DRY) { asm volatile("" :: "v"(ya.x), "v"(ya.y), "v"(ya.z), "v"(ya.w), "v"(yb.x), "v"(yb.y), "v"(yb.z), "v"(yb.w)); } else { *(u32x4v*)zp = ya; *(u32x4v*)(zp + 8) = yb; }
        }
    }
    if (!OUT) {
        bf16* sb = stbase + (size_t)idx * 18432;
#pragma unroll
        for (int dt = 0; dt < 8; ++dt) st_wt(sb + ((size_t)(w * 9 + dt) * 64 + lane) * 4, pack4(S[dt]));
        st_wt(sb + ((size_t)(w * 9 + 8) * 64 + lane) * 4, pack4(Sx));
        if (tid == 0) { st_wt_f(dsbase + (size_t)idx * 4, m); st_wt_f(dsbase + (size_t)idx * 4 + 1, bsum); }
        publish_item(flag_ptr(P, FLAG_ML, idx), (unsigned)l + 1u);
    }
    __syncthreads();
#undef ML_LOAD
}

template <bool OUT, bool DRY = false>
__device__ __forceinline__ void ssd_item(KP P, int l, int b, int gq, int s, LAS unsigned char* lds) {
    constexpr int PQ = 272;
    const int tid = opaque_tid(), lane = tid & 63, w = __builtin_amdgcn_readfirstlane(tid >> 6);
    const int g = w, hsub = lane >> 5;
    bf16* proj = (bf16*)(P->ws + WS_PROJ); const float* gts = (const float*)(P->ws + WS_GATES);
    LAS float* vg = (LAS float*)(lds + L_VEC + V_TOT);
    LAS float* vaend = vg + 32;
    LAS float* vacs = (LAS float*)(lds + L_VEC + 256);
    LAS float* veacs = vacs + 256;
    LAS float* vdti = veacs + 256;
    LAS float* vcw = (LAS float*)(lds + L_VEC + 3328);
    const int idx = (b * 2 + gq) * NSEG + s;
    bf16* stbase = (bf16*)((unsigned char*)P->out + DO_STATE) + ST_SSD;
    float* dsbase = (float*)(P->ws + WS_MISC) + DS_SSD;
    { const int cp = lane; (void)cp; const int ch = tid;
      const int src = (ch < 128) ? 512 + gq * 128 + ch : (ch < 256) ? 768 + gq * 128 + (ch - 128) : gq * 256 + (ch - 256);
#pragma unroll
      for (int kk = 0; kk < 4; ++kk) vcw[ch * 5 + kk] = P->ssd_conv_w[((size_t)l * 4 + kk) * 1024 + src];
      vcw[ch * 5 + 4] = P->ssd_conv_b[l * 1024 + src]; }
    const int qd0 = lane >> 4, r0 = lane & 15; (void)qd0; (void)r0;
    float dtb[2], An[2], iAn[2];
#pragma unroll
    for (int k = 0; k < 2; ++k) { const int hh = gq * 4 + 2 * k + hsub; dtb[k] = P->ssd_dt_bias[l * 8 + hh]; An[k] = -fexp(P->ssd_A_log[l * 8 + hh]); iAn[k] = 1.0f / An[k]; }
    const float dtb_l = P->ssd_dt_bias[l * 8 + gq * 4 + (lane & 3)], An_l = -fexp(P->ssd_A_log[l * 8 + gq * 4 + (lane & 3)]);
    const int hw0 = (w >> 2), hw1 = 2 + (w >> 2);
    const float Dh[2][2] = {{P->ssd_D[l * 8 + gq * 4 + 0], P->ssd_D[l * 8 + gq * 4 + 1]}, {P->ssd_D[l * 8 + gq * 4 + 2], P->ssd_D[l * 8 + gq * 4 + 3]}};
    f32x4 S[2][8];
#pragma unroll
    for (int R = 0; R < 2; ++R)
#pragma unroll
        for (int dt = 0; dt < 8; ++dt) S[R][dt] = (f32x4){0.f, 0.f, 0.f, 0.f};
    if (OUT) {
        wait_predecessors(flag_ptr(P, FLAG_SSD, idx - s), s, (unsigned)l + 1u);
        LAS float* vds = (LAS float*)(lds + L_QT);
        for (int i = tid; i < s * 4; i += 512) vds[i] = dsbase[(size_t)(idx - s) * 4 + i];
        __syncthreads();
        for (int sp0 = 0; sp0 < s; sp0 += 2) {
            u32x2v raw[2][16];
#pragma unroll
            for (int u = 0; u < 2; ++u) { const int sp = (sp0 + u < s) ? sp0 + u : s - 1; const bf16* sb = stbase + (size_t)(idx - s + sp) * 32768;
#pragma unroll
                for (int t = 0; t < 16; ++t) raw[u][t] = *(const u32x2v*)(sb + ((size_t)(w * 16 + t) * 64 + lane) * 4); }
#pragma unroll
            for (int u = 0; u < 2; ++u) if (sp0 + u < s) {
                const float f0 = fexp(vds[(sp0 + u) * 4 + hw0]), f1 = fexp(vds[(sp0 + u) * 4 + hw1]);
#pragma unroll
                for (int R = 0; R < 2; ++R)
#pragma unroll
                    for (int dt = 0; dt < 8; ++dt) { const u32x2v rw = raw[u][R * 8 + dt];
                        const f32x4 ds = (f32x4){lo2f(rw.x), hi2f(rw.x), lo2f(rw.y), hi2f(rw.y)}; S[R][dt] = S[R][dt] * (R == 0 ? f0 : f1) + ds; } }
        }
        __syncthreads();
    }
    float asum[2] = {0.f, 0.f};

    unsigned rC[11], rB[11], rx[2][11]; float gdt = 0.f;
    const bf16* halo = (const bf16*)(P->ws + WS_HALO);
    LAS unsigned* hxch = (LAS unsigned*)(lds + L_ST);
#define SSD_LOAD(cc) do { const int cl_ = opq(lane); const size_t rw_ = (size_t)b * SEQ + (size_t)s * SEGL + (size_t)(cc) * CH + 8 * g; \
        if (OUT) { \
            _Pragma("unroll") for (int jj = 0; jj < 8; ++jj) { const bf16* pr = proj + (rw_ + jj) * PP; \
                rB[jj] = *(const unsigned*)(pr + DBc(gq) + 2 * cl_); rC[jj] = *(const unsigned*)(pr + DCc(gq) + 2 * cl_); \
                rx[0][jj] = *(const unsigned*)(pr + DXc(gq) + 2 * cl_); rx[1][jj] = *(const unsigned*)(pr + DXc(gq) + 128 + 2 * cl_); } \
        } else { \
            _Pragma("unroll") for (int jj = 0; jj < 11; ++jj) { \
                if (jj < 3 && g == 0) {       \
                    if ((cc) == 0) { const bool ok = s > 0; const bf16* hr = halo + ((size_t)((b * NSEG + s - 1) * 3 + jj)) * 1024; \
                        rB[jj] = ok ? *(const unsigned*)(hr + (DBc(gq) - DSSD) + 2 * cl_) : 0u; rC[jj] = ok ? *(const unsigned*)(hr + (DCc(gq) - DSSD) + 2 * cl_) : 0u; \
                        rx[0][jj] = ok ? *(const unsigned*)(hr + (DXc(gq) - DSSD) + 2 * cl_) : 0u; rx[1][jj] = ok ? *(const unsigned*)(hr + (DXc(gq) - DSSD) + 128 + 2 * cl_) : 0u; } \
                } else { const bf16* pr = proj + (rw_ + jj - 3) * PP; \
                    rB[jj] = *(const unsigned*)(pr + DBc(gq) + 2 * cl_); rC[jj] = *(const unsigned*)(pr + DCc(gq) + 2 * cl_); \
                    rx[0][jj] = *(const unsigned*)(pr + DXc(gq) + 2 * cl_); rx[1][jj] = *(const unsigned*)(pr + DXc(gq) + 128 + 2 * cl_); } } \
        } \
        if (cl_ < 32) gdt = gts[(rw_ + (cl_ >> 2)) * 32 + G_DT + gq * 4 + (cl_ & 3)]; } while (0)
    SSD_LOAD(0);
    for (int c = 0; c < NCH; ++c) {
        const size_t rowc = (size_t)b * SEQ + (size_t)s * SEGL + (size_t)c * CH;
        const int cp = opq(lane);
        LAS float* vsl = vacs + (cp >> 5) * 64 + 8 * g;
        const float a_l = fsoftplus(gdt + dtb_l) * An_l;
        float al[2][8];
#pragma unroll
        for (int k = 0; k < 2; ++k) {
#pragma unroll
            for (int jj = 0; jj < 8; ++jj) { const float pa = __int_as_float(__builtin_amdgcn_readlane(__float_as_int(a_l), 4 * jj + 2 * k)), pb = __int_as_float(__builtin_amdgcn_readlane(__float_as_int(a_l), 4 * jj + 2 * k + 1));
                al[k][jj] = hsub ? pb : pa; }
#pragma unroll
            for (int jj = 1; jj < 8; ++jj) al[k][jj] += al[k][jj - 1];
            if ((lane & 31) == 0) vg[(2 * k + hsub) * 8 + g] = al[k][7];
        }
        __syncthreads();
        float base[2] = {0.f, 0.f}, aend[2] = {0.f, 0.f};
#pragma unroll
        for (int k = 0; k < 2; ++k)
#pragma unroll
            for (int gg = 0; gg < 8; ++gg) { const float t = vg[(2 * k + hsub) * 8 + gg]; if (gg < g) base[k] += t; aend[k] += t; }
#define SSD_PUT_T(region, src) do { u32x4v t_; \
          t_.x = (src[0] & 0xffffu) | (src[1] << 16); t_.y = (src[2] & 0xffffu) | (src[3] << 16); t_.z = (src[4] & 0xffffu) | (src[5] << 16); t_.w = (src[6] & 0xffffu) | (src[7] << 16); \
          *(LAS u32x4v*)(lds + (region) + (2 * cp) * 128 + ((g ^ (cp & 7)) << 4)) = t_; \
          t_.x = (src[0] >> 16) | (src[1] & 0xffff0000u); t_.y = (src[2] >> 16) | (src[3] & 0xffff0000u); t_.z = (src[4] >> 16) | (src[5] & 0xffff0000u); t_.w = (src[6] >> 16) | (src[7] & 0xffff0000u); \
          *(LAS u32x4v*)(lds + (region) + (2 * cp + 1) * 128 + ((g ^ (cp & 7)) << 4)) = t_; } while (0)
        unsigned x1a[8], x1s[8];
        unsigned Bp[8], Cp[8], x0p[8];
        if (OUT) {
#pragma unroll
            for (int jj = 0; jj < 8; ++jj) { *(LAS unsigned*)(lds + L_KT + (8 * g + jj) * PQ + 4 * cp) = rB[jj]; *(LAS unsigned*)(lds + L_QT + (8 * g + jj) * PQ + 4 * cp) = rC[jj]; }
            SSD_PUT_T(L_KTT, rB);
            { unsigned x0s[8];
#pragma unroll
              for (int jj = 0; jj < 8; ++jj) { const float a0 = base[0] + al[0][jj]; const float dtj = (al[0][jj] - (jj ? al[0][jj - 1] : 0.f)) * iAn[0], e0 = fexp(aend[0] - a0);
                  x0s[jj] = cvtpk(lo2f(rx[0][jj]) * e0, hi2f(rx[0][jj]) * e0);
                  if ((cp & 31) == 0) { vsl[jj] = a0; vsl[256 + jj] = fexp(a0); vsl[512 + jj] = frcp(dtj); } }
              SSD_PUT_T(L_VVT, x0s); SSD_PUT_T(L_VT, rx[0]); }
#pragma unroll
            for (int jj = 0; jj < 8; ++jj) { const float a1 = base[1] + al[1][jj]; const float dtj = (al[1][jj] - (jj ? al[1][jj - 1] : 0.f)) * iAn[1];
                x1a[jj] = rx[1][jj];
                if ((cp & 31) == 0) { vsl[128 + jj] = a1; vsl[128 + 256 + jj] = fexp(a1); vsl[128 + 512 + jj] = frcp(dtj); } }
        } else {
            LAS unsigned* hw_ = hxch + (c & 1) * 768; LAS unsigned* hr_ = hxch + ((c + 1) & 1) * 768;
            if (g == 7) {
#pragma unroll
                for (int jj = 0; jj < 3; ++jj) { hw_[(0 * 3 + jj) * 64 + cp] = rB[8 + jj]; hw_[(1 * 3 + jj) * 64 + cp] = rC[8 + jj]; hw_[(2 * 3 + jj) * 64 + cp] = rx[0][8 + jj]; hw_[(3 * 3 + jj) * 64 + cp] = rx[1][8 + jj]; } }
            if (g == 0 && c > 0) {
#pragma unroll
                for (int jj = 0; jj < 3; ++jj) { rB[jj] = hr_[(0 * 3 + jj) * 64 + cp]; rC[jj] = hr_[(1 * 3 + jj) * 64 + cp]; rx[0][jj] = hr_[(2 * 3 + jj) * 64 + cp]; rx[1][jj] = hr_[(3 * 3 + jj) * 64 + cp]; } }
#define SSD_TAPS(chan) float w0_[5], w1_[5]; _Pragma("unroll") for (int kk = 0; kk < 5; ++kk) { w0_[kk] = vcw[(chan) * 5 + kk]; w1_[kk] = vcw[((chan) + 1) * 5 + kk]; }
#define SSD_CONV(raw, jj, y0, y1) float y0 = w0_[4], y1 = w1_[4]; _Pragma("unroll") for (int kk = 0; kk < 4; ++kk) { y0 += w0_[kk] * lo2f(raw[jj + kk]); y1 += w1_[kk] * hi2f(raw[jj + kk]); }
            { SSD_TAPS(2 * cp)
#pragma unroll
              for (int jj = 0; jj < 8; ++jj) { SSD_CONV(rB, jj, y0, y1) Bp[jj] = cvtpk(fsilu(y0), fsilu(y1)); }
              SSD_PUT_T(L_KTT, Bp); }
            { SSD_TAPS(128 + 2 * cp)
#pragma unroll
              for (int jj = 0; jj < 8; ++jj) { SSD_CONV(rC, jj, y0, y1) Cp[jj] = cvtpk(fsilu(y0), fsilu(y1)); } }
            { SSD_TAPS(256 + 2 * cp)
              unsigned x0s[8];
#pragma unroll
              for (int jj = 0; jj < 8; ++jj) { SSD_CONV(rx[0], jj, y0, y1) const float a0 = base[0] + al[0][jj]; const float dtj = (al[0][jj] - (jj ? al[0][jj - 1] : 0.f)) * iAn[0], e0 = fexp(aend[0] - a0);
                  x0p[jj] = cvtpk(fsilu(y0) * dtj, fsilu(y1) * dtj); x0s[jj] = cvtpk(lo2f(x0p[jj]) * e0, hi2f(x0p[jj]) * e0); }
              SSD_PUT_T(L_VVT, x0s); }
            { SSD_TAPS(256 + 128 + 2 * cp)
#pragma unroll
              for (int jj = 0; jj < 8; ++jj) { SSD_CONV(rx[1], jj, y0, y1) const float a1 = base[1] + al[1][jj]; const float dtj = (al[1][jj] - (jj ? al[1][jj - 1] : 0.f)) * iAn[1], e1 = fexp(aend[1] - a1);
                  x1a[jj] = cvtpk(fsilu(y0) * dtj, fsilu(y1) * dtj); x1s[jj] = cvtpk(lo2f(x1a[jj]) * e1, hi2f(x1a[jj]) * e1); } }
#undef SSD_TAPS
#undef SSD_CONV
        }
        if (g == 0 && (lane & 31) == 0) { vaend[hsub] = fexp(aend[0]); vaend[2 + hsub] = fexp(aend[1]); }
        asum[0] += aend[0]; asum[1] += aend[1];
        if (!OUT) SSD_PUT_T(L_VT, x1s);
        if (c + 1 < NCH) SSD_LOAD(c + 1);
        __syncthreads();
        const int lc = opq(lane), r = lc & 15, qd = lc >> 4;
        if (!OUT) {
#pragma unroll
            for (int jj = 0; jj < 8; ++jj) { bf16* pr = proj + (rowc + 8 * g + jj) * PP;
                *(unsigned*)(pr + DBc(gq) + 2 * cp) = Bp[jj]; *(unsigned*)(pr + DCc(gq) + 2 * cp) = Cp[jj];
                *(unsigned*)(pr + DXc(gq) + 2 * cp) = x0p[jj]; *(unsigned*)(pr + DXc(gq) + 128 + 2 * cp) = x1a[jj]; }
            const float fe0 = vaend[hw0], fe1 = vaend[hw1];
#pragma unroll
            for (int dt = 0; dt < 8; ++dt) { S[0][dt] = S[0][dt] * fe0; S[1][dt] = S[1][dt] * fe1;
#pragma unroll
                for (int ks = 0; ks < 2; ++ks) { const bf16x8 a = frag64(lds + L_KTT, 16 * dt + r, ks, qd);
                    S[0][dt] = MFMA16(a, frag64(lds + L_VVT, 16 * w + r, ks, qd), S[0][dt]); S[1][dt] = MFMA16(a, frag64(lds + L_VT, 16 * w + r, ks, qd), S[1][dt]); } }
        } else {
            const int it = w & 3;
            f32x4 cb[2];
#pragma unroll
            for (int j2 = 0; j2 < 2; ++j2) { const int jt = 2 * (w >> 2) + j2; cb[j2] = (f32x4){0.f, 0.f, 0.f, 0.f};
                if (jt <= it) {
#pragma unroll
                    for (int ks = 0; ks < 4; ++ks) cb[j2] = MFMA16(frag(lds + L_KT, 16 * jt + r, PQ, ks, qd), frag(lds + L_QT, 16 * it + r, PQ, ks, qd), cb[j2]); } }
            unsigned uA[8]; float ssq = 0.f;
#pragma unroll
            for (int R = 0; R < 2; ++R) {
#pragma unroll
                for (int hs = 0; hs < 2; ++hs) { const int hd = 2 * R + hs; const float ai = vacs[hd * 64 + 16 * it + r]; const float dgi = Dh[R][hs] * vdti[hd * 64 + 16 * it + r];
#pragma unroll
                    for (int j2 = 0; j2 < 2; ++j2) { const int jt = 2 * (w >> 2) + j2; f32x4 pv = (f32x4){0.f, 0.f, 0.f, 0.f};
                        if (jt <= it) { const f32x4 aj = *(const LAS f32x4*)(vacs + hd * 64 + 16 * jt + 4 * qd);
#pragma unroll
                            for (int rg = 0; rg < 4; ++rg) { float v = cb[j2][rg] * fexp(fminf(ai - aj[rg], 0.f));
                                if (jt == it) { if (4 * qd + rg > r) v = 0.f; else if (4 * qd + rg == r) v += dgi; }
                                pv[rg] = v; } }
                        *(LAS u32x2v*)(lds + L_PM + hs * 9216 + sw64(16 * it + r, (16 * jt + 4 * qd) * 2)) = pack4(pv); } }
#pragma unroll
                for (int dt = 0; dt < 8; ++dt) *(LAS u32x2v*)(lds + L_ST + (16 * w + r) * PQ + (16 * dt + 4 * qd) * 2) = pack4(S[R][dt]);
                if (R == 1) {
#pragma unroll
                    for (int jj = 0; jj < 8; ++jj) { const float e1 = fexp(aend[1] - vsl[128 + jj]); x1s[jj] = cvtpk(lo2f(x1a[jj]) * e1, hi2f(x1a[jj]) * e1); }
                    SSD_PUT_T(L_VVT, x1s); SSD_PUT_T(L_VT, x1a); }
                __syncthreads();
                const int le_ = opq(lane), r = le_ & 15, qd = le_ >> 4;
                const int hd = 2 * R + (w >> 2);
                const int te = opq(tid), ei = te >> 3, ecc = te & 7;
                bf16* zp = proj + (rowc + ei) * PP + ZD + gq * 256 + R * 128 + 16 * ecc;
                const u32x4v za = *(const u32x4v*)zp, zb = *(const u32x4v*)(zp + 8);
                f32x4 o[4];
#pragma unroll
                for (int it2 = 0; it2 < 4; ++it2) { f32x4 o1 = (f32x4){0.f, 0.f, 0.f, 0.f}, o2 = (f32x4){0.f, 0.f, 0.f, 0.f};
#pragma unroll
                    for (int ks = 0; ks < 2; ++ks) if (ks == 0 || it2 >= 2) o1 = MFMA16(frag64(lds + L_VT, 16 * w + r, ks, qd), frag64(lds + L_PM + (w >> 2) * 9216, 16 * it2 + r, ks, qd), o1);
#pragma unroll
                    for (int ks = 0; ks < 4; ++ks) o2 = MFMA16(frag(lds + L_ST, 16 * w + r, PQ, ks, qd), frag(lds + L_QT, 16 * it2 + r, PQ, ks, qd), o2);
                    const float ea = veacs[hd * 64 + 16 * it2 + r]; o[it2] = o1 + o2 * ea; }
                const float fe = vaend[hd];
#pragma unroll
                for (int dt = 0; dt < 8; ++dt) { S[R][dt] = S[R][dt] * fe;
#pragma unroll
                    for (int ks = 0; ks < 2; ++ks) S[R][dt] = MFMA16(frag64(lds + L_KTT, 16 * dt + r, ks, qd), frag64(lds + L_VVT, 16 * w + r, ks, qd), S[R][dt]); }
#pragma unroll
                for (int it2 = 0; it2 < 4; ++it2) *(LAS u32x2v*)(lds + L_KT + (16 * it2 + r) * 272 + (16 * w + 4 * qd) * 2) = pack4(o[it2]);
                __syncthreads();
                const u32x4v oa = *(const LAS u32x4v*)(lds + L_KT + ei * 272 + ecc * 32), ob = *(const LAS u32x4v*)(lds + L_KT + ei * 272 + ecc * 32 + 16);
                const float ov[16] = {lo2f(oa.x), hi2f(oa.x), lo2f(oa.y), hi2f(oa.y), lo2f(oa.z), hi2f(oa.z), lo2f(oa.w), hi2f(oa.w), lo2f(ob.x), hi2f(ob.x), lo2f(ob.y), hi2f(ob.y), lo2f(ob.z), hi2f(ob.z), lo2f(ob.w), hi2f(ob.w)};
                const float zv[16] = {lo2f(za.x), hi2f(za.x), lo2f(za.y), hi2f(za.y), lo2f(za.z), hi2f(za.z), lo2f(za.w), hi2f(za.w), lo2f(zb.x), hi2f(zb.x), lo2f(zb.y), hi2f(zb.y), lo2f(zb.z), hi2f(zb.z), lo2f(zb.w), hi2f(zb.w)};
                if (R == 0) {
#pragma unroll
                    for (int k = 0; k < 8; ++k) { const float u0 = ov[2 * k] * fsilu(zv[2 * k]), u1 = ov[2 * k + 1] * fsilu(zv[2 * k + 1]); uA[k] = cvtpk(u0, u1); ssq += lo2f(uA[k]) * lo2f(uA[k]) + hi2f(uA[k]) * hi2f(uA[k]); }
                } else {
                    float uB[16];
#pragma unroll
                    for (int k = 0; k < 16; ++k) { uB[k] = ov[k] * fsilu(zv[k]); ssq += uB[k] * uB[k]; }
                    ssq += __shfl_xor(ssq, 1); ssq += __shfl_xor(ssq, 2); ssq += __shfl_xor(ssq, 4);
                    const float rs = frsq(ssq * (1.0f / 256.0f) + EPS);
                    const float* nwp = P->ssd_norm_w + l * 512 + gq * 256 + 16 * ecc;
                    u32x4v ya, yb;
                    ya.x = cvtpk(lo2f(uA[0]) * rs * nwp[0], hi2f(uA[0]) * rs * nwp[1]); ya.y = cvtpk(lo2f(uA[1]) * rs * nwp[2], hi2f(uA[1]) * rs * nwp[3]); ya.z = cvtpk(lo2f(uA[2]) * rs * nwp[4], hi2f(uA[2]) * rs * nwp[5]); ya.w = cvtpk(lo2f(uA[3]) * rs * nwp[6], hi2f(uA[3]) * rs * nwp[7]);
                    yb.x = cvtpk(lo2f(uA[4]) * rs * nwp[8], hi2f(uA[4]) * rs * nwp[9]); yb.y = cvtpk(lo2f(uA[5]) * rs * nwp[10], hi2f(uA[5]) * rs * nwp[11]); yb.z = cvtpk(lo2f(uA[6]) * rs * nwp[12], hi2f(uA[6]) * rs * nwp[13]); yb.w = cvtpk(lo2f(uA[7]) * rs * nwp[14], hi2f(uA[7]) * rs * nwp[15]);
                    if (DRY) { asm volatile("" :: "v"(ya.x), "v"(ya.y), "v"(ya.z), "v"(ya.w), "v"(yb.x), "v"(yb.y), "v"(yb.z), "v"(yb.w)); } else { *(u32x4v*)(zp - 128) = ya; *(u32x4v*)(zp - 128 + 8) = yb; }
                    nwp += 128;
                    ya.x = cvtpk(uB[0] * rs * nwp[0], uB[1] * rs * nwp[1]); ya.y = cvtpk(uB[2] * rs * nwp[2], uB[3] * rs * nwp[3]); ya.z = cvtpk(uB[4] * rs * nwp[4], uB[5] * rs * nwp[5]); ya.w = cvtpk(uB[6] * rs * nwp[6], uB[7] * rs * nwp[7]);
                    yb.x = cvtpk(uB[8] * rs * nwp[8], uB[9] * rs * nwp[9]); yb.y = cvtpk(uB[10] * rs * nwp[10], uB[11] * rs * nwp[11]); yb.z = cvtpk(uB[12] * rs * nwp[12], uB[13] * rs * nwp[13]); yb.w = cvtpk(uB[14] * rs * nwp[14], uB[15] * rs * nwp[15]);
                    if (DRY) { asm volatile("" :: "v"(ya.x), "v"(ya.y), "v"(ya.z), "v"(ya.w), "v"(yb.x), "v"(yb.y), "v"(yb.z), "v"(yb.w)); } else { *(u32x4v*)zp = ya; *(u32x4v*)(zp + 8) = yb; }
                }
            }
        }
    }
    if (!OUT) {
        bf16* sb = stbase + (size_t)idx * 32768;
#pragma unroll
        for (int R = 0; R < 2; ++R)
#pragma unroll
            for (int dt = 0; dt < 8; ++dt) st_wt(sb + ((size_t)(w * 16 + R * 8 + dt) * 64 + lane) * 4, pack4(S[R][dt]));
        if (g == 0 && (lane & 31) == 0) { st_wt_f(dsbase + (size_t)idx * 4 + hsub, asum[0]); st_wt_f(dsbase + (size_t)idx * 4 + 2 + hsub, asum[1]); }
        publish_item(flag_ptr(P, FLAG_SSD, idx), (unsigned)l + 1u);
    }
    __syncthreads();
#undef SSD_PUT_T
#undef SSD_LOAD
}
}
#define GAS __attribute__((address_space(1)))
typedef GAS unsigned gu32;
#define XB_TMO      128
#define XB_XCNT(j)  (256  + 64 * (j))
#define XB_XSUB(j)  (1280 + 64 * (j))
#define XB_XGEN(j)  (2304 + 64 * (j))
#define XB_TOP      3328
#define XB_TOPGEN   3392
#define XCD_BAR_WORDS 3456
#define XB_SPIN_CAP (1u << 18)

__device__ __forceinline__ unsigned xb_ld(unsigned* p)              { return __hip_atomic_load(p, __ATOMIC_RELAXED, __HIP_MEMORY_SCOPE_AGENT); }
__device__ __forceinline__ unsigned xb_add(unsigned* p, unsigned v) { return __hip_atomic_fetch_add(p, v, __ATOMIC_RELAXED, __HIP_MEMORY_SCOPE_AGENT); }
__device__ __forceinline__ unsigned xb_xcc_id() { return (unsigned)__builtin_amdgcn_s_getreg((3 << 11) | 20) & 0xFu; }
#define XB_SPIN(cond, bar) do { unsigned _sp = 0; while (cond) { __builtin_amdgcn_s_sleep(1); \
    if ((++_sp & 255u) == 0u) { if (xb_ld(&(bar)[XB_TMO])) break; if (_sp > XB_SPIN_CAP) { atomicAdd(&(bar)[XB_TMO], 1u); break; } } } } while (0)

struct XcdBarrier {
    unsigned* bar; unsigned x;
    volatile LAS unsigned* st;
};

__device__ __forceinline__ XcdBarrier xcd_barrier_post(unsigned* bar, volatile LAS unsigned* st) {
    XcdBarrier b; b.bar = bar; b.x = xb_xcc_id(); b.st = st;
    if (threadIdx.x == 0) (void)xb_add(&bar[XB_XCNT(b.x)], 1u);
    return b;
}
__device__ __forceinline__ void xcd_barrier_complete(unsigned* bar, unsigned x, unsigned& nloc, unsigned& nx) {
    const unsigned G = gridDim.x * gridDim.y * gridDim.z;
    unsigned sum, cnt, mine, sp = 0u;
    for (;;) {
        sum = 0u; cnt = 0u; mine = 0u;
#pragma unroll
        for (unsigned j = 0; j < 16; ++j) { const unsigned c = xb_ld(&bar[XB_XCNT(j)]); sum += c; cnt += (c > 0u) ? 1u : 0u; mine = (j == x) ? c : mine; }
        if (sum == G) break;
        __builtin_amdgcn_s_sleep(1);
        if ((++sp & 255u) == 0u) { if (xb_ld(&bar[XB_TMO])) break; if (sp > XB_SPIN_CAP) { atomicAdd(&bar[XB_TMO], 1u); break; } }
    }
    nloc = mine > 0u ? mine : 1u; nx = cnt > 0u ? cnt : 1u;
}

__device__ __forceinline__ void xcd_barrier(const XcdBarrier& b) {
    asm volatile("s_waitcnt vmcnt(0)" ::: "memory");
    __syncthreads();
    if (threadIdx.x == 0) {
        unsigned* bar = b.bar;
        __builtin_amdgcn_s_waitcnt(0);
        unsigned nloc = b.st[0], nx = b.st[1];
        if (nloc == 0u) { xcd_barrier_complete(bar, b.x, nloc, nx); b.st[0] = nloc; b.st[1] = nx; }
        const unsigned old = xb_add(&bar[XB_XSUB(b.x)], 1u);
        const unsigned gen = old / nloc;
        if (old + 1u == (gen + 1u) * nloc) {
            __builtin_amdgcn_fence(__ATOMIC_RELEASE, "agent");
            asm volatile("s_waitcnt vmcnt(0)" ::: "memory");
            const unsigned og = xb_add(&bar[XB_TOP], 1u);
            const unsigned tg = og / nx;
            if (og + 1u == (tg + 1u) * nx) xb_add(&bar[XB_TOPGEN], 1u);
            else XB_SPIN(xb_ld(&bar[XB_TOPGEN]) == tg, bar);
            __builtin_amdgcn_fence(__ATOMIC_ACQUIRE, "agent");
            xb_add(&bar[XB_XGEN(b.x)], 1u);
            asm volatile("s_waitcnt vmcnt(0)" ::: "memory");
        } else {
            XB_SPIN(xb_ld(&bar[XB_XGEN(b.x)]) == gen, bar);
            __builtin_amdgcn_fence(__ATOMIC_ACQUIRE, "agent");
            asm volatile("s_waitcnt vmcnt(0)" ::: "memory");
        }
    }
    __syncthreads();
}
constexpr int LDS_BYTES = 163840;
constexpr int LDS_BARST = 163832;
constexpr int CTL_BYTES = 65536;
template <bool OUT>
__device__ __forceinline__ void engine_items(KP P, int l, int bid, int nblk, LAS unsigned char* lds) {
    if (nblk == 256) {
        if (bid < 64) { const int s = bid & 15, bg = bid >> 4; mx::ssd_item<OUT>(P, l, bg >> 1, bg & 1, s, lds); }
        else if (bid < 192) { const int ii = bid - 64, s = ii & 15, bh = ii >> 4;
            mx::ml_item<OUT>(P, l, bh >> 2, bh & 3, s, lds); if (OUT) mx::pc_item<0, true>(P, l, bh >> 2, bh & 3, 15 - s, lds); else mx::pc_pass1<0>(P, l, bh >> 2, bh & 3, 15 - s, lds); }
        else { const int ii = bid - 192, sh = ii & 7, bh = ii >> 3;
            if (OUT) { mx::pc_item<2, true>(P, l, bh >> 2, bh & 3, sh, lds); mx::pc_item<2, true>(P, l, bh >> 2, bh & 3, 15 - sh, lds); }
            else { mx::pc_pass1<2>(P, l, bh >> 2, bh & 3, sh, lds); mx::pc_pass1<2>(P, l, bh >> 2, bh & 3, 15 - sh, lds); } }
    } else {
        for (int ii = bid; ii < 448; ii += nblk) {
            if (ii < 64) { const int s = ii & 15, bg = ii >> 4; mx::ssd_item<OUT>(P, l, bg >> 1, bg & 1, s, lds); }
            else if (ii < 192) { const int i2 = ii - 64, s = i2 & 15, bh = i2 >> 4; mx::ml_item<OUT>(P, l, bh >> 2, bh & 3, s, lds); }
            else if (ii < 320) { const int i2 = ii - 192, s = i2 & 15, bh = i2 >> 4; mx::pc_item<2, OUT>(P, l, bh >> 2, bh & 3, s, lds); }
            else { const int i2 = ii - 320, s = i2 & 15, bh = i2 >> 4; mx::pc_item<0, OUT>(P, l, bh >> 2, bh & 3, s, lds); }
        }
    }
}
__global__ void __launch_bounds__(512, 2) fwd_mega(Params Pval) {
    extern __shared__ __attribute__((aligned(16))) unsigned char lds_raw[]; LAS unsigned char* lds = (LAS unsigned char*)lds_raw;
    (void)Pval; KP P = (KP)__builtin_amdgcn_kernarg_segment_ptr();
#define LAUNDER() asm volatile("" : "+s"(P))
    const int bid = blockIdx.x, nblk = gridDim.x;
    if (threadIdx.x < 2) ((LAS unsigned*)(lds + LDS_BARST))[threadIdx.x] = 0u;
    __syncthreads();
    LAUNDER();
    XcdBarrier bar = xcd_barrier_post((unsigned*)(P->ws + WS_CTL) + 1024, (volatile LAS unsigned*)(lds + LDS_BARST));
    LAUNDER(); phase_prologue(P, bid, nblk, lds);
    xcd_barrier(bar);
#define LAYER_BODY(l) do { \
        LAUNDER(); phase_gemm_in(P, l, bid, nblk, lds); \
        xcd_barrier(bar); \
        LAUNDER(); engine_items<false>(P, l, bid, nblk, lds); \
        LAUNDER(); engine_items<true>(P, l, bid, nblk, lds); \
        LAUNDER(); convert_weights_queue(P, l, lds); \
        xcd_barrier(bar); \
        LAUNDER(); phase_gemm_out(P, l, bid, nblk, lds); \
        xcd_barrier(bar); } while (0)
    LAYER_BODY(0);
    LAYER_BODY(1);
    static_assert(DEPTH == 2, "layer bodies are written out");
    LAUNDER(); phase_final(P, bid, nblk);
}

extern "C" void kernel_launch(void* const* d_in, const int* in_sizes, int n_in, void* d_out, int out_size, void* d_ws, size_t ws_size, hipStream_t stream) {
    static int grid_blocks = 0;
    if (!grid_blocks) {
        if (n_in != 21 || out_size != NTOK * DM || ws_size < WS_END) { fprintf(stderr, "kernel_launch: unexpected shapes (n_in %d out %d ws %zu)\n", n_in, out_size, ws_size); grid_blocks = -1; return; }
        if (hipFuncSetAttribute((const void*)fwd_mega, hipFuncAttributeMaxDynamicSharedMemorySize, LDS_BYTES) != hipSuccess) { fprintf(stderr, "hipFuncSetAttribute failed\n"); grid_blocks = -1; return; }
        int dev = 0, cus = 0, per_cu = 0;
        (void)hipGetDevice(&dev); (void)hipDeviceGetAttribute(&cus, hipDeviceAttributeMultiprocessorCount, dev);
        (void)hipOccupancyMaxActiveBlocksPerMultiprocessor(&per_cu, (const void*)fwd_mega, 512, LDS_BYTES);
        if (per_cu < 1) { fprintf(stderr, "kernel_launch: occupancy query says %d blocks per CU\n", per_cu); grid_blocks = -1; return; }
        grid_blocks = cus;
    }
    if (grid_blocks < 0) return;
    (void)hipMemsetAsync((unsigned char*)d_ws + WS_CTL, 0, CTL_BYTES, stream);
    Params P{};
    const float** pp = (const float**)&P;
    for (int i = 0; i < 21; ++i) pp[i] = (const float*)d_in[i];
    P.out = (float*)d_out; P.ws = (unsigned char*)d_ws;
    void* args[] = {&P};
    hipError_t e = hipLaunchCooperativeKernel((const void*)fwd_mega, dim3(grid_blocks), dim3(512), args, LDS_BYTES, stream);
    if (e != hipSuccess) fprintf(stderr, "cooperative launch failed: %s (grid %d)\n", hipGetErrorString(e), grid_blocks);
}
```

```cpp
#include <hip/hip_runtime.h>
#include <hip/hip_cooperative_groups.h>
#include <cstdio>
#include <cstdint>
namespace cg = cooperative_groups;

constexpr int NTOK = 16384, SEQ = 8192, DM = 1024, DEPTH = 2, DPROJ = 7712, DINNER = 2048;
constexpr int PP = 7680;
constexpr int NPAD = 7936;
constexpr float EPS = 1e-6f;
constexpr int ZA = 0, ZB = 512, ZC = 1024, ZD = 1536;
__host__ __device__ constexpr int AQc(int h) { return 2048 + h * 256; }
__host__ __device__ constexpr int AKc(int h) { return 2048 + h * 256 + 64; }
__host__ __device__ constexpr int AVc(int h) { return 2048 + h * 256 + 128; }
__host__ __device__ constexpr int BQc(int h) { return 3072 + h * 512; }
__host__ __device__ constexpr int BKc(int h) { return 3072 + h * 512 + 128; }
__host__ __device__ constexpr int BVc(int h) { return 3072 + h * 512 + 256; }
__host__ __device__ constexpr int BOc(int h) { return 3072 + h * 512 + 384; }
__host__ __device__ constexpr int CQc(int h) { return 5120 + h * 384; }
__host__ __device__ constexpr int CFc(int h) { return 5120 + h * 384 + 128; }
__host__ __device__ constexpr int CIc(int h) { return 5120 + h * 384 + 256; }
constexpr int DSSD = 6656;
__host__ __device__ constexpr int DXc(int g) { return DSSD + g * 512; }
__host__ __device__ constexpr int DBc(int g) { return DSSD + g * 512 + 256; }
__host__ __device__ constexpr int DCc(int g) { return DSSD + g * 512 + 384; }
constexpr int G_GR = 0, G_BI = 16, G_BF = 20, G_DT = 24;

__host__ __device__ __forceinline__ int win_src_col(int n) {
    if (n < 2048) { const int g = n >> 9, r = n & 511; const int base = (g == 0) ? 1040 : (g == 1) ? 3608 : (g == 2) ? 5656 : 7200; return base + r; }
    if (n < 3072) { const int j = n - 2048, h = j >> 8, r = j & 255; return (r < 64) ? h * 64 + r : (r < 128) ? 256 + h * 64 + (r - 64) : 512 + h * 128 + (r - 128); }
    if (n < 5120) { const int j = n - 3072, h = j >> 9, r = j & 511, part = r >> 7, c = r & 127; return ((part == 0) ? 1552 : (part == 1) ? 2064 : (part == 2) ? 2576 : 3096) + h * 128 + c; }
    if (n < 6656) { const int j = n - 5120, h = j / 384, r = j % 384, part = r >> 7, c = r & 127; return ((part == 0) ? 4120 : (part == 1) ? 4632 : 5144) + h * 128 + c; }
    if (n < 7680) { const int j = n - 6656, g = j >> 9, r = j & 511; return (r < 256) ? 6168 + g * 256 + r : (r < 384) ? 6680 + g * 128 + (r - 256) : 6936 + g * 128 + (r - 384); }
    const int j = n - 7680;
    if (j < 16) return 1024 + j;
    if (j < 20) return 3088 + (j - 16);
    if (j < 24) return 3092 + (j - 20);
    if (j < 32) return 7192 + (j - 24);
    return -1;
}

constexpr size_t MiB = 1u << 20;
constexpr size_t WS_CTL = 0;
constexpr size_t WS_PROJ = 1 * MiB;
constexpr size_t WS_GATES = 241 * MiB;
constexpr size_t WS_WOUT = 243 * MiB;
constexpr size_t WS_SSQ = 251 * MiB;
constexpr size_t WS_RSTD0 = 252 * MiB;
constexpr size_t WS_MISC = 252 * MiB + 65536;
constexpr size_t WS_HALO = 253 * MiB;
constexpr size_t WS_END = 256 * MiB;
constexpr size_t DO_HB = 0;
constexpr size_t DO_WIN = 32 * MiB;
constexpr size_t DO_WIN_STRIDE = 15 * MiB + MiB / 2;
constexpr size_t DO_STATE = 32 * MiB;

typedef unsigned short bf16;
typedef float f32x4v __attribute__((ext_vector_type(4)));
typedef unsigned u32x4v __attribute__((ext_vector_type(4)));
typedef unsigned u32x2v __attribute__((ext_vector_type(2)));
#define LAS __attribute__((address_space(3)))

__device__ __forceinline__ float bf2f(unsigned short u) { return __uint_as_float(((unsigned)u) << 16); }
__device__ __forceinline__ unsigned f2bf(float f) { unsigned u = __float_as_uint(f); return (u + 0x7fffu + ((u >> 16) & 1u)) >> 16; }
__device__ __forceinline__ unsigned pk2(float lo, float hi) { return f2bf(lo) | (f2bf(hi) << 16); }
__device__ __forceinline__ float sigmoidf_(float x) { return 1.f / (1.f + __expf(-x)); }
__device__ __forceinline__ float siluf_(float x) { return x / (1.f + __expf(-x)); }
__device__ __forceinline__ float softplusf_(float x) { return fmaxf(x, 0.f) + log1pf(__expf(-fabsf(x))); }
__device__ __forceinline__ float logsigmoidf_(float x) { return fminf(x, 0.f) - log1pf(__expf(-fabsf(x))); }
__device__ __forceinline__ float wave_sum(float v) {
#pragma unroll
    for (int o = 1; o < 64; o <<= 1) v += __shfl_xor(v, o);
    return v;
}

typedef float f32x2c __attribute__((ext_vector_type(2)));
typedef __bf16 bf16x2c __attribute__((ext_vector_type(2)));
__device__ __forceinline__ unsigned cvt_pk2(float lo, float hi) { f32x2c v = {lo, hi}; bf16x2c r = __builtin_convertvector(v, bf16x2c); return __builtin_bit_cast(unsigned, r); }
__device__ __forceinline__ int opaque_tid() { int t = threadIdx.x; asm volatile("" : "+v"(t)); return t; }

struct Params {
    const float* x; const float* norm_w; const float* w_in; const float* gla_gate_w; const float* gla_gate_b; const float* gla_norm_w;
    const float* ml_conv_w; const float* ml_conv_b; const float* ml_i_b; const float* ml_f_b; const float* ml_norm_w;
    const float* hg_lb; const float* hg_norm_w; const float* ssd_conv_w; const float* ssd_conv_b; const float* ssd_dt_bias;
    const float* ssd_A_log; const float* ssd_D; const float* ssd_norm_w; const float* w_out; const float* final_norm_w;
    float* out; unsigned char* ws;
};
typedef const __attribute__((address_space(4))) Params* KP;
namespace pg8 {
#define PG8_LAS __attribute__((address_space(3)))
typedef unsigned short bf16_t;
typedef short bf16x8 __attribute__((ext_vector_type(8)));
typedef float f32x4 __attribute__((ext_vector_type(4)));
typedef unsigned u32x4 __attribute__((ext_vector_type(4)));
constexpr int BM = 256, BK = 64, HALF = 128, HTB = HALF * BK * 2  , STAGE_BYTES = 8 * HTB, NXCD = 8, WGM = 4;

__host__ __device__ __forceinline__ int lds_byte(int r, int c) { const int st = (r >> 4) * 2 + (c >> 5), rr = r & 15, cc = c & 31, ob = rr * 64 + cc * 2; return st * 1024 + (ob ^ (((ob >> 9) & 1) << 5)); }
__host__ __device__ __forceinline__ void stage_rc(int b, int& R, int& C) { const int st = b / 1024, sb = b % 1024, swz = sb ^ (((sb >> 9) & 1) << 5); R = (st >> 1) * 16 + swz / 64; C = (st & 1) * 32 + (swz % 64) / 2; }
__host__ __device__ __forceinline__ int perm32(int rho) { const int n = rho >> 4, i = rho & 15; return 8 * (i >> 2) + 4 * n + (i & 3); }

struct Unit { int pm, pn, idx; };
struct Gemm { const bf16_t* A; const bf16_t* Bt; int M, N, K, lda; };

struct StaticOrder {
    int nM, nN, nwg, G, c;
    __host__ __device__ void init(int M, int N, int G_, int c_) { nM = M / BM; nN = N / BM; nwg = nM * nN; G = G_; c = c_; }
    __host__ __device__ bool next(int i, Unit& u) const {
        const long L = (long)i * G + c; if (L >= nwg) return false;
        int wgid = (int)L; { const int q = nwg / NXCD, r = nwg % NXCD, xcd = wgid % NXCD, off = wgid / NXCD; wgid = (xcd < r ? xcd * (q + 1) : r * (q + 1) + (xcd - r) * q) + off; }
        const int nig = WGM * nN, gid = wgid / nig, fm = gid * WGM, gsz = (nM - fm) < WGM ? (nM - fm) : WGM;
        u.pm = fm + ((wgid % nig) % gsz); u.pn = (wgid % nig) / gsz; u.idx = i; return true;
    }
    __device__ __forceinline__ void a_ready(const Unit&) const {}
    __device__ __forceinline__ void done(const Unit&) const {}
};

__device__ __forceinline__ unsigned cvt_pk_bf16(float lo, float hi) { return cvt_pk2(lo, hi); }

template <class Epi, class Sched, bool ALIGN_EPI = false, bool SP2 = false>
__device__ __forceinline__ void gemm_phase(PG8_LAS unsigned char* lds, const Gemm g, const Sched& S, const Epi& E) {
    const int tid = opaque_tid(), wid = __builtin_amdgcn_readfirstlane(tid >> 6), lane = tid & 63, wr = wid >> 2, wc = wid & 3, fr = lane & 15, fq = lane >> 4;
    const int K = g.K, nt = K / BK, lda = g.lda;
    unsigned voffA[2], voffB[2];
#pragma unroll
    for (int i = 0; i < 2; ++i) { int R, C; stage_rc(tid * 16 + i * 8192, R, C); const int Rb = Epi::PERM ? ((R & ~31) + perm32(R & 31)) : R;
        voffA[i] = (unsigned)(R * lda + C) * 2u; voffB[i] = (unsigned)(Rb * K + C) * 2u; }
    const size_t kstep = (size_t)(BK * 2);
    const size_t hsA = (size_t)HALF * lda * 2, hsB = (size_t)HALF * K * 2;
    const size_t tsA = 2 * hsA, tsB = 2 * hsB;
    const unsigned ldsw = (unsigned)wid * 1024u;
    const int aoff = lds_byte(wr * 64 + fr, fq * 8), boff = lds_byte(wc * 32 + fr, fq * 8);
#define PG8_SA(b, h) (((b) * 2 + (h)) * HTB)
#define PG8_SB(b, h) ((4 + (b) * 2 + (h)) * HTB)
#define PG8_STAGE(bufoff, gbase, voff) do { _Pragma("unroll") for (int _i = 0; _i < 2; ++_i) \
        __builtin_amdgcn_global_load_lds((const unsigned*)((const char*)(gbase) + (voff)[_i]), (PG8_LAS unsigned*)(lds + (bufoff) + ldsw + _i * 8192), 16, 0, 0); } while (0)
#define PG8_LDA(dst, b, h) do { _Pragma("unroll") for (int m = 0; m < 4; ++m) _Pragma("unroll") for (int k = 0; k < 2; ++k) dst[m][k] = *(const PG8_LAS bf16x8*)(lds + PG8_SA(b, h) + aoff + m * 2048 + k * 1024); } while (0)
#define PG8_LDB(dst, b, h) do { _Pragma("unroll") for (int n = 0; n < 2; ++n) _Pragma("unroll") for (int k = 0; k < 2; ++k) dst[n][k] = *(const PG8_LAS bf16x8*)(lds + PG8_SB(b, h) + boff + n * 2048 + k * 1024); } while (0)
#define PG8_MMA(ai, bj, At, Bt) do { __builtin_amdgcn_s_setprio(1); _Pragma("unroll") for (int m = 0; m < 4; ++m) _Pragma("unroll") for (int n = 0; n < 2; ++n) _Pragma("unroll") for (int k = 0; k < 2; ++k) \
        acc[ai][bj][m][n] = __builtin_amdgcn_mfma_f32_16x16x32_bf16(Bt[n][k], At[m][k], acc[ai][bj][m][n], 0, 0, 0); __builtin_amdgcn_s_setprio(0); } while (0)
#define PG8_WAIT_V(n) asm volatile("s_waitcnt vmcnt(" #n ")" ::: "memory")
#define PG8_WAIT_L(n) asm volatile("s_waitcnt lgkmcnt(" #n ")" ::: "memory")
#define PG8_BAR __builtin_amdgcn_s_barrier()
#define PG8_SCHED __builtin_amdgcn_sched_barrier(0)
    Unit cur, nxt; int ui = 0;
    if (!S.next(0, cur)) return;
    f32x4 acc[2][2][4][2];
#pragma unroll
    for (int a = 0; a < 2; ++a)
#pragma unroll
        for (int b = 0; b < 2; ++b)
#pragma unroll
            for (int m = 0; m < 4; ++m)
#pragma unroll
                for (int n = 0; n < 2; ++n) acc[a][b][m][n] = (f32x4){0.f, 0.f, 0.f, 0.f};
    bf16x8 At[4][2], B0[2][2], B1[2][2];
    const char* cA = (const char*)g.A + (size_t)cur.pm * tsA; const char* cB = (const char*)g.Bt + (size_t)cur.pn * tsB;
    S.a_ready(cur);
    if constexpr (SP2) {
        PG8_STAGE(PG8_SB(0, 0), cB, voffB); PG8_STAGE(PG8_SB(0, 1), cB + hsB, voffB); PG8_STAGE(PG8_SA(0, 0), cA, voffA); PG8_STAGE(PG8_SA(0, 1), cA + hsA, voffA);
        if (wr == 1) PG8_BAR;
        PG8_WAIT_V(2); PG8_BAR;
        PG8_STAGE(PG8_SB(1, 0), cB + kstep, voffB); PG8_STAGE(PG8_SA(1, 0), cA + kstep, voffA); PG8_STAGE(PG8_SB(1, 1), cB + hsB + kstep, voffB);
        PG8_WAIT_V(6); PG8_BAR;
    } else {
        PG8_STAGE(PG8_SB(0, 0), cB, voffB); PG8_STAGE(PG8_SA(0, 0), cA, voffA); PG8_STAGE(PG8_SB(0, 1), cB + hsB, voffB); PG8_STAGE(PG8_SA(0, 1), cA + hsA, voffA);
        if (wr == 1) PG8_BAR;
        PG8_WAIT_V(4); PG8_BAR;
        PG8_STAGE(PG8_SB(1, 0), cB + kstep, voffB); PG8_STAGE(PG8_SA(1, 0), cA + kstep, voffA); PG8_STAGE(PG8_SB(1, 1), cB + hsB + kstep, voffB);
        PG8_WAIT_V(6); PG8_BAR;
    }
    u32x4 held[4]; bool have_held = false; Unit hu = cur;
    for (;;) {
        const bool has_next = S.next(ui + 1, nxt);
        const char* nA = has_next ? (const char*)g.A + (size_t)nxt.pm * tsA : cA; const char* nB = has_next ? (const char*)g.Bt + (size_t)nxt.pn * tsB : cB;
        for (int t = 0; t < nt; t += 2) {
            const bool last = (t == nt - 2);
            const char* a1 = cA + (size_t)(t + 1) * kstep;
            const char* a2 = last ? nA : cA + (size_t)(t + 2) * kstep; const char* b2 = last ? nB : cB + (size_t)(t + 2) * kstep;
            const char* a3 = a2 + kstep; const char* b3 = b2 + kstep;
            if (last && has_next) S.a_ready(nxt);
            if constexpr (Epi::DEFER) { if (have_held && (t == 2 || t == 6)) E.store_held(held, hu, (t - 2) >> 2, wr, wc, fr, fq); }
            if constexpr (SP2) {
            PG8_LDB(B0, 0, 0); PG8_LDB(B1, 0, 1); PG8_SCHED; PG8_LDA(At, 0, 0); PG8_STAGE(PG8_SA(1, 1), a1 + hsA, voffA);
            PG8_WAIT_V(8); PG8_WAIT_L(0); PG8_BAR; PG8_MMA(0, 0, At, B0); PG8_MMA(0, 1, At, B1); PG8_BAR; PG8_SCHED;
            PG8_LDA(At, 0, 1); PG8_STAGE(PG8_SB(0, 0), b2, voffB); PG8_STAGE(PG8_SB(0, 1), b2 + hsB, voffB); PG8_STAGE(PG8_SA(0, 0), a2, voffA);
            PG8_WAIT_V(8); PG8_WAIT_L(0); PG8_BAR; PG8_MMA(1, 0, At, B0); PG8_MMA(1, 1, At, B1); PG8_BAR; PG8_SCHED;
            PG8_LDB(B0, 1, 0); PG8_LDB(B1, 1, 1); PG8_SCHED; PG8_LDA(At, 1, 0); PG8_STAGE(PG8_SA(0, 1), a2 + hsA, voffA);
            PG8_WAIT_V(8); PG8_WAIT_L(0); PG8_BAR; PG8_MMA(0, 0, At, B0); PG8_MMA(0, 1, At, B1); PG8_BAR; PG8_SCHED;
            PG8_LDA(At, 1, 1); PG8_STAGE(PG8_SB(1, 0), b3, voffB); PG8_STAGE(PG8_SB(1, 1), b3 + hsB, voffB); PG8_STAGE(PG8_SA(1, 0), a3, voffA);
            PG8_WAIT_V(8); PG8_WAIT_L(0); PG8_BAR; PG8_MMA(1, 0, At, B0); PG8_MMA(1, 1, At, B1); PG8_BAR; PG8_SCHED;
            } else {
            PG8_LDB(B0, 0, 0); PG8_SCHED; PG8_LDA(At, 0, 0); PG8_STAGE(PG8_SA(1, 1), a1 + hsA, voffA);
            PG8_WAIT_L(8); PG8_BAR; PG8_WAIT_L(0); PG8_MMA(0, 0, At, B0); PG8_BAR; PG8_SCHED;
            PG8_LDB(B1, 0, 1); PG8_STAGE(PG8_SB(0, 0), b2, voffB);
            PG8_BAR; PG8_WAIT_L(0); PG8_MMA(0, 1, At, B1); PG8_BAR;
            PG8_LDA(At, 0, 1); PG8_STAGE(PG8_SA(0, 0), a2, voffA);
            PG8_BAR; PG8_WAIT_L(0); PG8_MMA(1, 0, At, B0); PG8_BAR; PG8_SCHED;
            PG8_STAGE(PG8_SB(0, 1), b2 + hsB, voffB);
            PG8_WAIT_V(6); PG8_BAR; PG8_MMA(1, 1, At, B1); PG8_BAR;
            PG8_LDB(B0, 1, 0); PG8_SCHED; PG8_LDA(At, 1, 0); PG8_STAGE(PG8_SA(0, 1), a2 + hsA, voffA);
            PG8_WAIT_L(8); PG8_BAR; PG8_WAIT_L(0); PG8_MMA(0, 0, At, B0); PG8_BAR; PG8_SCHED;
            PG8_LDB(B1, 1, 1); PG8_STAGE(PG8_SB(1, 0), b3, voffB);
            PG8_BAR; PG8_WAIT_L(0); PG8_MMA(0, 1, At, B1); PG8_BAR;
            PG8_LDA(At, 1, 1); PG8_STAGE(PG8_SA(1, 0), a3, voffA);
            PG8_BAR; PG8_WAIT_L(0); PG8_MMA(1, 0, At, B0); PG8_BAR; PG8_SCHED;
            PG8_STAGE(PG8_SB(1, 1), b3 + hsB, voffB);
            PG8_WAIT_V(6); PG8_BAR; PG8_MMA(1, 1, At, B1); PG8_BAR;
            }
        }
        if constexpr (ALIGN_EPI) { if (wr == 0) PG8_BAR; }
        if constexpr (Epi::DEFER) {
            have_held = E.first_half_and_pack(acc, cur, wr, wc, fr, fq, held); hu = cur;
            if (!has_next) { if (have_held) { for (int q = 0; q < 2; ++q) E.store_held(held, hu, q, wr, wc, fr, fq); } S.done(cur); break; }
            S.done(cur);
        } else {
            E(acc, cur, wr, wc, fr, fq); S.done(cur);
            if (!has_next) break;
        }
#pragma unroll
        for (int a = 0; a < 2; ++a)
#pragma unroll
            for (int b = 0; b < 2; ++b)
#pragma unroll
                for (int m = 0; m < 4; ++m)
#pragma unroll
                    for (int n = 0; n < 2; ++n) acc[a][b][m][n] = (f32x4){0.f, 0.f, 0.f, 0.f};
        cur = nxt; cA = nA; cB = nB; ++ui;
        if constexpr (ALIGN_EPI) { if (wr == 1) PG8_BAR; }
    }
    PG8_WAIT_V(0);
    if constexpr (!ALIGN_EPI) { if (wr == 0) PG8_BAR; }
    PG8_BAR;
#undef PG8_SA
#undef PG8_SB
#undef PG8_STAGE
#undef PG8_LDA
#undef PG8_LDB
#undef PG8_MMA
#undef PG8_WAIT_V
#undef PG8_WAIT_L
#undef PG8_BAR
#undef PG8_SCHED
}
}
struct EpiProj {
    static constexpr bool PERM = true;
    static constexpr bool DEFER = true;
    bf16* proj; float* gates; const LAS float* rstd_tab; bf16* halo;
    __device__ __forceinline__ u32x4v pack8(const pg8::f32x4& a0, const pg8::f32x4& a1, float rs) const {
        const pg8::f32x4 v0 = a0 * rs, v1 = a1 * rs;
        u32x4v w; w.x = pg8::cvt_pk_bf16(v0[0], v0[1]); w.y = pg8::cvt_pk_bf16(v0[2], v0[3]); w.z = pg8::cvt_pk_bf16(v1[0], v1[1]); w.w = pg8::cvt_pk_bf16(v1[2], v1[3]); return w; }
    __device__ __forceinline__ bool first_half_and_pack(const pg8::f32x4 (&acc)[2][2][4][2], const pg8::Unit& u, int wr, int wc, int fr, int fq, pg8::u32x4 (&held)[4]) const {
        const int row0 = u.pm * 256 + wr * 64 + fr;
        if (u.pn < 30) {
#pragma unroll
            for (int ai = 0; ai < 2; ++ai)
#pragma unroll
                for (int m = 0; m < 4; ++m) {
                    const int row = row0 + ai * 128 + m * 16;
                    const float rs = rstd_tab[u.idx * 256 + (row & 255)];
#pragma unroll
                    for (int bj = 0; bj < 2; ++bj) { const u32x4v w = pack8(acc[ai][bj][m][0], acc[ai][bj][m][1], rs);
                        if (ai == 1 && m >= 2) held[(m - 2) * 2 + bj] = w;
                        else *(u32x4v*)(proj + (size_t)row * PP + u.pn * 256 + bj * 128 + wc * 32 + 8 * fq) = w;
                        if (u.pn >= 26 && (row & 511) >= 509)
                            *(u32x4v*)(halo + ((size_t)((row >> 9) * 3 + ((row & 511) - 509))) * 1024 + (u.pn - 26) * 256 + bj * 128 + wc * 32 + 8 * fq) = w; }
                }
            return true;
        }
        if (wc == 0) {
#pragma unroll
            for (int ai = 0; ai < 2; ++ai)
#pragma unroll
                for (int m = 0; m < 4; ++m) { const int row = row0 + ai * 128 + m * 16; const float rs = rstd_tab[u.idx * 256 + (row & 255)];
                    float* gp = gates + (size_t)row * 32 + 8 * fq;
                    *(pg8::f32x4*)(gp) = acc[ai][0][m][0] * rs; *(pg8::f32x4*)(gp + 4) = acc[ai][0][m][1] * rs; }
        }
        return false;
    }
    __device__ __forceinline__ void store_held(const pg8::u32x4 (&held)[4], const pg8::Unit& u, int q, int wr, int wc, int fr, int fq) const {
        bf16* base = proj + (size_t)(u.pm * 256 + wr * 64 + fr + 128) * PP + u.pn * 256 + wc * 32 + 8 * fq;
#pragma unroll
        for (int m = 2; m < 4; ++m) if (m - 2 == q) {
#pragma unroll
            for (int bj = 0; bj < 2; ++bj) *(u32x4v*)(base + (size_t)(m * 16) * PP + bj * 128) = held[(m - 2) * 2 + bj]; }
    }
};
struct EpiRes {
    static constexpr bool PERM = true;
    static constexpr bool DEFER = false;
    bf16* hb; float* ssq; bf16* h2; int last;
    __device__ __forceinline__ void operator()(const pg8::f32x4 (&acc)[2][2][4][2], const pg8::Unit& u, int wr, int wc, int fr, int fq) const {
        const int row0 = u.pm * 256 + wr * 64 + fr, col0 = u.pn * 256 + wc * 32 + 8 * fq;
        u32x4v res[2][4][2];
#pragma unroll
        for (int ai = 0; ai < 2; ++ai)
#pragma unroll
            for (int m = 0; m < 4; ++m)
#pragma unroll
                for (int bj = 0; bj < 2; ++bj) res[ai][m][bj] = *(const u32x4v*)(hb + (size_t)(row0 + ai * 128 + m * 16) * DM + col0 + bj * 128);
#pragma unroll
        for (int ai = 0; ai < 2; ++ai)
#pragma unroll
            for (int m = 0; m < 4; ++m) {
                const int row = row0 + ai * 128 + m * 16;
                float sq = 0.f;
#pragma unroll
                for (int bj = 0; bj < 2; ++bj) {
                    const int col = col0 + bj * 128;
                    const u32x4v rw = res[ai][m][bj];
                    const pg8::f32x4 r0 = (pg8::f32x4){__uint_as_float(rw.x << 16), __uint_as_float(rw.x & 0xffff0000u), __uint_as_float(rw.y << 16), __uint_as_float(rw.y & 0xffff0000u)};
                    const pg8::f32x4 r1 = (pg8::f32x4){__uint_as_float(rw.z << 16), __uint_as_float(rw.z & 0xffff0000u), __uint_as_float(rw.w << 16), __uint_as_float(rw.w & 0xffff0000u)};
                    const pg8::f32x4 v0 = acc[ai][bj][m][0] + r0, v1 = acc[ai][bj][m][1] + r1;
                    u32x4v w; w.x = pg8::cvt_pk_bf16(v0[0], v0[1]); w.y = pg8::cvt_pk_bf16(v0[2], v0[3]); w.z = pg8::cvt_pk_bf16(v1[0], v1[1]); w.w = pg8::cvt_pk_bf16(v1[2], v1[3]);
                    bf16* dst = last ? (bf16*)((char*)h2 + (size_t)row * (PP * 2)) + col : hb + (size_t)row * DM + col;
                    *(u32x4v*)dst = w;
                    sq += (v0[0] * v0[0] + v0[1] * v0[1]) + (v0[2] * v0[2] + v0[3] * v0[3]) + (v1[0] * v1[0] + v1[1] * v1[1]) + (v1[2] * v1[2] + v1[3] * v1[3]);
                }
                sq += __shfl_xor(sq, 16); sq += __shfl_xor(sq, 32);
                if (fq == 0) ssq[(size_t)(u.pn * 4 + wc) * NTOK + row] = sq;
            }
    }
};

constexpr int NIT_WIN = (DM / 64) * (NPAD / 32), NIT_WOUT = (DINNER / 64) * (DM / 32);
template <int NR>
__device__ __forceinline__ void rows_to_bf16_rstd(const float* x, bf16* hb, float* rstd, int m0, int mstride, int lane) {
    f32x4v v[NR][4];
#pragma unroll
    for (int q = 0; q < NR; ++q) { const f32x4v* xr = (const f32x4v*)(x + (size_t)(m0 + q * mstride) * DM) + lane;
#pragma unroll
        for (int j = 0; j < 4; ++j) v[q][j] = __builtin_nontemporal_load(xr + 64 * j); }
#pragma unroll
    for (int q = 0; q < NR; ++q) { float s = 0.f;
#pragma unroll
        for (int j = 0; j < 4; ++j) s += (v[q][j].x * v[q][j].x + v[q][j].y * v[q][j].y) + (v[q][j].z * v[q][j].z + v[q][j].w * v[q][j].w);
        s = wave_sum(s);
        if (lane == 0) rstd[m0 + q * mstride] = 1.0f / sqrtf(s * (1.0f / DM) + EPS);
        u32x2v* o8 = (u32x2v*)(hb + (size_t)(m0 + q * mstride) * DM) + lane;
#pragma unroll
        for (int j = 0; j < 4; ++j) { u32x2v w; w.x = cvt_pk2(v[q][j].x, v[q][j].y); w.y = cvt_pk2(v[q][j].z, v[q][j].w); o8[64 * j] = w; } }
}
template <bool WIN>
__device__ __forceinline__ void transpose_item(const float* W, int K, int Nsrc, int Ndst, bf16* WT, LAS float* scr, int item, int lane, const float* kscale) {
    const int nb_n = Ndst / 32, kb = item / nb_n, nb = item % nb_n, k0 = 64 * kb, n0 = 32 * nb;
    const int n4 = (lane & 7) * 4; const int src = WIN ? win_src_col(n0 + n4) : (n0 + n4);
#pragma unroll
    for (int i = 0; i < 8; ++i) { const int kk = 8 * i + (lane >> 3);
        f32x4v v = (f32x4v){0.f, 0.f, 0.f, 0.f}; if (src >= 0) { v = __builtin_nontemporal_load((const f32x4v*)(W + (size_t)(k0 + kk) * Nsrc + src)); if (WIN) v = v * kscale[k0 + kk]; }
        scr[kk * 33 + n4] = v.x; scr[kk * 33 + n4 + 1] = v.y; scr[kk * 33 + n4 + 2] = v.z; scr[kk * 33 + n4 + 3] = v.w; }
    asm volatile("s_waitcnt lgkmcnt(0)" ::: "memory");
    const int c = lane & 7;
#pragma unroll
    for (int j = 0; j < 4; ++j) { const int n = (lane >> 3) + 8 * j; const LAS float* s = scr + (8 * c) * 33 + n;
        u32x4v o; o.x = cvt_pk2(s[0 * 33], s[1 * 33]); o.y = cvt_pk2(s[2 * 33], s[3 * 33]); o.z = cvt_pk2(s[4 * 33], s[5 * 33]); o.w = cvt_pk2(s[6 * 33], s[7 * 33]);
        *(u32x4v*)(WT + (size_t)(n0 + n) * K + k0 + 8 * c) = o; }
    asm volatile("s_waitcnt lgkmcnt(0)" ::: "memory");
}
struct TItem { const float* W; bf16* WT; const float* kscale; int K, Nsrc, k0, n0, src; bool win; };
__device__ __forceinline__ TItem cvt_item(KP P, int l, int it, int lane) {
    const int n_in = (l + 1 < DEPTH) ? NIT_WIN : 0; TItem t;
    if (it < n_in) { t.W = P->w_in + (size_t)(l + 1) * DM * DPROJ; t.K = DM; t.Nsrc = DPROJ; t.WT = (bf16*)((unsigned char*)P->out + DO_WIN + (size_t)(l + 1) * DO_WIN_STRIDE); t.kscale = P->norm_w + (l + 1) * DM; t.win = true;
        const int nb_n = NPAD / 32; t.k0 = 64 * (it / nb_n); t.n0 = 32 * (it % nb_n); t.src = win_src_col(t.n0 + (lane & 7) * 4); }
    else { const int i2 = it - n_in; t.W = P->w_out + (size_t)l * DINNER * DM; t.K = DINNER; t.Nsrc = DM; t.WT = (bf16*)(P->ws + WS_WOUT) + (size_t)l * DM * DINNER; t.kscale = nullptr; t.win = false;
        const int nb_n = DM / 32; t.k0 = 64 * (i2 / nb_n); t.n0 = 32 * (i2 % nb_n); t.src = t.n0 + (lane & 7) * 4; }
    return t;
}
__device__ __forceinline__ void cvt_load(const TItem& t, int lane, f32x4v (&v)[8]) {
#pragma unroll
    for (int i = 0; i < 8; ++i) { const int kk = 8 * i + (lane >> 3);
        v[i] = (f32x4v){0.f, 0.f, 0.f, 0.f}; if (t.src >= 0) { v[i] = __builtin_nontemporal_load((const f32x4v*)(t.W + (size_t)(t.k0 + kk) * t.Nsrc + t.src)); if (t.win) v[i] = v[i] * t.kscale[t.k0 + kk]; } }
}
__device__ __forceinline__ void cvt_finish(const TItem& t, int lane, const f32x4v (&v)[8], LAS float* scr) {
    const int n4 = (lane & 7) * 4;
#pragma unroll
    for (int i = 0; i < 8; ++i) { const int kk = 8 * i + (lane >> 3);
        scr[kk * 33 + n4] = v[i].x; scr[kk * 33 + n4 + 1] = v[i].y; scr[kk * 33 + n4 + 2] = v[i].z; scr[kk * 33 + n4 + 3] = v[i].w; }
    asm volatile("s_waitcnt lgkmcnt(0)" ::: "memory");
    const int c = lane & 7;
#pragma unroll
    for (int j = 0; j < 4; ++j) { const int n = (lane >> 3) + 8 * j; const LAS float* sp = scr + (8 * c) * 33 + n;
        u32x4v o; o.x = cvt_pk2(sp[0 * 33], sp[1 * 33]); o.y = cvt_pk2(sp[2 * 33], sp[3 * 33]); o.z = cvt_pk2(sp[4 * 33], sp[5 * 33]); o.w = cvt_pk2(sp[6 * 33], sp[7 * 33]);
        *(u32x4v*)(t.WT + (size_t)(t.n0 + n) * t.K + t.k0 + 8 * c) = o; }
    asm volatile("s_waitcnt lgkmcnt(0)" ::: "memory");
}
__device__ __forceinline__ void phase_prologue(KP P, int bid, int nblk, LAS unsigned char* lds) {
    const int tid = opaque_tid(), lane = tid & 63, wave = tid >> 6;
    const int gw = bid * 8 + wave, ngw = nblk * 8;
    LAS float* scr = (LAS float*)(lds + wave * 16384);
    bf16* hb = (bf16*)((unsigned char*)P->out + DO_HB); float* rstd0 = (float*)(P->ws + WS_RSTD0);
    { int m = gw;
      for (; m + 7 * ngw < NTOK; m += 8 * ngw) rows_to_bf16_rstd<8>(P->x, hb, rstd0, m, ngw, lane);
      for (; m + 3 * ngw < NTOK; m += 4 * ngw) rows_to_bf16_rstd<4>(P->x, hb, rstd0, m, ngw, lane);
      for (; m < NTOK; m += ngw) rows_to_bf16_rstd<1>(P->x, hb, rstd0, m, 0, lane); }
    for (int it = gw; it < NIT_WIN; it += ngw)
        transpose_item<true>(P->w_in, DM, DPROJ, NPAD, (bf16*)((unsigned char*)P->out + DO_WIN), scr, it, lane, P->norm_w);
}
constexpr int CVT_BATCH = 1;
__device__ __forceinline__ void convert_weights_late(KP P, int l, int gw, int ngw, LAS unsigned char* lds) {
    const int tid = opaque_tid(), lane = tid & 63, wave = tid >> 6;
    LAS float* scr = (LAS float*)(lds + wave * 16384);
    const int n_in = (l + 1 < DEPTH) ? NIT_WIN : 0;
    for (int it = gw; it < n_in + NIT_WOUT; it += ngw) {
        if (it < n_in) transpose_item<true>(P->w_in + (size_t)(l + 1) * DM * DPROJ, DM, DPROJ, NPAD, (bf16*)((unsigned char*)P->out + DO_WIN + (size_t)(l + 1) * DO_WIN_STRIDE), scr, it, lane, P->norm_w + (l + 1) * DM);
        else transpose_item<false>(P->w_out + (size_t)l * DINNER * DM, DINNER, DM, DM, (bf16*)(P->ws + WS_WOUT) + (size_t)l * DM * DINNER, scr, it - n_in, lane, nullptr);
    }
}
__device__ __forceinline__ void convert_weights_queue(KP P, int l, LAS unsigned char* lds) {
    const int tid = opaque_tid(), lane = tid & 63, wave = tid >> 6;
    LAS float* scr = (LAS float*)(lds + wave * 16384);
    volatile LAS int* slot = (volatile LAS int*)(lds + 8 * 16384);
    const int ntot = ((l + 1 < DEPTH) ? NIT_WIN : 0) + NIT_WOUT;
    unsigned* ctr = (unsigned*)(P->ws + WS_CTL) + 64 + 32 * l;
    for (;;) {
        if (tid == 0) *slot = (int)__hip_atomic_fetch_add(ctr, 16u, __ATOMIC_RELAXED, __HIP_MEMORY_SCOPE_AGENT);
        __syncthreads();
        const int base = __builtin_amdgcn_readfirstlane(*slot);
        __syncthreads();
        if (base >= ntot) break;
        const int i0 = base + wave, i1 = base + 8 + wave;
        f32x4v va[8], vb[8]; TItem ta, tb;
        if (i0 < ntot) { ta = cvt_item(P, l, i0, lane); cvt_load(ta, lane, va); }
        if (i1 < ntot) { tb = cvt_item(P, l, i1, lane); cvt_load(tb, lane, vb); }
        if (i0 < ntot) cvt_finish(ta, lane, va, scr);
        if (i1 < ntot) cvt_finish(tb, lane, vb, scr);
    }
}
__device__ __forceinline__ void phase_gemm_in(KP P, int l, int bid, int nblk, LAS unsigned char* lds) {
    pg8::Gemm g{(const bf16*)((unsigned char*)P->out + DO_HB), (const bf16*)((unsigned char*)P->out + DO_WIN + (size_t)l * DO_WIN_STRIDE), NTOK, NPAD, DM, DM};
    pg8::StaticOrder S; S.init(NTOK, NPAD, nblk, bid);
    LAS float* rtab = (LAS float*)(lds + 131072);
    { const int tid = opaque_tid(); const float* rstd0 = (const float*)(P->ws + WS_RSTD0); const float* ssq = (const float*)(P->ws + WS_SSQ);
      const int nunit = min(((NTOK / 256) * (NPAD / 256) + nblk - 1) / nblk, 31);
      for (int e = tid; e < nunit * 256; e += 512) { pg8::Unit u; const int i = e >> 8;
          if (S.next(i, u)) { const int row = u.pm * 256 + (e & 255); float r;
              if (l == 0) r = rstd0[row];
              else { float sum = 0.f;
#pragma unroll
                  for (int p = 0; p < 16; ++p) sum += ssq[(size_t)p * NTOK + row];
                  r = 1.0f / sqrtf(sum * (1.0f / DM) + EPS); }
              rtab[e] = r; } }
      __syncthreads(); }
    EpiProj E{(bf16*)(P->ws + WS_PROJ), (float*)(P->ws + WS_GATES), rtab, (bf16*)(P->ws + WS_HALO)};
    pg8::gemm_phase<EpiProj, pg8::StaticOrder, true, true>(lds, g, S, E);
}
__device__ __forceinline__ void phase_gemm_out(KP P, int l, int bid, int nblk, LAS unsigned char* lds) {
    pg8::Gemm g{(const bf16*)(P->ws + WS_PROJ), (const bf16*)(P->ws + WS_WOUT) + (size_t)l * DM * DINNER, NTOK, DM, DINNER, PP};
    pg8::StaticOrder S; S.init(NTOK, DM, nblk, bid);
    EpiRes E{(bf16*)((unsigned char*)P->out + DO_HB), (float*)(P->ws + WS_SSQ), (bf16*)(P->ws + WS_PROJ + 4096), (l == DEPTH - 1) ? 1 : 0};
    pg8::gemm_phase<EpiRes, pg8::StaticOrder, false, true>(lds, g, S, E);
}
__device__ __forceinline__ void phase_final(KP P, int bid, int nblk) {
    const int tid = opaque_tid(), lane = tid & 63, wave = tid >> 6;
    const int gw = bid * 8 + wave, ngw = nblk * 8;
    const float* ssq = (const float*)(P->ws + WS_SSQ);
    f32x4v wv[4];
#pragma unroll
    for (int j = 0; j < 4; ++j) wv[j] = *((const f32x4v*)P->final_norm_w + 2 * lane + (j & 1) + 128 * (j >> 1));
    for (int m0 = gw; m0 < NTOK; m0 += 2 * ngw) {
        u32x4v ha[2], hb_[2]; float sp[2];
#pragma unroll
        for (int q = 0; q < 2; ++q) { const int m = m0 + q * ngw; const u32x4v* hr = (const u32x4v*)(P->ws + WS_PROJ + 4096 + (size_t)m * (PP * 2));
            ha[q] = __builtin_nontemporal_load(hr + lane); hb_[q] = __builtin_nontemporal_load(hr + 64 + lane); sp[q] = (lane < 16) ? ssq[(size_t)lane * NTOK + m] : 0.f; }
#pragma unroll
        for (int q = 0; q < 2; ++q) { const int m = m0 + q * ngw;
            const float rs = 1.0f / sqrtf(wave_sum(sp[q]) * (1.0f / DM) + EPS);
            f32x4v* o = (f32x4v*)(P->out + (size_t)m * DM);
            f32x4v v;
            v = (f32x4v){__uint_as_float(ha[q].x << 16), __uint_as_float(ha[q].x & 0xffff0000u), __uint_as_float(ha[q].y << 16), __uint_as_float(ha[q].y & 0xffff0000u)}; o[2 * lane] = v * rs * wv[0];
            v = (f32x4v){__uint_as_float(ha[q].z << 16), __uint_as_float(ha[q].z & 0xffff0000u), __uint_as_float(ha[q].w << 16), __uint_as_float(ha[q].w & 0xffff0000u)}; o[2 * lane + 1] = v * rs * wv[1];
            v = (f32x4v){__uint_as_float(hb_[q].x << 16), __uint_as_float(hb_[q].x & 0xffff0000u), __uint_as_float(hb_[q].y << 16), __uint_as_float(hb_[q].y & 0xffff0000u)}; o[128 + 2 * lane] = v * rs * wv[2];
            v = (f32x4v){__uint_as_float(hb_[q].z << 16), __uint_as_float(hb_[q].z & 0xffff0000u), __uint_as_float(hb_[q].w << 16), __uint_as_float(hb_[q].w & 0xffff0000u)}; o[128 + 2 * lane + 1] = v * rs * wv[3]; }
    }
}
namespace mx {
typedef short bf16x8 __attribute__((ext_vector_type(8)));
typedef float f32x4 __attribute__((ext_vector_type(4)));
constexpr int SEGL = 512, NSEG = SEQ / SEGL, CH = 64, NCH = SEGL / CH;
constexpr int L_QT = 0, L_KT = 17408, L_KTT = 34816, L_VT = 53248, L_PM = 73984, L_ST = 92416, L_VVT = 131584, L_VEC = 150016;
constexpr int V_TOT = 0, V_PRE = 4096, V_POST = 4608, V_MISC = 5120;
constexpr size_t ST_GLA = 0, ST_HGRN = 1048576, ST_ML = 3145728, ST_SSD = 5505024;
constexpr int DS_GLA = 0, DS_HGRN = 8192, DS_ML = 24576, DS_SSD = 25600;

__device__ __forceinline__ int opq(int v) { asm volatile("" : "+v"(v)); return v; }
#define MFMA16(a, b, c) __builtin_amdgcn_mfma_f32_16x16x32_bf16((a), (b), (c), 0, 0, 0)
__device__ __forceinline__ bf16x8 frag(LAS unsigned char* base, int row, int pitch, int ks, int qd) { return *(const LAS bf16x8*)(base + row * pitch + ks * 64 + qd * 16); }
__device__ __forceinline__ int sw64(int row, int byteoff) { return row * 128 + ((((byteoff >> 4) ^ ((row >> 1) & 7)) << 4) | (byteoff & 15)); }
__device__ __forceinline__ bf16x8 frag64(LAS unsigned char* base, int row, int ks, int qd) { return *(const LAS bf16x8*)(base + row * 128 + (((4 * ks + qd) ^ ((row >> 1) & 7)) << 4)); }
template <int PQ> __device__ __forceinline__ int offp(int row, int byteoff) { return PQ == 272 ? row * 272 + byteoff : sw64(row, byteoff); }
template <int PQ> __device__ __forceinline__ bf16x8 fragp(LAS unsigned char* base, int row, int ks, int qd) { return PQ == 272 ? frag(base, row, 272, ks, qd) : frag64(base, row, ks, qd); }
__device__ __forceinline__ unsigned cvtpk(float lo, float hi) { return cvt_pk2(lo, hi); }
__device__ __forceinline__ u32x2v pack4(f32x4 v) { u32x2v w; w.x = cvtpk(v[0], v[1]); w.y = cvtpk(v[2], v[3]); return w; }
__device__ __forceinline__ float lo2f(unsigned w) { return __uint_as_float(w << 16); }
__device__ __forceinline__ float hi2f(unsigned w) { return __uint_as_float(w & 0xffff0000u); }

__device__ __forceinline__ float fexp(float x) { return __builtin_amdgcn_exp2f(x * 1.4426950408889634f); }
__device__ __forceinline__ float flog(float x) { return __builtin_amdgcn_logf(x) * 0.6931471805599453f; }
__device__ __forceinline__ float frcp(float x) { return __builtin_amdgcn_rcpf(x); }
__device__ __forceinline__ float frsq(float x) { return __builtin_amdgcn_rsqf(x); }
__device__ __forceinline__ float fsigmoid(float x) { return frcp(1.f + fexp(-x)); }
__device__ __forceinline__ float fsilu(float x) { return x * frcp(1.f + fexp(-x)); }
__device__ __forceinline__ float flog1pexp(float nx) { return flog(1.f + fexp(nx)); }
__device__ __forceinline__ float flogsigmoid(float x) { return fminf(x, 0.f) - flog1pexp(-fabsf(x)); }
__device__ __forceinline__ float fsoftplus(float x) { return fmaxf(x, 0.f) + flog1pexp(-fabsf(x)); }

constexpr int FLAG_OFF = 8192, FLAG_SSD = 0, FLAG_ML = 64, FLAG_HG = 192, FLAG_GLA = 320;
__device__ __forceinline__ unsigned* flag_ptr(KP P, int fbase, int idx) { return (unsigned*)(P->ws + WS_CTL) + FLAG_OFF + (fbase + idx) * 16; }
__device__ __forceinline__ void st_wt(bf16* p, u32x2v v) { __hip_atomic_store((unsigned long long*)p, ((unsigned long long)v.y << 32) | v.x, __ATOMIC_RELAXED, __HIP_MEMORY_SCOPE_AGENT); }
__device__ __forceinline__ void st_wt_f(float* p, float v) { __hip_atomic_store(p, v, __ATOMIC_RELAXED, __HIP_MEMORY_SCOPE_AGENT); }
__device__ __forceinline__ void publish_item(unsigned* flag, unsigned epoch) {
    asm volatile("s_waitcnt vmcnt(0)" ::: "memory");
    __syncthreads();
    if (threadIdx.x == 0) __hip_atomic_store(flag, epoch, __ATOMIC_RELAXED, __HIP_MEMORY_SCOPE_AGENT);
}
__device__ __forceinline__ void wait_predecessors(unsigned* flag0, int s, unsigned epoch) {
    {
        if ((int)threadIdx.x < 64) {
            if ((int)threadIdx.x < s) { unsigned spins = 0;
                while (__hip_atomic_load(flag0 + threadIdx.x * 16, __ATOMIC_RELAXED, __HIP_MEMORY_SCOPE_AGENT) < epoch) { __builtin_amdgcn_s_sleep(2); if (++spins > (1u << 22)) break; } }
            __builtin_amdgcn_fence(__ATOMIC_ACQUIRE, "agent");
            asm volatile("s_waitcnt vmcnt(0)" ::: "memory");
        }
    }
    __syncthreads();
}

template <int TYPE, bool OUT, bool DRY = false>
__device__ __forceinline__ void pc_item(KP P, int l, int b, int h, int s, LAS unsigned char* lds) {
    if (!OUT && s == NSEG - 1) return;
    constexpr int DK = (TYPE == 0) ? 64 : 128, NDT = DK / 16, PQ = (DK == 128) ? 272 : 144, NKS = DK / 32;
    const int tid = opaque_tid(), lane = tid & 63, w = __builtin_amdgcn_readfirstlane(tid >> 6), r = lane & 15, qd = lane >> 4;
    const int cp = lane, g = w;
    constexpr int NTK = (TYPE == 0) ? 4 : 8;
    const int ck = (TYPE == 0) ? (lane & 31) : lane, th = (TYPE == 0) ? (lane >> 5) : 0;
    const bool kact = true;
    bf16* proj = (bf16*)(P->ws + WS_PROJ);
    LAS float* vtot = (LAS float*)(lds + L_VEC + V_TOT); LAS float* vpre = (LAS float*)(lds + L_VEC + V_PRE); LAS float* vpost = (LAS float*)(lds + L_VEC + V_POST);
    const int QCOL = (TYPE == 0) ? AQc(h) : CQc(h), KCOL = (TYPE == 0) ? AKc(h) : CFc(h), VCOL = (TYPE == 0) ? AVc(h) : CIc(h), ZCOL = ((TYPE == 0) ? ZA : ZC) + h * 128;
    const float qscale = (TYPE == 0) ? 0.125f : 0.08838834764831845f;
    const int idx = (b * 4 + h) * NSEG + s;
    bf16* stbase = (bf16*)((unsigned char*)P->out + DO_STATE) + ((TYPE == 0) ? ST_GLA : ST_HGRN);
    float* dsbase = (float*)(P->ws + WS_MISC) + ((TYPE == 0) ? DS_GLA : DS_HGRN);
    float lb0 = 0.f, lb1 = 0.f, gb0 = 0.f, gb1 = 0.f, gw0[16], gw1[16];
#pragma unroll
    for (int rr = 0; rr < 16; ++rr) { gw0[rr] = 0.f; gw1[rr] = 0.f; }
    if (kact) {
        if (TYPE == 2) {
#pragma unroll
            for (int c2 = 0; c2 < 2; ++c2) { const int ch = h * 128 + 2 * ck + c2;
                float mx_ = -1e30f; for (int i = 0; i < DEPTH; ++i) mx_ = fmaxf(mx_, P->hg_lb[i * 512 + ch]);
                float den = 0.f, num = 0.f; for (int i = 0; i < DEPTH; ++i) { const float e = fexp(P->hg_lb[i * 512 + ch] - mx_); den += e; if (i >= 1 && i <= l) num += e; }
                if (c2 == 0) lb0 = num / den; else lb1 = num / den; }
        } else {
#pragma unroll
            for (int rr = 0; rr < 16; ++rr) { gw0[rr] = P->gla_gate_w[((size_t)l * 16 + rr) * 256 + h * 64 + 2 * ck]; gw1[rr] = P->gla_gate_w[((size_t)l * 16 + rr) * 256 + h * 64 + 2 * ck + 1]; }
            gb0 = P->gla_gate_b[l * 256 + h * 64 + 2 * ck]; gb1 = P->gla_gate_b[l * 256 + h * 64 + 2 * ck + 1];
        }
    }
    unsigned rq[8], rk[8], rv[8]; f32x4 grv = (f32x4){0.f, 0.f, 0.f, 0.f};
#define PC_LOAD(cc) do { const size_t rw_ = (size_t)b * SEQ + (size_t)s * SEGL + (size_t)(cc) * CH + 8 * g; \
        _Pragma("unroll") for (int jj = 0; jj < 8; ++jj) rv[jj] = *(const unsigned*)(proj + (rw_ + jj) * PP + VCOL + 2 * cp); \
        _Pragma("unroll") for (int jj = 0; jj < NTK; ++jj) { const bf16* pr = proj + (rw_ + NTK * th + jj) * PP; \
            rk[jj] = *(const unsigned*)(pr + KCOL + 2 * ck); rq[jj] = OUT ? *(const unsigned*)(pr + QCOL + 2 * ck) : 0u; } \
        if (TYPE == 0) { if (lane < 32) grv = *(const f32x4*)((const float*)(P->ws + WS_GATES) + (rw_ + (lane >> 2)) * 32 + G_GR + (lane & 3) * 4); } } while (0)
    PC_LOAD(0);
    f32x4 S[NDT];
#pragma unroll
    for (int dt = 0; dt < NDT; ++dt) S[dt] = (f32x4){0.f, 0.f, 0.f, 0.f};
    if (OUT) {
        wait_predecessors(flag_ptr(P, (TYPE == 0) ? FLAG_GLA : FLAG_HG, idx - s), s, (unsigned)l + 1u);
        LAS float* vds = (LAS float*)(lds + L_QT);
        for (int i = tid; i < s * DK; i += 512) vds[i] = dsbase[(size_t)(idx - s) * DK + i];
        __syncthreads();
        for (int sp0 = 0; sp0 < s; sp0 += 4) {
            u32x2v raw[4][NDT];
#pragma unroll
            for (int u = 0; u < 4; ++u) { const int sp = (sp0 + u < s) ? sp0 + u : s - 1; const bf16* sb = stbase + (size_t)(idx - s + sp) * (DK * 128);
#pragma unroll
                for (int dt = 0; dt < NDT; ++dt) raw[u][dt] = *(const u32x2v*)(sb + ((size_t)(w * NDT + dt) * 64 + lane) * 4); }
#pragma unroll
            for (int u = 0; u < 4; ++u) if (sp0 + u < s) {
#pragma unroll
                for (int dt = 0; dt < NDT; ++dt) { const f32x4 d4 = *(const LAS f32x4*)(vds + (sp0 + u) * DK + 16 * dt + 4 * qd);
                    const f32x4 ds = (f32x4){lo2f(raw[u][dt].x), hi2f(raw[u][dt].x), lo2f(raw[u][dt].y), hi2f(raw[u][dt].y)}; S[dt] = S[dt] * d4 + ds; } }
        }
        __syncthreads();
    }
    float gsum0 = 0.f, gsum1 = 0.f;
    const int ei = tid >> 3, ecc = tid & 7;
    float nw[16];
#pragma unroll
    for (int k = 0; k < 16; ++k) nw[k] = OUT ? ((TYPE == 0) ? P->gla_norm_w : P->hg_norm_w)[l * 512 + h * 128 + 16 * ecc + k] : 0.f;

    constexpr int L_OB = L_VVT;
    float lg0[8], lg1[8], kk0[8], kk1[8];
#define PC_A1() do { \
        if (TYPE == 0) { if (lane < 32) *(LAS f32x4*)((LAS float*)(lds + L_VEC + V_MISC) + g * 128 + (lane >> 2) * 16 + (lane & 3) * 4) = grv; } \
        if (kact) { \
            if (TYPE == 2) { \
                _Pragma("unroll") for (int jj = 0; jj < 8; ++jj) { const float f0 = lo2f(rk[jj]), f1 = hi2f(rk[jj]); \
                    const float s0 = fsigmoid(f0), s1 = fsigmoid(f1); \
                    lg0[jj] = flog(fmaxf(lb0 + (1.f - lb0) * s0, 1e-30f)); lg1[jj] = flog(fmaxf(lb1 + (1.f - lb1) * s1, 1e-30f)); \
                    kk0[jj] = (1.f - lb0) * (1.f - s0); kk1[jj] = (1.f - lb1) * (1.f - s1); } \
            } else { \
                LAS float* vgr = (LAS float*)(lds + L_VEC + V_MISC) + g * 128; \
                _Pragma("unroll") for (int jj = 0; jj < NTK; ++jj) { const LAS f32x4* gr4 = (const LAS f32x4*)(vgr + (NTK * th + jj) * 16); float a0 = gb0, a1 = gb1; \
                    _Pragma("unroll") for (int r4 = 0; r4 < 4; ++r4) { const f32x4 x = gr4[r4]; \
                        _Pragma("unroll") for (int e = 0; e < 4; ++e) { a0 += x[e] * gw0[4 * r4 + e]; a1 += x[e] * gw1[4 * r4 + e]; } } \
                    lg0[jj] = flogsigmoid(a0) * (1.0f / 16.0f); lg1[jj] = flogsigmoid(a1) * (1.0f / 16.0f); \
                    kk0[jj] = lo2f(rk[jj]); kk1[jj] = hi2f(rk[jj]); } \
            } \
            _Pragma("unroll") for (int jj = 1; jj < NTK; ++jj) { lg0[jj] += lg0[jj - 1]; lg1[jj] += lg1[jj - 1]; } \
            if (TYPE == 0) { const float o0 = __shfl_xor(lg0[NTK - 1], 32), o1 = __shfl_xor(lg1[NTK - 1], 32);       \
                if (th) { _Pragma("unroll") for (int jj = 0; jj < NTK; ++jj) { lg0[jj] += o0; lg1[jj] += o1; } } \
                else { vtot[g * 128 + 2 * ck] = lg0[NTK - 1] + o0; vtot[g * 128 + 2 * ck + 1] = lg1[NTK - 1] + o1; } } \
            else { vtot[g * 128 + 2 * ck] = lg0[NTK - 1]; vtot[g * 128 + 2 * ck + 1] = lg1[NTK - 1]; } \
        } } while (0)
#define PC_A2(cc) do { \
        if (kact) { \
            float base0 = 0.f, base1 = 0.f, ref0 = 0.f, ref1 = 0.f, end0 = 0.f, end1 = 0.f; \
            _Pragma("unroll") for (int gg = 0; gg < 8; ++gg) { const float t0 = vtot[gg * 128 + 2 * ck], t1 = vtot[gg * 128 + 2 * ck + 1]; \
                if (gg < g) { base0 += t0; base1 += t1; } if (gg < 4) { ref0 += t0; ref1 += t1; } end0 += t0; end1 += t1; } \
            float kt0[8], kt1[8]; \
            _Pragma("unroll") for (int jj = 0; jj < NTK; ++jj) { const float G0 = base0 + lg0[jj], G1 = base1 + lg1[jj]; \
                kt0[jj] = kk0[jj] * fexp(fminf(ref0 - G0, 80.f)); kt1[jj] = kk1[jj] * fexp(fminf(ref1 - G1, 80.f)); \
                if (OUT) { *(LAS unsigned*)(lds + L_QT + offp<PQ>(8 * g + NTK * th + jj, 4 * ck)) = cvtpk(lo2f(rq[jj]) * qscale * fexp(fminf(G0 - ref0, 80.f)), hi2f(rq[jj]) * qscale * fexp(fminf(G1 - ref1, 80.f))); \
                           *(LAS unsigned*)(lds + L_KT + offp<PQ>(8 * g + NTK * th + jj, 4 * ck)) = cvtpk(kt0[jj], kt1[jj]); } } \
            if (TYPE == 0) { u32x2v t2; \
                t2.x = cvtpk(kt0[0], kt0[1]); t2.y = cvtpk(kt0[2], kt0[3]); *(LAS u32x2v*)(lds + L_KTT + sw64(2 * ck, 16 * g + 8 * th)) = t2; \
                t2.x = cvtpk(kt1[0], kt1[1]); t2.y = cvtpk(kt1[2], kt1[3]); *(LAS u32x2v*)(lds + L_KTT + sw64(2 * ck + 1, 16 * g + 8 * th)) = t2; \
            } else { u32x4v t; \
                t.x = cvtpk(kt0[0], kt0[1]); t.y = cvtpk(kt0[2], kt0[3]); t.z = cvtpk(kt0[4], kt0[5]); t.w = cvtpk(kt0[6], kt0[7]); *(LAS u32x4v*)(lds + L_KTT + (2 * ck) * 128 + ((g ^ (ck & 7)) << 4)) = t; \
                t.x = cvtpk(kt1[0], kt1[1]); t.y = cvtpk(kt1[2], kt1[3]); t.z = cvtpk(kt1[4], kt1[5]); t.w = cvtpk(kt1[6], kt1[7]); *(LAS u32x4v*)(lds + L_KTT + (2 * ck + 1) * 128 + ((g ^ (ck & 7)) << 4)) = t; } \
            if (g == 0 && th == 0) { vpre[2 * ck] = fexp(ref0); vpre[2 * ck + 1] = fexp(ref1); vpost[2 * ck] = fexp(end0 - ref0); vpost[2 * ck + 1] = fexp(end1 - ref1); gsum0 += end0; gsum1 += end1; } \
        } \
        { u32x4v t; \
          t.x = (rv[0] & 0xffffu) | (rv[1] << 16); t.y = (rv[2] & 0xffffu) | (rv[3] << 16); t.z = (rv[4] & 0xffffu) | (rv[5] << 16); t.w = (rv[6] & 0xffffu) | (rv[7] << 16); \
          *(LAS u32x4v*)(lds + L_VT + (2 * cp) * 128 + ((g ^ (cp & 7)) << 4)) = t; \
          t.x = (rv[0] >> 16) | (rv[1] & 0xffff0000u); t.y = (rv[2] >> 16) | (rv[3] & 0xffff0000u); t.z = (rv[4] >> 16) | (rv[5] & 0xffff0000u); t.w = (rv[6] >> 16) | (rv[7] & 0xffff0000u); \
          *(LAS u32x4v*)(lds + L_VT + (2 * cp + 1) * 128 + ((g ^ (cp & 7)) << 4)) = t; } \
        if ((cc) + 1 < NCH) PC_LOAD((cc) + 1); } while (0)
    PC_A1();
    __syncthreads();
    PC_A2(0);
    __syncthreads();
    for (int c = 0; c < NCH; ++c) {
        const size_t rowc = (size_t)b * SEQ + (size_t)s * SEGL + (size_t)c * CH;
        bf16* zp = proj + (rowc + ei) * PP + ZCOL + 16 * ecc;
        u32x4v za = (u32x4v){0u, 0u, 0u, 0u}, zb = za;
        if (OUT) { za = *(const u32x4v*)zp; zb = *(const u32x4v*)(zp + 8); }
#pragma unroll
        for (int dt = 0; dt < NDT; ++dt) { const f32x4 p4 = *(const LAS f32x4*)(vpre + 16 * dt + 4 * qd); S[dt] = S[dt] * p4;
            if (OUT) *(LAS u32x2v*)(lds + L_ST + offp<PQ>(16 * w + r, (16 * dt + 4 * qd) * 2)) = pack4(S[dt]); }
        if (OUT) {
            const int it = w & 3;
#pragma unroll
            for (int j2 = 0; j2 < 2; ++j2) { const int jt = 2 * (w >> 2) + j2; f32x4 acc = (f32x4){0.f, 0.f, 0.f, 0.f};
                if (jt <= it) {
#pragma unroll
                    for (int ks = 0; ks < NKS; ++ks) acc = MFMA16(fragp<PQ>(lds + L_KT, 16 * jt + r, ks, qd), fragp<PQ>(lds + L_QT, 16 * it + r, ks, qd), acc);
                    if (jt == it) {
#pragma unroll
                        for (int rg = 0; rg < 4; ++rg) if (4 * qd + rg > r) acc[rg] = 0.f; }
                }
                *(LAS u32x2v*)(lds + L_PM + sw64(16 * it + r, (16 * jt + 4 * qd) * 2)) = pack4(acc); }
            __syncthreads();
        }
        f32x4 o[4];
        if (OUT) {
#pragma unroll
            for (int it = 0; it < 4; ++it) { o[it] = (f32x4){0.f, 0.f, 0.f, 0.f};
#pragma unroll
                for (int ks = 0; ks < 2; ++ks) if (ks == 0 || it >= 2) o[it] = MFMA16(frag64(lds + L_VT, 16 * w + r, ks, qd), frag64(lds + L_PM, 16 * it + r, ks, qd), o[it]);
#pragma unroll
                for (int ks = 0; ks < NKS; ++ks) o[it] = MFMA16(fragp<PQ>(lds + L_ST, 16 * w + r, ks, qd), fragp<PQ>(lds + L_QT, 16 * it + r, ks, qd), o[it]); }
        }
#pragma unroll
        for (int dt = 0; dt < NDT; ++dt) {
#pragma unroll
            for (int ks = 0; ks < 2; ++ks) S[dt] = MFMA16(frag64(lds + L_KTT, 16 * dt + r, ks, qd), frag64(lds + L_VT, 16 * w + r, ks, qd), S[dt]);
            const f32x4 q4 = *(const LAS f32x4*)(vpost + 16 * dt + 4 * qd); S[dt] = S[dt] * q4; }
        if (c + 1 < NCH) PC_A1();
        if (OUT) {
#pragma unroll
            for (int it = 0; it < 4; ++it) *(LAS u32x2v*)(lds + L_OB + (16 * it + r) * 272 + (16 * w + 4 * qd) * 2) = pack4(o[it]);
        }
        __syncthreads();
        if (c + 1 < NCH) PC_A2(c + 1);
        if (OUT) {
            const u32x4v oa = *(const LAS u32x4v*)(lds + L_OB + ei * 272 + ecc * 32), ob = *(const LAS u32x4v*)(lds + L_OB + ei * 272 + ecc * 32 + 16);
            float ov[16] = {lo2f(oa.x), hi2f(oa.x), lo2f(oa.y), hi2f(oa.y), lo2f(oa.z), hi2f(oa.z), lo2f(oa.w), hi2f(oa.w), lo2f(ob.x), hi2f(ob.x), lo2f(ob.y), hi2f(ob.y), lo2f(ob.z), hi2f(ob.z), lo2f(ob.w), hi2f(ob.w)};
            float ss = 0.f;
#pragma unroll
            for (int k = 0; k < 16; ++k) ss += ov[k] * ov[k];
            ss += __shfl_xor(ss, 1); ss += __shfl_xor(ss, 2); ss += __shfl_xor(ss, 4);
            const float rs = frsq(ss * (1.0f / 128.0f) + EPS);
            const float zv[16] = {lo2f(za.x), hi2f(za.x), lo2f(za.y), hi2f(za.y), lo2f(za.z), hi2f(za.z), lo2f(za.w), hi2f(za.w), lo2f(zb.x), hi2f(zb.x), lo2f(zb.y), hi2f(zb.y), lo2f(zb.z), hi2f(zb.z), lo2f(zb.w), hi2f(zb.w)};
            float y[16];
#pragma unroll
            for (int k = 0; k < 16; ++k) y[k] = ov[k] * rs * nw[k] * fsilu(zv[k]);
            u32x4v ya, yb; ya.x = cvtpk(y[0], y[1]); ya.y = cvtpk(y[2], y[3]); ya.z = cvtpk(y[4], y[5]); ya.w = cvtpk(y[6], y[7]); yb.x = cvtpk(y[8], y[9]); yb.y = cvtpk(y[10], y[11]); yb.z = cvtpk(y[12], y[13]); yb.w = cvtpk(y[14], y[15]);
            if (DRY) { asm volatile("" :: "v"(ya.x), "v"(ya.y), "v"(ya.z), "v"(ya.w), "v"(yb.x), "v"(yb.y), "v"(yb.z), "v"(yb.w)); } else { *(u32x4v*)zp = ya; *(u32x4v*)(zp + 8) = yb; }
        }
        __syncthreads();
    }
    if (!OUT) {
        bf16* sb = stbase + (size_t)idx * (DK * 128);
#pragma unroll
        for (int dt = 0; dt < NDT; ++dt) st_wt(sb + ((size_t)(w * NDT + dt) * 64 + lane) * 4, pack4(S[dt]));
        if (g == 0 && th == 0) { st_wt_f(dsbase + (size_t)idx * DK + 2 * ck, fexp(gsum0)); st_wt_f(dsbase + (size_t)idx * DK + 2 * ck + 1, fexp(gsum1)); }
        publish_item(flag_ptr(P, (TYPE == 0) ? FLAG_GLA : FLAG_HG, idx), (unsigned)l + 1u);
    }
    __syncthreads();
#undef PC_LOAD
#undef PC_A1
#undef PC_A2
}

template <int TYPE>
__device__ __forceinline__ void pc_pass1(KP P, int l, int b, int h, int s, LAS unsigned char* lds) {
    if (s == NSEG - 1) return;
    constexpr int DK = (TYPE == 0) ? 64 : 128, NDT = DK / 16;
    const int tid = opaque_tid(), lane = tid & 63, w = __builtin_amdgcn_readfirstlane(tid >> 6), r = lane & 15, qd = lane >> 4;
    const int cp = lane, g = w;
    constexpr int NTK = (TYPE == 0) ? 4 : 8;
    const int ck = (TYPE == 0) ? (lane & 31) : lane, th = (TYPE == 0) ? (lane >> 5) : 0;
    bf16* proj = (bf16*)(P->ws + WS_PROJ);
    const int KCOL = (TYPE == 0) ? AKc(h) : CFc(h), VCOL = (TYPE == 0) ? AVc(h) : CIc(h);
    const int idx = (b * 4 + h) * NSEG + s;
    bf16* stbase = (bf16*)((unsigned char*)P->out + DO_STATE) + ((TYPE == 0) ? ST_GLA : ST_HGRN);
    float* dsbase = (float*)(P->ws + WS_MISC) + ((TYPE == 0) ? DS_GLA : DS_HGRN);
    float lb0 = 0.f, lb1 = 0.f, gb0 = 0.f, gb1 = 0.f, gw0[16], gw1[16];
#pragma unroll
    for (int rr = 0; rr < 16; ++rr) { gw0[rr] = 0.f; gw1[rr] = 0.f; }
    if (TYPE == 2) {
#pragma unroll
        for (int c2 = 0; c2 < 2; ++c2) { const int ch = h * 128 + 2 * ck + c2;
            float mx_ = -1e30f; for (int i = 0; i < DEPTH; ++i) mx_ = fmaxf(mx_, P->hg_lb[i * 512 + ch]);
            float den = 0.f, num = 0.f; for (int i = 0; i < DEPTH; ++i) { const float e = fexp(P->hg_lb[i * 512 + ch] - mx_); den += e; if (i >= 1 && i <= l) num += e; }
            if (c2 == 0) lb0 = num / den; else lb1 = num / den; }
    } else {
#pragma unroll
        for (int rr = 0; rr < 16; ++rr) { gw0[rr] = P->gla_gate_w[((size_t)l * 16 + rr) * 256 + h * 64 + 2 * ck]; gw1[rr] = P->gla_gate_w[((size_t)l * 16 + rr) * 256 + h * 64 + 2 * ck + 1]; }
        gb0 = P->gla_gate_b[l * 256 + h * 64 + 2 * ck]; gb1 = P->gla_gate_b[l * 256 + h * 64 + 2 * ck + 1];
    }
    f32x4 S[NDT];
#pragma unroll
    for (int dt = 0; dt < NDT; ++dt) S[dt] = (f32x4){0.f, 0.f, 0.f, 0.f};
    float gsum0 = 0.f, gsum1 = 0.f;
#define P1_KTT(par) ((par) ? L_ST : L_KTT)
#define P1_VT(par) ((par) ? L_ST + 16384 : L_VT)
#define P1_TOT(par) ((LAS float*)(lds + ((par) ? L_QT : L_VEC + V_TOT)))
#define P1_PRE(par) ((LAS float*)(lds + ((par) ? L_QT + 4096 : L_VEC + V_PRE)))
#define P1_POST(par) ((LAS float*)(lds + ((par) ? L_QT + 4608 : L_VEC + V_POST)))
    unsigned rk[8], rv[2][8]; f32x4 grv = (f32x4){0.f, 0.f, 0.f, 0.f};
    float lg0[8], lg1[8], kk0[8], kk1[8];
#define P1_LOAD(cc, par) do { const size_t rw_ = (size_t)b * SEQ + (size_t)s * SEGL + (size_t)(cc) * CH + 8 * g; \
        _Pragma("unroll") for (int jj = 0; jj < 8; ++jj) rv[par][jj] = *(const unsigned*)(proj + (rw_ + jj) * PP + VCOL + 2 * cp); \
        _Pragma("unroll") for (int jj = 0; jj < NTK; ++jj) rk[jj] = *(const unsigned*)(proj + (rw_ + NTK * th + jj) * PP + KCOL + 2 * ck); \
        if (TYPE == 0) { if (lane < 32) grv = *(const f32x4*)((const float*)(P->ws + WS_GATES) + (rw_ + (lane >> 2)) * 32 + G_GR + (lane & 3) * 4); } } while (0)
#define P1_A1(par) do { LAS float* vtot_ = P1_TOT(par); \
        if (TYPE == 0) { if (lane < 32) *(LAS f32x4*)((LAS float*)(lds + L_VEC + V_MISC) + g * 128 + (lane >> 2) * 16 + (lane & 3) * 4) = grv; } \
        if (TYPE == 2) { \
            _Pragma("unroll") for (int jj = 0; jj < 8; ++jj) { const float f0 = lo2f(rk[jj]), f1 = hi2f(rk[jj]); \
                const float s0 = fsigmoid(f0), s1 = fsigmoid(f1); \
                lg0[jj] = flog(fmaxf(lb0 + (1.f - lb0) * s0, 1e-30f)); lg1[jj] = flog(fmaxf(lb1 + (1.f - lb1) * s1, 1e-30f)); \
                kk0[jj] = (1.f - lb0) * (1.f - s0); kk1[jj] = (1.f - lb1) * (1.f - s1); } \
        } else { \
            LAS float* vgr = (LAS float*)(lds + L_VEC + V_MISC) + g * 128; \
            _Pragma("unroll") for (int jj = 0; jj < NTK; ++jj) { const LAS f32x4* gr4 = (const LAS f32x4*)(vgr + (NTK * th + jj) * 16); float a0 = gb0, a1 = gb1; \
                _Pragma("unroll") for (int r4 = 0; r4 < 4; ++r4) { const f32x4 x = gr4[r4]; \
                    _Pragma("unroll") for (int e = 0; e < 4; ++e) { a0 += x[e] * gw0[4 * r4 + e]; a1 += x[e] * gw1[4 * r4 + e]; } } \
                lg0[jj] = flogsigmoid(a0) * (1.0f / 16.0f); lg1[jj] = flogsigmoid(a1) * (1.0f / 16.0f); \
                kk0[jj] = lo2f(rk[jj]); kk1[jj] = hi2f(rk[jj]); } \
        } \
        _Pragma("unroll") for (int jj = 1; jj < NTK; ++jj) { lg0[jj] += lg0[jj - 1]; lg1[jj] += lg1[jj - 1]; } \
        if (TYPE == 0) { const float o0 = __shfl_xor(lg0[NTK - 1], 32), o1 = __shfl_xor(lg1[NTK - 1], 32); \
            if (th) { _Pragma("unroll") for (int jj = 0; jj < NTK; ++jj) { lg0[jj] += o0; lg1[jj] += o1; } } \
            else { vtot_[g * 128 + 2 * ck] = lg0[NTK - 1] + o0; vtot_[g * 128 + 2 * ck + 1] = lg1[NTK - 1] + o1; } } \
        else { vtot_[g * 128 + 2 * ck] = lg0[NTK - 1]; vtot_[g * 128 + 2 * ck + 1] = lg1[NTK - 1]; } } while (0)
#define P1_A2(par) do { const LAS float* vtot_ = P1_TOT(par); \
        float base0 = 0.f, base1 = 0.f, ref0 = 0.f, ref1 = 0.f, end0 = 0.f, end1 = 0.f; \
        _Pragma("unroll") for (int gg = 0; gg < 8; ++gg) { const float t0 = vtot_[gg * 128 + 2 * ck], t1 = vtot_[gg * 128 + 2 * ck + 1]; \
            if (gg < g) { base0 += t0; base1 += t1; } if (gg < 4) { ref0 += t0; ref1 += t1; } end0 += t0; end1 += t1; } \
        float kt0[8], kt1[8]; \
        _Pragma("unroll") for (int jj = 0; jj < NTK; ++jj) { const float G0 = base0 + lg0[jj], G1 = base1 + lg1[jj]; \
            kt0[jj] = kk0[jj] * fexp(fminf(ref0 - G0, 80.f)); kt1[jj] = kk1[jj] * fexp(fminf(ref1 - G1, 80.f)); } \
        if (TYPE == 0) { u32x2v t2; \
            t2.x = cvtpk(kt0[0], kt0[1]); t2.y = cvtpk(kt0[2], kt0[3]); *(LAS u32x2v*)(lds + P1_KTT(par) + sw64(2 * ck, 16 * g + 8 * th)) = t2; \
            t2.x = cvtpk(kt1[0], kt1[1]); t2.y = cvtpk(kt1[2], kt1[3]); *(LAS u32x2v*)(lds + P1_KTT(par) + sw64(2 * ck + 1, 16 * g + 8 * th)) = t2; \
        } else { u32x4v t; \
            t.x = cvtpk(kt0[0], kt0[1]); t.y = cvtpk(kt0[2], kt0[3]); t.z = cvtpk(kt0[4], kt0[5]); t.w = cvtpk(kt0[6], kt0[7]); *(LAS u32x4v*)(lds + P1_KTT(par) + (2 * ck) * 128 + ((g ^ (ck & 7)) << 4)) = t; \
            t.x = cvtpk(kt1[0], kt1[1]); t.y = cvtpk(kt1[2], kt1[3]); t.z = cvtpk(kt1[4], kt1[5]); t.w = cvtpk(kt1[6], kt1[7]); *(LAS u32x4v*)(lds + P1_KTT(par) + (2 * ck + 1) * 128 + ((g ^ (ck & 7)) << 4)) = t; } \
        if (g == 0 && th == 0) { LAS float* vpre_ = P1_PRE(par); LAS float* vpost_ = P1_POST(par); \
            vpre_[2 * ck] = fexp(ref0); vpre_[2 * ck + 1] = fexp(ref1); vpost_[2 * ck] = fexp(end0 - ref0); vpost_[2 * ck + 1] = fexp(end1 - ref1); gsum0 += end0; gsum1 += end1; } \
        { u32x4v t; \
          t.x = (rv[par][0] & 0xffffu) | (rv[par][1] << 16); t.y = (rv[par][2] & 0xffffu) | (rv[par][3] << 16); t.z = (rv[par][4] & 0xffffu) | (rv[par][5] << 16); t.w = (rv[par][6] & 0xffffu) | (rv[par][7] << 16); \
          *(LAS u32x4v*)(lds + P1_VT(par) + (2 * cp) * 128 + ((g ^ (cp & 7)) << 4)) = t; \
          t.x = (rv[par][0] >> 16) | (rv[par][1] & 0xffff0000u); t.y = (rv[par][2] >> 16) | (rv[par][3] & 0xffff0000u); t.z = (rv[par][4] >> 16) | (rv[par][5] & 0xffff0000u); t.w = (rv[par][6] >> 16) | (rv[par][7] & 0xffff0000u); \
          *(LAS u32x4v*)(lds + P1_VT(par) + (2 * cp + 1) * 128 + ((g ^ (cp & 7)) << 4)) = t; } } while (0)
#define P1_E(par) do { const LAS float* vpre_ = P1_PRE(par); const LAS float* vpost_ = P1_POST(par); \
        _Pragma("unroll") for (int dt = 0; dt < NDT; ++dt) { const f32x4 p4 = *(const LAS f32x4*)(vpre_ + 16 * dt + 4 * qd); S[dt] = S[dt] * p4; } \
        _Pragma("unroll") for (int dt = 0; dt < NDT; ++dt) { \
            _Pragma("unroll") for (int ks = 0; ks < 2; ++ks) S[dt] = MFMA16(frag64(lds + P1_KTT(par), 16 * dt + r, ks, qd), frag64(lds + P1_VT(par), 16 * w + r, ks, qd), S[dt]); \
            const f32x4 q4 = *(const LAS f32x4*)(vpost_ + 16 * dt + 4 * qd); S[dt] = S[dt] * q4; } } while (0)
    P1_LOAD(0, 0);
    P1_A1(0);
    P1_LOAD(1, 1);
    __syncthreads();
    P1_A2(0);
    P1_A1(1);
    P1_LOAD(2, 0);
    __syncthreads();
    for (int c = 0; c < NCH; c += 2) {
        P1_E(0);
        P1_A2(1);
        if (c + 2 < NCH) P1_A1(0);
        if (c + 3 < NCH) P1_LOAD(c + 3, 1);
        __syncthreads();
        P1_E(1);
        if (c + 2 < NCH) P1_A2(0);
        if (c + 3 < NCH) P1_A1(1);
        if (c + 4 < NCH) P1_LOAD(c + 4, 0);
        __syncthreads();
    }
    {
        bf16* sb = stbase + (size_t)idx * (DK * 128);
#pragma unroll
        for (int dt = 0; dt < NDT; ++dt) st_wt(sb + ((size_t)(w * NDT + dt) * 64 + lane) * 4, pack4(S[dt]));
        if (g == 0 && th == 0) { st_wt_f(dsbase + (size_t)idx * DK + 2 * ck, fexp(gsum0)); st_wt_f(dsbase + (size_t)idx * DK + 2 * ck + 1, fexp(gsum1)); }
        publish_item(flag_ptr(P, (TYPE == 0) ? FLAG_GLA : FLAG_HG, idx), (unsigned)l + 1u);
    }
    __syncthreads();
#undef P1_KTT
#undef P1_VT
#undef P1_TOT
#undef P1_PRE
#undef P1_POST
#undef P1_LOAD
#undef P1_A1
#undef P1_A2
#undef P1_E
}

template <bool OUT, bool DRY = false>
__device__ __forceinline__ void ml_item(KP P, int l, int b, int h, int s, LAS unsigned char* lds) {
    if (!OUT && s == NSEG - 1) return;
    constexpr int PQ = 272;
    const int tid = opaque_tid(), lane = tid & 63, w = __builtin_amdgcn_readfirstlane(tid >> 6), r = lane & 15, qd = lane >> 4;
    const int cp = lane, g = w;
    bf16* proj = (bf16*)(P->ws + WS_PROJ); const float* gts = (const float*)(P->ws + WS_GATES);
    LAS float* vg = (LAS float*)(lds + L_VEC + V_TOT);
    LAS float* vemr = (LAS float*)(lds + L_VEC + V_MISC);
    LAS float* vden = vemr + 64;
    const int idx = (b * 4 + h) * NSEG + s;
    bf16* stbase = (bf16*)((unsigned char*)P->out + DO_STATE) + ST_ML;
    float* dsbase = (float*)(P->ws + WS_MISC) + DS_ML;
    float wq[4][2], wk[4][2], bq[2], bk[2];
#pragma unroll
    for (int c2 = 0; c2 < 2; ++c2) { const int ch = h * 128 + 2 * cp + c2;
#pragma unroll
        for (int kk = 0; kk < 4; ++kk) { wq[kk][c2] = P->ml_conv_w[((size_t)l * 4 + kk) * 1024 + ch]; wk[kk][c2] = P->ml_conv_w[((size_t)l * 4 + kk) * 1024 + 512 + ch]; }
        bq[c2] = P->ml_conv_b[l * 1024 + ch]; bk[c2] = P->ml_conv_b[l * 1024 + 512 + ch]; }
    const float ib = P->ml_i_b[l * 4 + h], fb = P->ml_f_b[l * 4 + h];
    unsigned rq[11], rk[11], rv[8]; float gpre = 0.f;
#define ML_LOAD(cc) do { const size_t rw_ = (size_t)b * SEQ + (size_t)s * SEGL + (size_t)(cc) * CH + 8 * g; const int ts_ = s * SEGL + (cc) * CH + 8 * g; \
        _Pragma("unroll") for (int jj = 0; jj < 11; ++jj) { const bool ok = (ts_ + jj - 3) >= 0; const bf16* pr = proj + (rw_ + jj - 3) * PP; \
            rk[jj] = ok ? *(const unsigned*)(pr + BKc(h) + 2 * cp) : 0u; rq[jj] = (ok && OUT) ? *(const unsigned*)(pr + BQc(h) + 2 * cp) : 0u; } \
        _Pragma("unroll") for (int jj = 0; jj < 8; ++jj) rv[jj] = *(const unsigned*)(proj + (rw_ + jj) * PP + BVc(h) + 2 * cp); \
        if (lane < 16) gpre = gts[(rw_ + (lane >> 1)) * 32 + ((lane & 1) ? G_BF : G_BI) + h]; } while (0)
    ML_LOAD(0);
    f32x4 S[8], Sx = (f32x4){0.f, 0.f, 0.f, 0.f};
#pragma unroll
    for (int dt = 0; dt < 8; ++dt) S[dt] = (f32x4){0.f, 0.f, 0.f, 0.f};
    float m = 0.f, bsum = 0.f;
    if (OUT) {
        wait_predecessors(flag_ptr(P, FLAG_ML, idx - s), s, (unsigned)l + 1u);
        LAS float* vds = (LAS float*)(lds + L_QT);
        for (int i = tid; i < s * 4; i += 512) vds[i] = dsbase[(size_t)(idx - s) * 4 + i];
        __syncthreads();
        for (int sp0 = 0; sp0 < s; sp0 += 4) {
            u32x2v raw[4][9];
#pragma unroll
            for (int u = 0; u < 4; ++u) { const int sp = (sp0 + u < s) ? sp0 + u : s - 1; const bf16* sb = stbase + (size_t)(idx - s + sp) * 18432;
#pragma unroll
                for (int dt = 0; dt < 9; ++dt) raw[u][dt] = *(const u32x2v*)(sb + ((size_t)(w * 9 + dt) * 64 + lane) * 4); }
#pragma unroll
            for (int u = 0; u < 4; ++u) if (sp0 + u < s) {
                const float ml_ = vds[(sp0 + u) * 4], bs = vds[(sp0 + u) * 4 + 1];
                const float mn = fmaxf(bs + m, ml_), f1 = fexp(bs + m - mn), f2 = fexp(ml_ - mn); m = mn;
#pragma unroll
                for (int dt = 0; dt < 9; ++dt) { const f32x4 ds = (f32x4){lo2f(raw[u][dt].x), hi2f(raw[u][dt].x), lo2f(raw[u][dt].y), hi2f(raw[u][dt].y)};
                    if (dt < 8) S[dt] = S[dt] * f1 + ds * f2; else Sx = Sx * f1 + ds * f2; } }
        }
        __syncthreads();
    }
    if (tid < 128) { const int rr = tid >> 3, ck = tid & 7; const unsigned one2 = (rr == 0) ? 0x3f803f80u : 0u; u32x4v t; t.x = one2; t.y = one2; t.z = one2; t.w = one2; *(LAS u32x4v*)(lds + L_VT + (128 + rr) * 128 + 16 * ck) = t; }
    const int ei = tid >> 3, ecc = tid & 7;
    float nw[16];
#pragma unroll
    for (int k = 0; k < 16; ++k) nw[k] = OUT ? P->ml_norm_w[l * 512 + h * 128 + 16 * ecc + k] : 0.f;

    for (int c = 0; c < NCH; ++c) {
        const size_t rowc = (size_t)b * SEQ + (size_t)s * SEGL + (size_t)c * CH;
        float ig[8], bl[8];
        const float gval = (lane & 1) ? flogsigmoid(gpre + fb) : gpre + ib;
#pragma unroll
        for (int jj = 0; jj < 8; ++jj) { ig[jj] = __int_as_float(__builtin_amdgcn_readlane(__float_as_int(gval), 2 * jj)); bl[jj] = __int_as_float(__builtin_amdgcn_readlane(__float_as_int(gval), 2 * jj + 1)); }
#pragma unroll
        for (int jj = 1; jj < 8; ++jj) bl[jj] += bl[jj - 1];
        float lpm[8];
        lpm[0] = ig[0] - bl[0];
#pragma unroll
        for (int jj = 1; jj < 8; ++jj) lpm[jj] = fmaxf(lpm[jj - 1], ig[jj] - bl[jj]);
        if (lane == 0) { vg[g] = bl[7]; vg[8 + g] = lpm[7]; }
        __syncthreads();
        float base = 0.f, cmprev = -1e30f, blast = 0.f, M = m;
#pragma unroll
        for (int gg = 0; gg < 8; ++gg) { const float t = vg[gg], lm = vg[8 + gg]; const float ag = lm - blast;
            if (gg < g) cmprev = fmaxf(cmprev, ag); M = fmaxf(M, ag); if (gg < g) base += t; blast += t; }
        float kt0[8], kt1[8];
#pragma unroll
        for (int jj = 0; jj < 8; ++jj) {
            const float bj = base + bl[jj]; const float cmj = fmaxf(cmprev, lpm[jj] - base); const float mu = fmaxf(cmj, m);
            const float ek = fexp(ig[jj] - bj - M), eq = fexp(M - mu);
            float yk0 = bk[0], yk1 = bk[1], yq0 = bq[0], yq1 = bq[1];
#pragma unroll
            for (int kk = 0; kk < 4; ++kk) { yk0 += wk[kk][0] * lo2f(rk[jj + kk]); yk1 += wk[kk][1] * hi2f(rk[jj + kk]); yq0 += wq[kk][0] * lo2f(rq[jj + kk]); yq1 += wq[kk][1] * hi2f(rq[jj + kk]); }
            kt0[jj] = fsilu(yk0) * 0.08838834764831845f * ek; kt1[jj] = fsilu(yk1) * 0.08838834764831845f * ek;
            if (OUT) { *(LAS unsigned*)(lds + L_QT + (8 * g + jj) * PQ + 4 * cp) = cvtpk(fsilu(yq0) * eq, fsilu(yq1) * eq);
                       *(LAS unsigned*)(lds + L_KT + (8 * g + jj) * PQ + 4 * cp) = cvtpk(kt0[jj], kt1[jj]);
                       if (lane == 0) vemr[8 * g + jj] = fexp(-bj - mu); } }
        { u32x4v t;
          t.x = cvtpk(kt0[0], kt0[1]); t.y = cvtpk(kt0[2], kt0[3]); t.z = cvtpk(kt0[4], kt0[5]); t.w = cvtpk(kt0[6], kt0[7]); *(LAS u32x4v*)(lds + L_KTT + (2 * cp) * 128 + ((g ^ (cp & 7)) << 4)) = t;
          t.x = cvtpk(kt1[0], kt1[1]); t.y = cvtpk(kt1[2], kt1[3]); t.z = cvtpk(kt1[4], kt1[5]); t.w = cvtpk(kt1[6], kt1[7]); *(LAS u32x4v*)(lds + L_KTT + (2 * cp + 1) * 128 + ((g ^ (cp & 7)) << 4)) = t;
          t.x = (rv[0] & 0xffffu) | (rv[1] << 16); t.y = (rv[2] & 0xffffu) | (rv[3] << 16); t.z = (rv[4] & 0xffffu) | (rv[5] << 16); t.w = (rv[6] & 0xffffu) | (rv[7] << 16);
          *(LAS u32x4v*)(lds + L_VT + (2 * cp) * 128 + ((g ^ (cp & 7)) << 4)) = t;
          t.x = (rv[0] >> 16) | (rv[1] & 0xffff0000u); t.y = (rv[2] >> 16) | (rv[3] & 0xffff0000u); t.z = (rv[4] >> 16) | (rv[5] & 0xffff0000u); t.w = (rv[6] >> 16) | (rv[7] & 0xffff0000u);
          *(LAS u32x4v*)(lds + L_VT + (2 * cp + 1) * 128 + ((g ^ (cp & 7)) << 4)) = t; }
        const float pre = fexp(m - M);
        m = blast + M; bsum += blast;
        if (c + 1 < NCH) ML_LOAD(c + 1);
        __syncthreads();
        bf16* zp = proj + (rowc + ei) * PP + ZB + h * 128 + 16 * ecc; const bf16* gp = proj + (rowc + ei) * PP + BOc(h) + 16 * ecc;
        u32x4v za = (u32x4v){0u, 0u, 0u, 0u}, zb = za, ga = za, gb_ = za;
        if (OUT) { za = *(const u32x4v*)zp; zb = *(const u32x4v*)(zp + 8); ga = *(const u32x4v*)gp; gb_ = *(const u32x4v*)(gp + 8); }
#pragma unroll
        for (int dt = 0; dt < 8; ++dt) { S[dt] = S[dt] * pre; if (OUT) *(LAS u32x2v*)(lds + L_ST + (16 * w + r) * PQ + (16 * dt + 4 * qd) * 2) = pack4(S[dt]); }
        Sx = Sx * pre; if (OUT) *(LAS u32x2v*)(lds + L_ST + (128 + r) * PQ + (16 * w + 4 * qd) * 2) = pack4(Sx);
        if (OUT) {
            const int it = w & 3;
#pragma unroll
            for (int j2 = 0; j2 < 2; ++j2) { const int jt = 2 * (w >> 2) + j2; f32x4 acc = (f32x4){0.f, 0.f, 0.f, 0.f};
                if (jt <= it) {
#pragma unroll
                    for (int ks = 0; ks < 4; ++ks) acc = MFMA16(frag(lds + L_KT, 16 * jt + r, PQ, ks, qd), frag(lds + L_QT, 16 * it + r, PQ, ks, qd), acc);
                    if (jt == it) {
#pragma unroll
                        for (int rg = 0; rg < 4; ++rg) if (4 * qd + rg > r) acc[rg] = 0.f; }
                }
                *(LAS u32x2v*)(lds + L_PM + sw64(16 * it + r, (16 * jt + 4 * qd) * 2)) = pack4(acc); }
            __syncthreads();
        }
        f32x4 o[4], ox = (f32x4){0.f, 0.f, 0.f, 0.f};
        if (OUT) {
#pragma unroll
            for (int it = 0; it < 4; ++it) { o[it] = (f32x4){0.f, 0.f, 0.f, 0.f};
#pragma unroll
                for (int ks = 0; ks < 2; ++ks) if (ks == 0 || it >= 2) o[it] = MFMA16(frag64(lds + L_VT, 16 * w + r, ks, qd), frag64(lds + L_PM, 16 * it + r, ks, qd), o[it]);
#pragma unroll
                for (int ks = 0; ks < 4; ++ks) o[it] = MFMA16(frag(lds + L_ST, 16 * w + r, PQ, ks, qd), frag(lds + L_QT, 16 * it + r, PQ, ks, qd), o[it]); }
            const int itx = w & 3;
#pragma unroll
            for (int ks = 0; ks < 2; ++ks) ox = MFMA16(frag64(lds + L_VT, 128 + r, ks, qd), frag64(lds + L_PM, 16 * itx + r, ks, qd), ox);
#pragma unroll
            for (int ks = 0; ks < 4; ++ks) ox = MFMA16(frag(lds + L_ST, 128 + r, PQ, ks, qd), frag(lds + L_QT, 16 * itx + r, PQ, ks, qd), ox);
            if (w < 4 && qd == 0) vden[16 * itx + r] = ox[0];
        }
#pragma unroll
        for (int dt = 0; dt < 8; ++dt)
#pragma unroll
            for (int ks = 0; ks < 2; ++ks) S[dt] = MFMA16(frag64(lds + L_KTT, 16 * dt + r, ks, qd), frag64(lds + L_VT, 16 * w + r, ks, qd), S[dt]);
#pragma unroll
        for (int ks = 0; ks < 2; ++ks) Sx = MFMA16(frag64(lds + L_KTT, 16 * w + r, ks, qd), frag64(lds + L_VT, 128 + r, ks, qd), Sx);
        if (OUT) {
#pragma unroll
            for (int it = 0; it < 4; ++it) *(LAS u32x2v*)(lds + L_KT + (16 * it + r) * 272 + (16 * w + 4 * qd) * 2) = pack4(o[it]);
            __syncthreads();
            const u32x4v oa = *(const LAS u32x4v*)(lds + L_KT + ei * 272 + ecc * 32), ob = *(const LAS u32x4v*)(lds + L_KT + ei * 272 + ecc * 32 + 16);
            float ov[16] = {lo2f(oa.x), hi2f(oa.x), lo2f(oa.y), hi2f(oa.y), lo2f(oa.z), hi2f(oa.z), lo2f(oa.w), hi2f(oa.w), lo2f(ob.x), hi2f(ob.x), lo2f(ob.y), hi2f(ob.y), lo2f(ob.z), hi2f(ob.z), lo2f(ob.w), hi2f(ob.w)};
            const float dinv = frcp(fmaxf(fabsf(vden[ei]), vemr[ei]));
            const float zv[16] = {lo2f(za.x), hi2f(za.x), lo2f(za.y), hi2f(za.y), lo2f(za.z), hi2f(za.z), lo2f(za.w), hi2f(za.w), lo2f(zb.x), hi2f(zb.x), lo2f(zb.y), hi2f(zb.y), lo2f(zb.z), hi2f(zb.z), lo2f(zb.w), hi2f(zb.w)};
            const float gv[16] = {lo2f(ga.x), hi2f(ga.x), lo2f(ga.y), hi2f(ga.y), lo2f(ga.z), hi2f(ga.z), lo2f(ga.w), hi2f(ga.w), lo2f(gb_.x), hi2f(gb_.x), lo2f(gb_.y), hi2f(gb_.y), lo2f(gb_.z), hi2f(gb_.z), lo2f(gb_.w), hi2f(gb_.w)};
            float ss = 0.f;
#pragma unroll
            for (int k = 0; k < 16; ++k) { ov[k] = ov[k] * dinv * fsigmoid(gv[k]); ss += ov[k] * ov[k]; }
            ss += __shfl_xor(ss, 1); ss += __shfl_xor(ss, 2); ss += __shfl_xor(ss, 4);
            const float rs = frsq(ss * (1.0f / 128.0f) + EPS);
            float y[16];
#pragma unroll
            for (int k = 0; k < 16; ++k) y[k] = ov[k] * rs * nw[k] * fsilu(zv[k]);
            u32x4v ya, yb; ya.x = cvtpk(y[0], y[1]); ya.y = cvtpk(y[2], y[3]); ya.z = cvtpk(y[4], y[5]); ya.w = cvtpk(y[6], y[7]); yb.x = cvtpk(y[8], y[9]); yb.y = cvtpk(y[10], y[11]); yb.z = cvtpk(y[12], y[13]); yb.w = cvtpk(y[14], y[15]);
            if (DRY) { asm volatile("" :: "v"(ya.x), "v"(ya.y), "v"(ya.z), "v"(ya.w), "v"(yb.x), "v"(yb.y), "v"(yb.z), "v"(yb.w)); } else { *(u32x4v*)zp = ya; *(u32x4v*)(zp + 8) = yb; }
        }
    }
    if (!OUT) {
        bf16* sb = stbase + (size_t)idx * 18432;
#pragma unroll
        for (int dt = 0; dt < 8; ++dt) st_wt(sb + ((size_t)(w * 9 + dt) * 64 + lane) * 4, pack4(S[dt]));
        st_wt(sb + ((size_t)(w * 9 + 8) * 64 + lane) * 4, pack4(Sx));
        if (tid == 0) { st_wt_f(dsbase + (size_t)idx * 4, m); st_wt_f(dsbase + (size_t)idx * 4 + 1, bsum); }
        publish_item(flag_ptr(P, FLAG_ML, idx), (unsigned)l + 1u);
    }
    __syncthreads();
#undef ML_LOAD
}

template <bool OUT, bool DRY = false>
__device__ __forceinline__ void ssd_item(KP P, int l, int b, int gq, int s, LAS unsigned char* lds) {
    constexpr int PQ = 272;
    const int tid = opaque_tid(), lane = tid & 63, w = __builtin_amdgcn_readfirstlane(tid >> 6);
    const int g = w, hsub = lane >> 5;
    bf16* proj = (bf16*)(P->ws + WS_PROJ); const float* gts = (const float*)(P->ws + WS_GATES);
    LAS float* vg = (LAS float*)(lds + L_VEC + V_TOT);
    LAS float* vaend = vg + 32;
    LAS float* vacs = (LAS float*)(lds + L_VEC + 256);
    LAS float* veacs = vacs + 256;
    LAS float* vdti = veacs + 256;
    LAS float* vcw = (LAS float*)(lds + L_VEC + 3328);
    const int idx = (b * 2 + gq) * NSEG + s;
    bf16* stbase = (bf16*)((unsigned char*)P->out + DO_STATE) + ST_SSD;
    float* dsbase = (float*)(P->ws + WS_MISC) + DS_SSD;
    { const int cp = lane; (void)cp; const int ch = tid;
      const int src = (ch < 128) ? 512 + gq * 128 + ch : (ch < 256) ? 768 + gq * 128 + (ch - 128) : gq * 256 + (ch - 256);
#pragma unroll
      for (int kk = 0; kk < 4; ++kk) vcw[ch * 5 + kk] = P->ssd_conv_w[((size_t)l * 4 + kk) * 1024 + src];
      vcw[ch * 5 + 4] = P->ssd_conv_b[l * 1024 + src]; }
    const int qd0 = lane >> 4, r0 = lane & 15; (void)qd0; (void)r0;
    float dtb[2], An[2], iAn[2];
#pragma unroll
    for (int k = 0; k < 2; ++k) { const int hh = gq * 4 + 2 * k + hsub; dtb[k] = P->ssd_dt_bias[l * 8 + hh]; An[k] = -fexp(P->ssd_A_log[l * 8 + hh]); iAn[k] = 1.0f / An[k]; }
    const float dtb_l = P->ssd_dt_bias[l * 8 + gq * 4 + (lane & 3)], An_l = -fexp(P->ssd_A_log[l * 8 + gq * 4 + (lane & 3)]);
    const int hw0 = (w >> 2), hw1 = 2 + (w >> 2);
    const float Dh[2][2] = {{P->ssd_D[l * 8 + gq * 4 + 0], P->ssd_D[l * 8 + gq * 4 + 1]}, {P->ssd_D[l * 8 + gq * 4 + 2], P->ssd_D[l * 8 + gq * 4 + 3]}};
    f32x4 S[2][8];
#pragma unroll
    for (int R = 0; R < 2; ++R)
#pragma unroll
        for (int dt = 0; dt < 8; ++dt) S[R][dt] = (f32x4){0.f, 0.f, 0.f, 0.f};
    if (OUT) {
        wait_predecessors(flag_ptr(P, FLAG_SSD, idx - s), s, (unsigned)l + 1u);
        LAS float* vds = (LAS float*)(lds + L_QT);
        for (int i = tid; i < s * 4; i += 512) vds[i] = dsbase[(size_t)(idx - s) * 4 + i];
        __syncthreads();
        for (int sp0 = 0; sp0 < s; sp0 += 2) {
            u32x2v raw[2][16];
#pragma unroll
            for (int u = 0; u < 2; ++u) { const int sp = (sp0 + u < s) ? sp0 + u : s - 1; const bf16* sb = stbase + (size_t)(idx - s + sp) * 32768;
#pragma unroll
                for (int t = 0; t < 16; ++t) raw[u][t] = *(const u32x2v*)(sb + ((size_t)(w * 16 + t) * 64 + lane) * 4); }
#pragma unroll
            for (int u = 0; u < 2; ++u) if (sp0 + u < s) {
                const float f0 = fexp(vds[(sp0 + u) * 4 + hw0]), f1 = fexp(vds[(sp0 + u) * 4 + hw1]);
#pragma unroll
                for (int R = 0; R < 2; ++R)
#pragma unroll
                    for (int dt = 0; dt < 8; ++dt) { const u32x2v rw = raw[u][R * 8 + dt];
                        const f32x4 ds = (f32x4){lo2f(rw.x), hi2f(rw.x), lo2f(rw.y), hi2f(rw.y)}; S[R][dt] = S[R][dt] * (R == 0 ? f0 : f1) + ds; } }
        }
        __syncthreads();
    }
    float asum[2] = {0.f, 0.f};

    unsigned rC[11], rB[11], rx[2][11]; float gdt = 0.f;
    const bf16* halo = (const bf16*)(P->ws + WS_HALO);
    LAS unsigned* hxch = (LAS unsigned*)(lds + L_ST);
#define SSD_LOAD(cc) do { const int cl_ = opq(lane); const size_t rw_ = (size_t)b * SEQ + (size_t)s * SEGL + (size_t)(cc) * CH + 8 * g; \
        if (OUT) { \
            _Pragma("unroll") for (int jj = 0; jj < 8; ++jj) { const bf16* pr = proj + (rw_ + jj) * PP; \
                rB[jj] = *(const unsigned*)(pr + DBc(gq) + 2 * cl_); rC[jj] = *(const unsigned*)(pr + DCc(gq) + 2 * cl_); \
                rx[0][jj] = *(const unsigned*)(pr + DXc(gq) + 2 * cl_); rx[1][jj] = *(const unsigned*)(pr + DXc(gq) + 128 + 2 * cl_); } \
        } else { \
            _Pragma("unroll") for (int jj = 0; jj < 11; ++jj) { \
                if (jj < 3 && g == 0) {       \
                    if ((cc) == 0) { const bool ok = s > 0; const bf16* hr = halo + ((size_t)((b * NSEG + s - 1) * 3 + jj)) * 1024; \
                        rB[jj] = ok ? *(const unsigned*)(hr + (DBc(gq) - DSSD) + 2 * cl_) : 0u; rC[jj] = ok ? *(const unsigned*)(hr + (DCc(gq) - DSSD) + 2 * cl_) : 0u; \
                        rx[0][jj] = ok ? *(const unsigned*)(hr + (DXc(gq) - DSSD) + 2 * cl_) : 0u; rx[1][jj] = ok ? *(const unsigned*)(hr + (DXc(gq) - DSSD) + 128 + 2 * cl_) : 0u; } \
                } else { const bf16* pr = proj + (rw_ + jj - 3) * PP; \
                    rB[jj] = *(const unsigned*)(pr + DBc(gq) + 2 * cl_); rC[jj] = *(const unsigned*)(pr + DCc(gq) + 2 * cl_); \
                    rx[0][jj] = *(const unsigned*)(pr + DXc(gq) + 2 * cl_); rx[1][jj] = *(const unsigned*)(pr + DXc(gq) + 128 + 2 * cl_); } } \
        } \
        if (cl_ < 32) gdt = gts[(rw_ + (cl_ >> 2)) * 32 + G_DT + gq * 4 + (cl_ & 3)]; } while (0)
    SSD_LOAD(0);
    for (int c = 0; c < NCH; ++c) {
        const size_t rowc = (size_t)b * SEQ + (size_t)s * SEGL + (size_t)c * CH;
        const int cp = opq(lane);
        LAS float* vsl = vacs + (cp >> 5) * 64 + 8 * g;
        const float a_l = fsoftplus(gdt + dtb_l) * An_l;
        float al[2][8];
#pragma unroll
        for (int k = 0; k < 2; ++k) {
#pragma unroll
            for (int jj = 0; jj < 8; ++jj) { const float pa = __int_as_float(__builtin_amdgcn_readlane(__float_as_int(a_l), 4 * jj + 2 * k)), pb = __int_as_float(__builtin_amdgcn_readlane(__float_as_int(a_l), 4 * jj + 2 * k + 1));
                al[k][jj] = hsub ? pb : pa; }
#pragma unroll
            for (int jj = 1; jj < 8; ++jj) al[k][jj] += al[k][jj - 1];
            if ((lane & 31) == 0) vg[(2 * k + hsub) * 8 + g] = al[k][7];
        }
        __syncthreads();
        float base[2] = {0.f, 0.f}, aend[2] = {0.f, 0.f};
#pragma unroll
        for (int k = 0; k < 2; ++k)
#pragma unroll
            for (int gg = 0; gg < 8; ++gg) { const float t = vg[(2 * k + hsub) * 8 + gg]; if (gg < g) base[k] += t; aend[k] += t; }
#define SSD_PUT_T(region, src) do { u32x4v t_; \
          t_.x = (src[0] & 0xffffu) | (src[1] << 16); t_.y = (src[2] & 0xffffu) | (src[3] << 16); t_.z = (src[4] & 0xffffu) | (src[5] << 16); t_.w = (src[6] & 0xffffu) | (src[7] << 16); \
          *(LAS u32x4v*)(lds + (region) + (2 * cp) * 128 + ((g ^ (cp & 7)) << 4)) = t_; \
          t_.x = (src[0] >> 16) | (src[1] & 0xffff0000u); t_.y = (src[2] >> 16) | (src[3] & 0xffff0000u); t_.z = (src[4] >> 16) | (src[5] & 0xffff0000u); t_.w = (src[6] >> 16) | (src[7] & 0xffff0000u); \
          *(LAS u32x4v*)(lds + (region) + (2 * cp + 1) * 128 + ((g ^ (cp & 7)) << 4)) = t_; } while (0)
        unsigned x1a[8], x1s[8];
        unsigned Bp[8], Cp[8], x0p[8];
        if (OUT) {
#pragma unroll
            for (int jj = 0; jj < 8; ++jj) { *(LAS unsigned*)(lds + L_KT + (8 * g + jj) * PQ + 4 * cp) = rB[jj]; *(LAS unsigned*)(lds + L_QT + (8 * g + jj) * PQ + 4 * cp) = rC[jj]; }
            SSD_PUT_T(L_KTT, rB);
            { unsigned x0s[8];
#pragma unroll
              for (int jj = 0; jj < 8; ++jj) { const float a0 = base[0] + al[0][jj]; const float dtj = (al[0][jj] - (jj ? al[0][jj - 1] : 0.f)) * iAn[0], e0 = fexp(aend[0] - a0);
                  x0s[jj] = cvtpk(lo2f(rx[0][jj]) * e0, hi2f(rx[0][jj]) * e0);
                  if ((cp & 31) == 0) { vsl[jj] = a0; vsl[256 + jj] = fexp(a0); vsl[512 + jj] = frcp(dtj); } }
              SSD_PUT_T(L_VVT, x0s); SSD_PUT_T(L_VT, rx[0]); }
#pragma unroll
            for (int jj = 0; jj < 8; ++jj) { const float a1 = base[1] + al[1][jj]; const float dtj = (al[1][jj] - (jj ? al[1][jj - 1] : 0.f)) * iAn[1];
                x1a[jj] = rx[1][jj];
                if ((cp & 31) == 0) { vsl[128 + jj] = a1; vsl[128 + 256 + jj] = fexp(a1); vsl[128 + 512 + jj] = frcp(dtj); } }
        } else {
            LAS unsigned* hw_ = hxch + (c & 1) * 768; LAS unsigned* hr_ = hxch + ((c + 1) & 1) * 768;
            if (g == 7) {
#pragma unroll
                for (int jj = 0; jj < 3; ++jj) { hw_[(0 * 3 + jj) * 64 + cp] = rB[8 + jj]; hw_[(1 * 3 + jj) * 64 + cp] = rC[8 + jj]; hw_[(2 * 3 + jj) * 64 + cp] = rx[0][8 + jj]; hw_[(3 * 3 + jj) * 64 + cp] = rx[1][8 + jj]; } }
            if (g == 0 && c > 0) {
#pragma unroll
                for (int jj = 0; jj < 3; ++jj) { rB[jj] = hr_[(0 * 3 + jj) * 64 + cp]; rC[jj] = hr_[(1 * 3 + jj) * 64 + cp]; rx[0][jj] = hr_[(2 * 3 + jj) * 64 + cp]; rx[1][jj] = hr_[(3 * 3 + jj) * 64 + cp]; } }
#define SSD_TAPS(chan) float w0_[5], w1_[5]; _Pragma("unroll") for (int kk = 0; kk < 5; ++kk) { w0_[kk] = vcw[(chan) * 5 + kk]; w1_[kk] = vcw[((chan) + 1) * 5 + kk]; }
#define SSD_CONV(raw, jj, y0, y1) float y0 = w0_[4], y1 = w1_[4]; _Pragma("unroll") for (int kk = 0; kk < 4; ++kk) { y0 += w0_[kk] * lo2f(raw[jj + kk]); y1 += w1_[kk] * hi2f(raw[jj + kk]); }
            { SSD_TAPS(2 * cp)
#pragma unroll
              for (int jj = 0; jj < 8; ++jj) { SSD_CONV(rB, jj, y0, y1) Bp[jj] = cvtpk(fsilu(y0), fsilu(y1)); }
              SSD_PUT_T(L_KTT, Bp); }
            { SSD_TAPS(128 + 2 * cp)
#pragma unroll
              for (int jj = 0; jj < 8; ++jj) { SSD_CONV(rC, jj, y0, y1) Cp[jj] = cvtpk(fsilu(y0), fsilu(y1)); } }
            { SSD_TAPS(256 + 2 * cp)
              unsigned x0s[8];
#pragma unroll
              for (int jj = 0; jj < 8; ++jj) { SSD_CONV(rx[0], jj, y0, y1) const float a0 = base[0] + al[0][jj]; const float dtj = (al[0][jj] - (jj ? al[0][jj - 1] : 0.f)) * iAn[0], e0 = fexp(aend[0] - a0);
                  x0p[jj] = cvtpk(fsilu(y0) * dtj, fsilu(y1) * dtj); x0s[jj] = cvtpk(lo2f(x0p[jj]) * e0, hi2f(x0p[jj]) * e0); }
              SSD_PUT_T(L_VVT, x0s); }
            { SSD_TAPS(256 + 128 + 2 * cp)
#pragma unroll
              for (int jj = 0; jj < 8; ++jj) { SSD_CONV(rx[1], jj, y0, y1) const float a1 = base[1] + al[1][jj]; const float dtj = (al[1][jj] - (jj ? al[1][jj - 1] : 0.f)) * iAn[1], e1 = fexp(aend[1] - a1);
                  x1a[jj] = cvtpk(fsilu(y0) * dtj, fsilu(y1) * dtj); x1s[jj] = cvtpk(lo2f(x1a[jj]) * e1, hi2f(x1a[jj]) * e1); } }
#undef SSD_TAPS
#undef SSD_CONV
        }
        if (g == 0 && (lane & 31) == 0) { vaend[hsub] = fexp(aend[0]); vaend[2 + hsub] = fexp(aend[1]); }
        asum[0] += aend[0]; asum[1] += aend[1];
        if (!OUT) SSD_PUT_T(L_VT, x1s);
        if (c + 1 < NCH) SSD_LOAD(c + 1);
        __syncthreads();
        const int lc = opq(lane), r = lc & 15, qd = lc >> 4;
        if (!OUT) {
#pragma unroll
            for (int jj = 0; jj < 8; ++jj) { bf16* pr = proj + (rowc + 8 * g + jj) * PP;
                *(unsigned*)(pr + DBc(gq) + 2 * cp) = Bp[jj]; *(unsigned*)(pr + DCc(gq) + 2 * cp) = Cp[jj];
                *(unsigned*)(pr + DXc(gq) + 2 * cp) = x0p[jj]; *(unsigned*)(pr + DXc(gq) + 128 + 2 * cp) = x1a[jj]; }
            const float fe0 = vaend[hw0], fe1 = vaend[hw1];
#pragma unroll
            for (int dt = 0; dt < 8; ++dt) { S[0][dt] = S[0][dt] * fe0; S[1][dt] = S[1][dt] * fe1;
#pragma unroll
                for (int ks = 0; ks < 2; ++ks) { const bf16x8 a = frag64(lds + L_KTT, 16 * dt + r, ks, qd);
                    S[0][dt] = MFMA16(a, frag64(lds + L_VVT, 16 * w + r, ks, qd), S[0][dt]); S[1][dt] = MFMA16(a, frag64(lds + L_VT, 16 * w + r, ks, qd), S[1][dt]); } }
        } else {
            const int it = w & 3;
            f32x4 cb[2];
#pragma unroll
            for (int j2 = 0; j2 < 2; ++j2) { const int jt = 2 * (w >> 2) + j2; cb[j2] = (f32x4){0.f, 0.f, 0.f, 0.f};
                if (jt <= it) {
#pragma unroll
                    for (int ks = 0; ks < 4; ++ks) cb[j2] = MFMA16(frag(lds + L_KT, 16 * jt + r, PQ, ks, qd), frag(lds + L_QT, 16 * it + r, PQ, ks, qd), cb[j2]); } }
            unsigned uA[8]; float ssq = 0.f;
#pragma unroll
            for (int R = 0; R < 2; ++R) {
#pragma unroll
                for (int hs = 0; hs < 2; ++hs) { const int hd = 2 * R + hs; const float ai = vacs[hd * 64 + 16 * it + r]; const float dgi = Dh[R][hs] * vdti[hd * 64 + 16 * it + r];
#pragma unroll
                    for (int j2 = 0; j2 < 2; ++j2) { const int jt = 2 * (w >> 2) + j2; f32x4 pv = (f32x4){0.f, 0.f, 0.f, 0.f};
                        if (jt <= it) { const f32x4 aj = *(const LAS f32x4*)(vacs + hd * 64 + 16 * jt + 4 * qd);
#pragma unroll
                            for (int rg = 0; rg < 4; ++rg) { float v = cb[j2][rg] * fexp(fminf(ai - aj[rg], 0.f));
                                if (jt == it) { if (4 * qd + rg > r) v = 0.f; else if (4 * qd + rg == r) v += dgi; }
                                pv[rg] = v; } }
                        *(LAS u32x2v*)(lds + L_PM + hs * 9216 + sw64(16 * it + r, (16 * jt + 4 * qd) * 2)) = pack4(pv); } }
#pragma unroll
                for (int dt = 0; dt < 8; ++dt) *(LAS u32x2v*)(lds + L_ST + (16 * w + r) * PQ + (16 * dt + 4 * qd) * 2) = pack4(S[R][dt]);
                if (R == 1) {
#pragma unroll
                    for (int jj = 0; jj < 8; ++jj) { const float e1 = fexp(aend[1] - vsl[128 + jj]); x1s[jj] = cvtpk(lo2f(x1a[jj]) * e1, hi2f(x1a[jj]) * e1); }
                    SSD_PUT_T(L_VVT, x1s); SSD_PUT_T(L_VT, x1a); }
                __syncthreads();
                const int le_ = opq(lane), r = le_ & 15, qd = le_ >> 4;
                const int hd = 2 * R + (w >> 2);
                const int te = opq(tid), ei = te >> 3, ecc = te & 7;
                bf16* zp = proj + (rowc + ei) * PP + ZD + gq * 256 + R * 128 + 16 * ecc;
                const u32x4v za = *(const u32x4v*)zp, zb = *(const u32x4v*)(zp + 8);
                f32x4 o[4];
#pragma unroll
                for (int it2 = 0; it2 < 4; ++it2) { f32x4 o1 = (f32x4){0.f, 0.f, 0.f, 0.f}, o2 = (f32x4){0.f, 0.f, 0.f, 0.f};
#pragma unroll
                    for (int ks = 0; ks < 2; ++ks) if (ks == 0 || it2 >= 2) o1 = MFMA16(frag64(lds + L_VT, 16 * w + r, ks, qd), frag64(lds + L_PM + (w >> 2) * 9216, 16 * it2 + r, ks, qd), o1);
#pragma unroll
                    for (int ks = 0; ks < 4; ++ks) o2 = MFMA16(frag(lds + L_ST, 16 * w + r, PQ, ks, qd), frag(lds + L_QT, 16 * it2 + r, PQ, ks, qd), o2);
                    const float ea = veacs[hd * 64 + 16 * it2 + r]; o[it2] = o1 + o2 * ea; }
                const float fe = vaend[hd];
#pragma unroll
                for (int dt = 0; dt < 8; ++dt) { S[R][dt] = S[R][dt] * fe;
#pragma unroll
                    for (int ks = 0; ks < 2; ++ks) S[R][dt] = MFMA16(frag64(lds + L_KTT, 16 * dt + r, ks, qd), frag64(lds + L_VVT, 16 * w + r, ks, qd), S[R][dt]); }
#pragma unroll
                for (int it2 = 0; it2 < 4; ++it2) *(LAS u32x2v*)(lds + L_KT + (16 * it2 + r) * 272 + (16 * w + 4 * qd) * 2) = pack4(o[it2]);
                __syncthreads();
                const u32x4v oa = *(const LAS u32x4v*)(lds + L_KT + ei * 272 + ecc * 32), ob = *(const LAS u32x4v*)(lds + L_KT + ei * 272 + ecc * 32 + 16);
                const float ov[16] = {lo2f(oa.x), hi2f(oa.x), lo2f(oa.y), hi2f(oa.y), lo2f(oa.z), hi2f(oa.z), lo2f(oa.w), hi2f(oa.w), lo2f(ob.x), hi2f(ob.x), lo2f(ob.y), hi2f(ob.y), lo2f(ob.z), hi2f(ob.z), lo2f(ob.w), hi2f(ob.w)};
                const float zv[16] = {lo2f(za.x), hi2f(za.x), lo2f(za.y), hi2f(za.y), lo2f(za.z), hi2f(za.z), lo2f(za.w), hi2f(za.w), lo2f(zb.x), hi2f(zb.x), lo2f(zb.y), hi2f(zb.y), lo2f(zb.z), hi2f(zb.z), lo2f(zb.w), hi2f(zb.w)};
                if (R == 0) {
#pragma unroll
                    for (int k = 0; k < 8; ++k) { const float u0 = ov[2 * k] * fsilu(zv[2 * k]), u1 = ov[2 * k + 1] * fsilu(zv[2 * k + 1]); uA[k] = cvtpk(u0, u1); ssq += lo2f(uA[k]) * lo2f(uA[k]) + hi2f(uA[k]) * hi2f(uA[k]); }
                } else {
                    float uB[16];
#pragma unroll
                    for (int k = 0; k < 16; ++k) { uB[k] = ov[k] * fsilu(zv[k]); ssq += uB[k] * uB[k]; }
                    ssq += __shfl_xor(ssq, 1); ssq += __shfl_xor(ssq, 2); ssq += __shfl_xor(ssq, 4);
                    const float rs = frsq(ssq * (1.0f / 256.0f) + EPS);
                    const float* nwp = P->ssd_norm_w + l * 512 + gq * 256 + 16 * ecc;
                    u32x4v ya, yb;
                    ya.x = cvtpk(lo2f(uA[0]) * rs * nwp[0], hi2f(uA[0]) * rs * nwp[1]); ya.y = cvtpk(lo2f(uA[1]) * rs * nwp[2], hi2f(uA[1]) * rs * nwp[3]); ya.z = cvtpk(lo2f(uA[2]) * rs * nwp[4], hi2f(uA[2]) * rs * nwp[5]); ya.w = cvtpk(lo2f(uA[3]) * rs * nwp[6], hi2f(uA[3]) * rs * nwp[7]);
                    yb.x = cvtpk(lo2f(uA[4]) * rs * nwp[8], hi2f(uA[4]) * rs * nwp[9]); yb.y = cvtpk(lo2f(uA[5]) * rs * nwp[10], hi2f(uA[5]) * rs * nwp[11]); yb.z = cvtpk(lo2f(uA[6]) * rs * nwp[12], hi2f(uA[6]) * rs * nwp[13]); yb.w = cvtpk(lo2f(uA[7]) * rs * nwp[14], hi2f(uA[7]) * rs * nwp[15]);
                    if (DRY) { asm volatile("" :: "v"(ya.x), "v"(ya.y), "v"(ya.z), "v"(ya.w), "v"(yb.x), "v"(yb.y), "v"(yb.z), "v"(yb.w)); } else { *(u32x4v*)(zp - 128) = ya; *(u32x4v*)(zp - 128 + 8) = yb; }
                    nwp += 128;
                    ya.x = cvtpk(uB[0] * rs * nwp[0], uB[1] * rs * nwp[1]); ya.y = cvtpk(uB[2] * rs * nwp[2], uB[3] * rs * nwp[3]); ya.z = cvtpk(uB[4] * rs * nwp[4], uB[5] * rs * nwp[5]); ya.w = cvtpk(uB[6] * rs * nwp[6], uB[7] * rs * nwp[7]);
                    yb.x = cvtpk(uB[8] * rs * nwp[8], uB[9] * rs * nwp[9]); yb.y = cvtpk(uB[10] * rs * nwp[10], uB[11] * rs * nwp[11]); yb.z = cvtpk(uB[12] * rs * nwp[12], uB[13] * rs * nwp[13]); yb.w = cvtpk(uB[14] * rs * nwp[14], uB[15] * rs * nwp[15]);
                    if (DRY) { asm volatile("" :: "v"(ya.x), "v"(ya.y), "v"(ya.z), "v"(ya.w), "v"(yb.x), "v"(yb.y), "v"(yb.z), "v"(yb.w)); } else { *(u32x4v*)zp = ya; *(u32x4v*)(zp + 8) = yb; }
                }
            }
        }
    }
    if (!OUT) {
        bf16* sb = stbase + (size_t)idx * 32768;
#pragma unroll
        for (int R = 0; R < 2; ++R)
#pragma unroll
            for (int dt = 0; dt < 8; ++dt) st_wt(sb + ((size_t)(w * 16 + R * 8 + dt) * 64 + lane) * 4, pack4(S[R][dt]));
        if (g == 0 && (lane & 31) == 0) { st_wt_f(dsbase + (size_t)idx * 4 + hsub, asum[0]); st_wt_f(dsbase + (size_t)idx * 4 + 2 + hsub, asum[1]); }
        publish_item(flag_ptr(P, FLAG_SSD, idx), (unsigned)l + 1u);
    }
    __syncthreads();
#undef SSD_PUT_T
#undef SSD_LOAD
}
}
#define GAS __attribute__((address_space(1)))
typedef GAS unsigned gu32;
#define XB_TMO      128
#define XB_XCNT(j)  (256  + 64 * (j))
#define XB_XSUB(j)  (1280 + 64 * (j))
#define XB_XGEN(j)  (2304 + 64 * (j))
#define XB_TOP      3328
#define XB_TOPGEN   3392
#define XCD_BAR_WORDS 3456
#define XB_SPIN_CAP (1u << 18)

__device__ __forceinline__ unsigned xb_ld(unsigned* p)              { return __hip_atomic_load(p, __ATOMIC_RELAXED, __HIP_MEMORY_SCOPE_AGENT); }
__device__ __forceinline__ unsigned xb_add(unsigned* p, unsigned v) { return __hip_atomic_fetch_add(p, v, __ATOMIC_RELAXED, __HIP_MEMORY_SCOPE_AGENT); }
__device__ __forceinline__ unsigned xb_xcc_id() { return (unsigned)__builtin_amdgcn_s_getreg((3 << 11) | 20) & 0xFu; }
#define XB_SPIN(cond, bar) do { unsigned _sp = 0; while (cond) { __builtin_amdgcn_s_sleep(1); \
    if ((++_sp & 255u) == 0u) { if (xb_ld(&(bar)[XB_TMO])) break; if (_sp > XB_SPIN_CAP) { atomicAdd(&(bar)[XB_TMO], 1u); break; } } } } while (0)

struct XcdBarrier {
    unsigned* bar; unsigned x;
    volatile LAS unsigned* st;
};

__device__ __forceinline__ XcdBarrier xcd_barrier_post(unsigned* bar, volatile LAS unsigned* st) {
    XcdBarrier b; b.bar = bar; b.x = xb_xcc_id(); b.st = st;
    if (threadIdx.x == 0) (void)xb_add(&bar[XB_XCNT(b.x)], 1u);
    return b;
}
__device__ __forceinline__ void xcd_barrier_complete(unsigned* bar, unsigned x, unsigned& nloc, unsigned& nx) {
    const unsigned G = gridDim.x * gridDim.y * gridDim.z;
    unsigned sum, cnt, mine, sp = 0u;
    for (;;) {
        sum = 0u; cnt = 0u; mine = 0u;
#pragma unroll
        for (unsigned j = 0; j < 16; ++j) { const unsigned c = xb_ld(&bar[XB_XCNT(j)]); sum += c; cnt += (c > 0u) ? 1u : 0u; mine = (j == x) ? c : mine; }
        if (sum == G) break;
        __builtin_amdgcn_s_sleep(1);
        if ((++sp & 255u) == 0u) { if (xb_ld(&bar[XB_TMO])) break; if (sp > XB_SPIN_CAP) { atomicAdd(&bar[XB_TMO], 1u); break; } }
    }
    nloc = mine > 0u ? mine : 1u; nx = cnt > 0u ? cnt : 1u;
}

__device__ __forceinline__ void xcd_barrier(const XcdBarrier& b) {
    asm volatile("s_waitcnt vmcnt(0)" ::: "memory");
    __syncthreads();
    if (threadIdx.x == 0) {
        unsigned* bar = b.bar;
        __builtin_amdgcn_s_waitcnt(0);
        unsigned nloc = b.st[0], nx = b.st[1];
        if (nloc == 0u) { xcd_barrier_complete(bar, b.x, nloc, nx); b.st[0] = nloc; b.st[1] = nx; }
        const unsigned old = xb_add(&bar[XB_XSUB(b.x)], 1u);
        const unsigned gen = old / nloc;
        if (old + 1u == (gen + 1u) * nloc) {
            __builtin_amdgcn_fence(__ATOMIC_RELEASE, "agent");
            asm volatile("s_waitcnt vmcnt(0)" ::: "memory");
            const unsigned og = xb_add(&bar[XB_TOP], 1u);
            const unsigned tg = og / nx;
            if (og + 1u == (tg + 1u) * nx) xb_add(&bar[XB_TOPGEN], 1u);
            else XB_SPIN(xb_ld(&bar[XB_TOPGEN]) == tg, bar);
            __builtin_amdgcn_fence(__ATOMIC_ACQUIRE, "agent");
            xb_add(&bar[XB_XGEN(b.x)], 1u);
            asm volatile("s_waitcnt vmcnt(0)" ::: "memory");
        } else {
            XB_SPIN(xb_ld(&bar[XB_XGEN(b.x)]) == gen, bar);
            __builtin_amdgcn_fence(__ATOMIC_ACQUIRE, "agent");
            asm volatile("s_waitcnt vmcnt(0)" ::: "memory");
        }
    }
    __syncthreads();
}
constexpr int LDS_BYTES = 163840;
constexpr int LDS_BARST = 163832;
constexpr int CTL_BYTES = 65536;
template <bool OUT>
__device__ __forceinline__ void engine_items(KP P, int l, int bid, int nblk, LAS unsigned char* lds) {
    if (nblk == 256) {
        if (bid < 64) { const int s = bid & 15, bg = bid >> 4; mx::ssd_item<OUT>(P, l, bg >> 1, bg & 1, s, lds); }
        else if (bid < 192) { const int ii = bid - 64, s = ii & 15, bh = ii >> 4;
            mx::ml_item<OUT>(P, l, bh >> 2, bh & 3, s, lds); if (OUT) mx::pc_item<0, true>(P, l, bh >> 2, bh & 3, 15 - s, lds); else mx::pc_pass1<0>(P, l, bh >> 2, bh & 3, 15 - s, lds); }
        else { const int ii = bid - 192, sh = ii & 7, bh = ii >> 3;
            if (OUT) { mx::pc_item<2, true>(P, l, bh >> 2, bh & 3, sh, lds); mx::pc_item<2, true>(P, l, bh >> 2, bh & 3, 15 - sh, lds); }
            else { mx::pc_pass1<2>(P, l, bh >> 2, bh & 3, sh, lds); mx::pc_pass1<2>(P, l, bh >> 2, bh & 3, 15 - sh, lds); } }
    } else {
        for (int ii = bid; ii < 448; ii += nblk) {
            if (ii < 64) { const int s = ii & 15, bg = ii >> 4; mx::ssd_item<OUT>(P, l, bg >> 1, bg & 1, s, lds); }
            else if (ii < 192) { const int i2 = ii - 64, s = i2 & 15, bh = i2 >> 4; mx::ml_item<OUT>(P, l, bh >> 2, bh & 3, s, lds); }
            else if (ii < 320) { const int i2 = ii - 192, s = i2 & 15, bh = i2 >> 4; mx::pc_item<2, OUT>(P, l, bh >> 2, bh & 3, s, lds); }
            else { const int i2 = ii - 320, s = i2 & 15, bh = i2 >> 4; mx::pc_item<0, OUT>(P, l, bh >> 2, bh & 3, s, lds); }
        }
    }
}
__global__ void __launch_bounds__(512, 2) fwd_mega(Params Pval) {
    extern __shared__ __attribute__((aligned(16))) unsigned char lds_raw[]; LAS unsigned char* lds = (LAS unsigned char*)lds_raw;
    (void)Pval; KP P = (KP)__builtin_amdgcn_kernarg_segment_ptr();
#define LAUNDER() asm volatile("" : "+s"(P))
    const int bid = blockIdx.x, nblk = gridDim.x;
    if (threadIdx.x < 2) ((LAS unsigned*)(lds + LDS_BARST))[threadIdx.x] = 0u;
    __syncthreads();
    LAUNDER();
    XcdBarrier bar = xcd_barrier_post((unsigned*)(P->ws + WS_CTL) + 1024, (volatile LAS unsigned*)(lds + LDS_BARST));
    LAUNDER(); phase_prologue(P, bid, nblk, lds);
    xcd_barrier(bar);
#define LAYER_BODY(l) do { \
        LAUNDER(); phase_gemm_in(P, l, bid, nblk, lds); \
        xcd_barrier(bar); \
        LAUNDER(); engine_items<false>(P, l, bid, nblk, lds); \
        LAUNDER(); engine_items<true>(P, l, bid, nblk, lds); \
        LAUNDER(); convert_weights_queue(P, l, lds); \
        xcd_barrier(bar); \
        LAUNDER(); phase_gemm_out(P, l, bid, nblk, lds); \
        xcd_barrier(bar); } while (0)
    LAYER_BODY(0);
    LAYER_BODY(1);
    static_assert(DEPTH == 2, "layer bodies are written out");
    LAUNDER(); phase_final(P, bid, nblk);
}

extern "C" void kernel_launch(void* const* d_in, const int* in_sizes, int n_in, void* d_out, int out_size, void* d_ws, size_t ws_size, hipStream_t stream) {
    static int grid_blocks = 0;
    if (!grid_blocks) {
        if (n_in != 21 || out_size != NTOK * DM || ws_size < WS_END) { fprintf(stderr, "kernel_launch: unexpected shapes (n_in %d out %d ws %zu)\n", n_in, out_size, ws_size); grid_blocks = -1; return; }
        if (hipFuncSetAttribute((const void*)fwd_mega, hipFuncAttributeMaxDynamicSharedMemorySize, LDS_BYTES) != hipSuccess) { fprintf(stderr, "hipFuncSetAttribute failed\n"); grid_blocks = -1; return; }
        int dev = 0, cus = 0, per_cu = 0;
        (void)hipGetDevice(&dev); (void)hipDeviceGetAttribute(&cus, hipDeviceAttributeMultiprocessorCount, dev);
        (void)hipOccupancyMaxActiveBlocksPerMultiprocessor(&per_cu, (const void*)fwd_mega, 512, LDS_BYTES);
        if (per_cu < 1) { fprintf(stderr, "kernel_launch: occupancy query says %d blocks per CU\n", per_cu); grid_blocks = -1; return; }
        grid_blocks = cus;
    }
    if (grid_blocks < 0) return;
    (void)hipMemsetAsync((unsigned char*)d_ws + WS_CTL, 0, CTL_BYTES, stream);
    Params P{};
    const float** pp = (const float**)&P;
    for (int i = 0; i < 21; ++i) pp[i] = (const float*)d_in[i];
    P.out = (float*)d_out; P.ws = (unsigned char*)d_ws;
    void* args[] = {&P};
    hipError_t e = hipLaunchCooperativeKernel((const void*)fwd_mega, dim3(grid_blocks), dim3(512), args, LDS_BYTES, stream);
    if (e != hipSuccess) fprintf(stderr, "cooperative launch failed: %s (grid %d)\n", hipGetErrorString(e), grid_blocks);
}
```

```cpp
#include <hip/hip_runtime.h>
#include <hip/hip_cooperative_groups.h>
#include <cstdio>
#include <cstdint>
namespace cg = cooperative_groups;

constexpr int NTOK = 16384, SEQ = 8192, DM = 1024, DEPTH = 2, DPROJ = 7712, DINNER = 2048;
constexpr int PP = 7680;
constexpr int NPAD = 7936;
constexpr float EPS = 1e-6f;
constexpr int ZA = 0, ZB = 512, ZC = 1024, ZD = 1536;
__host__ __device__ constexpr int AQc(int h) { return 2048 + h * 256; }
__host__ __device__ constexpr int AKc(int h) { return 2048 + h * 256 + 64; }
__host__ __device__ constexpr int AVc(int h) { return 2048 + h * 256 + 128; }
__host__ __device__ constexpr int BQc(int h) { return 3072 + h * 512; }
__host__ __device__ constexpr int BKc(int h) { return 3072 + h * 512 + 128; }
__host__ __device__ constexpr int BVc(int h) { return 3072 + h * 512 + 256; }
__host__ __device__ constexpr int BOc(int h) { return 3072 + h * 512 + 384; }
__host__ __device__ constexpr int CQc(int h) { return 5120 + h * 384; }
__host__ __device__ constexpr int CFc(int h) { return 5120 + h * 384 + 128; }
__host__ __device__ constexpr int CIc(int h) { return 5120 + h * 384 + 256; }
constexpr int DSSD = 6656;
__host__ __device__ constexpr int DXc(int g) { return DSSD + g * 512; }
__host__ __device__ constexpr int DBc(int g) { return DSSD + g * 512 + 256; }
__host__ __device__ constexpr int DCc(int g) { return DSSD + g * 512 + 384; }
constexpr int G_GR = 0, G_BI = 16, G_BF = 20, G_DT = 24;

__host__ __device__ __forceinline__ int win_src_col(int n) {
    if (n < 2048) { const int g = n >> 9, r = n & 511; const int base = (g == 0) ? 1040 : (g == 1) ? 3608 : (g == 2) ? 5656 : 7200; return base + r; }
    if (n < 3072) { const int j = n - 2048, h = j >> 8, r = j & 255; return (r < 64) ? h * 64 + r : (r < 128) ? 256 + h * 64 + (r - 64) : 512 + h * 128 + (r - 128); }
    if (n < 5120) { const int j = n - 3072, h = j >> 9, r = j & 511, part = r >> 7, c = r & 127; return ((part == 0) ? 1552 : (part == 1) ? 2064 : (part == 2) ? 2576 : 3096) + h * 128 + c; }
    if (n < 6656) { const int j = n - 5120, h = j / 384, r = j % 384, part = r >> 7, c = r & 127; return ((part == 0) ? 4120 : (part == 1) ? 4632 : 5144) + h * 128 + c; }
    if (n < 7680) { const int j = n - 6656, g = j >> 9, r = j & 511; return (r < 256) ? 6168 + g * 256 + r : (r < 384) ? 6680 + g * 128 + (r - 256) : 6936 + g * 128 + (r - 384); }
    const int j = n - 7680;
    if (j < 16) return 1024 + j;
    if (j < 20) return 3088 + (j - 16);
    if (j < 24) return 3092 + (j - 20);
    if (j < 32) return 7192 + (j - 24);
    return -1;
}

constexpr size_t MiB = 1u << 20;
constexpr size_t WS_CTL = 0;
constexpr size_t WS_PROJ = 1 * MiB;
constexpr size_t WS_GATES = 241 * MiB;
constexpr size_t WS_WOUT = 243 * MiB;
constexpr size_t WS_SSQ = 251 * MiB;
constexpr size_t WS_RSTD0 = 252 * MiB;
constexpr size_t WS_MISC = 252 * MiB + 65536;
constexpr size_t WS_HALO = 253 * MiB;
constexpr size_t WS_END = 256 * MiB;
constexpr size_t DO_HB = 0;
constexpr size_t DO_WIN = 32 * MiB;
constexpr size_t DO_WIN_STRIDE = 15 * MiB + MiB / 2;
constexpr size_t DO_STATE = 32 * MiB;

typedef unsigned short bf16;
typedef float f32x4v __attribute__((ext_vector_type(4)));
typedef unsigned u32x4v __attribute__((ext_vector_type(4)));
typedef unsigned u32x2v __attribute__((ext_vector_type(2)));
#define LAS __attribute__((address_space(3)))

__device__ __forceinline__ float bf2f(unsigned short u) { return __uint_as_float(((unsigned)u) << 16); }
__device__ __forceinline__ unsigned f2bf(float f) { unsigned u = __float_as_uint(f); return (u + 0x7fffu + ((u >> 16) & 1u)) >> 16; }
__device__ __forceinline__ unsigned pk2(float lo, float hi) { return f2bf(lo) | (f2bf(hi) << 16); }
__device__ __forceinline__ float sigmoidf_(float x) { return 1.f / (1.f + __expf(-x)); }
__device__ __forceinline__ float siluf_(float x) { return x / (1.f + __expf(-x)); }
__device__ __forceinline__ float softplusf_(float x) { return fmaxf(x, 0.f) + log1pf(__expf(-fabsf(x))); }
__device__ __forceinline__ float logsigmoidf_(float x) { return fminf(x, 0.f) - log1pf(__expf(-fabsf(x))); }
__device__ __forceinline__ float wave_sum(float v) {
#pragma unroll
    for (int o = 1; o < 64; o <<= 1) v += __shfl_xor(v, o);
    return v;
}

typedef float f32x2c __attribute__((ext_vector_type(2)));
typedef __bf16 bf16x2c __attribute__((ext_vector_type(2)));
__device__ __forceinline__ unsigned cvt_pk2(float lo, float hi) { f32x2c v = {lo, hi}; bf16x2c r = __builtin_convertvector(v, bf16x2c); return __builtin_bit_cast(unsigned, r); }
__device__ __forceinline__ int opaque_tid() { int t = threadIdx.x; asm volatile("" : "+v"(t)); return t; }

struct Params {
    const float* x; const float* norm_w; const float* w_in; const float* gla_gate_w; const float* gla_gate_b; const float* gla_norm_w;
    const float* ml_conv_w; const float* ml_conv_b; const float* ml_i_b; const float* ml_f_b; const float* ml_norm_w;
    const float* hg_lb; const float* hg_norm_w; const float* ssd_conv_w; const float* ssd_conv_b; const float* ssd_dt_bias;
    const float* ssd_A_log; const float* ssd_D; const float* ssd_norm_w; const float* w_out; const float* final_norm_w;
    float* out; unsigned char* ws;
};
typedef const __attribute__((address_space(4))) Params* KP;
namespace pg8 {
#define PG8_LAS __attribute__((address_space(3)))
typedef unsigned short bf16_t;
typedef short bf16x8 __attribute__((ext_vector_type(8)));
typedef float f32x4 __attribute__((ext_vector_type(4)));
typedef unsigned u32x4 __attribute__((ext_vector_type(4)));
constexpr int BM = 256, BK = 64, HALF = 128, HTB = HALF * BK * 2  , STAGE_BYTES = 8 * HTB, NXCD = 8, WGM = 4;

__host__ __device__ __forceinline__ int lds_byte(int r, int c) { const int st = (r >> 4) * 2 + (c >> 5), rr = r & 15, cc = c & 31, ob = rr * 64 + cc * 2; return st * 1024 + (ob ^ (((ob >> 9) & 1) << 5)); }
__host__ __device__ __forceinline__ void stage_rc(int b, int& R, int& C) { const int st = b / 1024, sb = b % 1024, swz = sb ^ (((sb >> 9) & 1) << 5); R = (st >> 1) * 16 + swz / 64; C = (st & 1) * 32 + (swz % 64) / 2; }
__host__ __device__ __forceinline__ int perm32(int rho) { const int n = rho >> 4, i = rho & 15; return 8 * (i >> 2) + 4 * n + (i & 3); }

struct Unit { int pm, pn, idx; };
struct Gemm { const bf16_t* A; const bf16_t* Bt; int M, N, K, lda; };

struct StaticOrder {
    int nM, nN, nwg, G, c;
    __host__ __device__ void init(int M, int N, int G_, int c_) { nM = M / BM; nN = N / BM; nwg = nM * nN; G = G_; c = c_; }
    __host__ __device__ bool next(int i, Unit& u) const {
        const long L = (long)i * G + c; if (L >= nwg) return false;
        int wgid = (int)L; { const int q = nwg / NXCD, r = nwg % NXCD, xcd = wgid % NXCD, off = wgid / NXCD; wgid = (xcd < r ? xcd * (q + 1) : r * (q + 1) + (xcd - r) * q) + off; }
        const int nig = WGM * nN, gid = wgid / nig, fm = gid * WGM, gsz = (nM - fm) < WGM ? (nM - fm) : WGM;
        u.pm = fm + ((wgid % nig) % gsz); u.pn = (wgid % nig) / gsz; u.idx = i; return true;
    }
    __device__ __forceinline__ void a_ready(const Unit&) const {}
    __device__ __forceinline__ void done(const Unit&) const {}
};

__device__ __forceinline__ unsigned cvt_pk_bf16(float lo, float hi) { return cvt_pk2(lo, hi); }

template <class Epi, class Sched, bool ALIGN_EPI = false, bool SP2 = false>
__device__ __forceinline__ void gemm_phase(PG8_LAS unsigned char* lds, const Gemm g, const Sched& S, const Epi& E) {
    const int tid = opaque_tid(), wid = __builtin_amdgcn_readfirstlane(tid >> 6), lane = tid & 63, wr = wid >> 2, wc = wid & 3, fr = lane & 15, fq = lane >> 4;
    const int K = g.K, nt = K / BK, lda = g.lda;
    unsigned voffA[2], voffB[2];
#pragma unroll
    for (int i = 0; i < 2; ++i) { int R, C; stage_rc(tid * 16 + i * 8192, R, C); const int Rb = Epi::PERM ? ((R & ~31) + perm32(R & 31)) : R;
        voffA[i] = (unsigned)(R * lda + C) * 2u; voffB[i] = (unsigned)(Rb * K + C) * 2u; }
    const size_t kstep = (size_t)(BK * 2);
    const size_t hsA = (size_t)HALF * lda * 2, hsB = (size_t)HALF * K * 2;
    const size_t tsA = 2 * hsA, tsB = 2 * hsB;
    const unsigned ldsw = (unsigned)wid * 1024u;
    const int aoff = lds_byte(wr * 64 + fr, fq * 8), boff = lds_byte(wc * 32 + fr, fq * 8);
#define PG8_SA(b, h) (((b) * 2 + (h)) * HTB)
#define PG8_SB(b, h) ((4 + (b) * 2 + (h)) * HTB)
#define PG8_STAGE(bufoff, gbase, voff) do { _Pragma("unroll") for (int _i = 0; _i < 2; ++_i) \
        __builtin_amdgcn_global_load_lds((const unsigned*)((const char*)(gbase) + (voff)[_i]), (PG8_LAS unsigned*)(lds + (bufoff) + ldsw + _i * 8192), 16, 0, 0); } while (0)
#define PG8_LDA(dst, b, h) do { _Pragma("unroll") for (int m = 0; m < 4; ++m) _Pragma("unroll") for (int k = 0; k < 2; ++k) dst[m][k] = *(const PG8_LAS bf16x8*)(lds + PG8_SA(b, h) + aoff + m * 2048 + k * 1024); } while (0)
#define PG8_LDB(dst, b, h) do { _Pragma("unroll") for (int n = 0; n < 2; ++n) _Pragma("unroll") for (int k = 0; k < 2; ++k) dst[n][k] = *(const PG8_LAS bf16x8*)(lds + PG8_SB(b, h) + boff + n * 2048 + k * 1024); } while (0)
#define PG8_MMA(ai, bj, At, Bt) do { __builtin_amdgcn_s_setprio(1); _Pragma("unroll") for (int m = 0; m < 4; ++m) _Pragma("unroll") for (int n = 0; n < 2; ++n) _Pragma("unroll") for (int k = 0; k < 2; ++k) \
        acc[ai][bj][m][n] = __builtin_amdgcn_mfma_f32_16x16x32_bf16(Bt[n][k], At[m][k], acc[ai][bj][m][n], 0, 0, 0); __builtin_amdgcn_s_setprio(0); } while (0)
#define PG8_WAIT_V(n) asm volatile("s_waitcnt vmcnt(" #n ")" ::: "memory")
#define PG8_WAIT_L(n) asm volatile("s_waitcnt lgkmcnt(" #n ")" ::: "memory")
#define PG8_BAR __builtin_amdgcn_s_barrier()
#define PG8_SCHED __builtin_amdgcn_sched_barrier(0)
    Unit cur, nxt; int ui = 0;
    if (!S.next(0, cur)) return;
    f32x4 acc[2][2][4][2];
#pragma unroll
    for (int a = 0; a < 2; ++a)
#pragma unroll
        for (int b = 0; b < 2; ++b)
#pragma unroll
            for (int m = 0; m < 4; ++m)
#pragma unroll
                for (int n = 0; n < 2; ++n) acc[a][b][m][n] = (f32x4){0.f, 0.f, 0.f, 0.f};
    bf16x8 At[4][2], B0[2][2], B1[2][2];
    const char* cA = (const char*)g.A + (size_t)cur.pm * tsA; const char* cB = (const char*)g.Bt + (size_t)cur.pn * tsB;
    S.a_ready(cur);
    if constexpr (SP2) {
        PG8_STAGE(PG8_SB(0, 0), cB, voffB); PG8_STAGE(PG8_SB(0, 1), cB + hsB, voffB); PG8_STAGE(PG8_SA(0, 0), cA, voffA); PG8_STAGE(PG8_SA(0, 1), cA + hsA, voffA);
        if (wr == 1) PG8_BAR;
        PG8_WAIT_V(2); PG8_BAR;
        PG8_STAGE(PG8_SB(1, 0), cB + kstep, voffB); PG8_STAGE(PG8_SA(1, 0), cA + kstep, voffA); PG8_STAGE(PG8_SB(1, 1), cB + hsB + kstep, voffB);
        PG8_WAIT_V(6); PG8_BAR;
    } else {
        PG8_STAGE(PG8_SB(0, 0), cB, voffB); PG8_STAGE(PG8_SA(0, 0), cA, voffA); PG8_STAGE(PG8_SB(0, 1), cB + hsB, voffB); PG8_STAGE(PG8_SA(0, 1), cA + hsA, voffA);
        if (wr == 1) PG8_BAR;
        PG8_WAIT_V(4); PG8_BAR;
        PG8_STAGE(PG8_SB(1, 0), cB + kstep, voffB); PG8_STAGE(PG8_SA(1, 0), cA + kstep, voffA); PG8_STAGE(PG8_SB(1, 1), cB + hsB + kstep, voffB);
        PG8_WAIT_V(6); PG8_BAR;
    }
    u32x4 held[4]; bool have_held = false; Unit hu = cur;
    for (;;) {
        const bool has_next = S.next(ui + 1, nxt);
        const char* nA = has_next ? (const char*)g.A + (size_t)nxt.pm * tsA : cA; const char* nB = has_next ? (const char*)g.Bt + (size_t)nxt.pn * tsB : cB;
        for (int t = 0; t < nt; t += 2) {
            const bool last = (t == nt - 2);
            const char* a1 = cA + (size_t)(t + 1) * kstep;
            const char* a2 = last ? nA : cA + (size_t)(t + 2) * kstep; const char* b2 = last ? nB : cB + (size_t)(t + 2) * kstep;
            const char* a3 = a2 + kstep; const char* b3 = b2 + kstep;
            if (last && has_next) S.a_ready(nxt);
            if constexpr (Epi::DEFER) { if (have_held && (t == 2 || t == 6)) E.store_held(held, hu, (t - 2) >> 2, wr, wc, fr, fq); }
            if constexpr (SP2) {
            PG8_LDB(B0, 0, 0); PG8_LDB(B1, 0, 1); PG8_SCHED; PG8_LDA(At, 0, 0); PG8_STAGE(PG8_SA(1, 1), a1 + hsA, voffA);
            PG8_WAIT_V(8); PG8_WAIT_L(0); PG8_BAR; PG8_MMA(0, 0, At, B0); PG8_MMA(0, 1, At, B1); PG8_BAR; PG8_SCHED;
            PG8_LDA(At, 0, 1); PG8_STAGE(PG8_SB(0, 0), b2, voffB); PG8_STAGE(PG8_SB(0, 1), b2 + hsB, voffB); PG8_STAGE(PG8_SA(0, 0), a2, voffA);
            PG8_WAIT_V(8); PG8_WAIT_L(0); PG8_BAR; PG8_MMA(1, 0, At, B0); PG8_MMA(1, 1, At, B1); PG8_BAR; PG8_SCHED;
            PG8_LDB(B0, 1, 0); PG8_LDB(B1, 1, 1); PG8_SCHED; PG8_LDA(At, 1, 0); PG8_STAGE(PG8_SA(0, 1), a2 + hsA, voffA);
            PG8_WAIT_V(8); PG8_WAIT_L(0); PG8_BAR; PG8_MMA(0, 0, At, B0); PG8_MMA(0, 1, At, B1); PG8_BAR; PG8_SCHED;
            PG8_LDA(At, 1, 1); PG8_STAGE(PG8_SB(1, 0), b3, voffB); PG8_STAGE(PG8_SB(1, 1), b3 + hsB, voffB); PG8_STAGE(PG8_SA(1, 0), a3, voffA);
            PG8_WAIT_V(8); PG8_WAIT_L(0); PG8_BAR; PG8_MMA(1, 0, At, B0); PG8_MMA(1, 1, At, B1); PG8_BAR; PG8_SCHED;
            } else {
            PG8_LDB(B0, 0, 0); PG8_SCHED; PG8_LDA(At, 0, 0); PG8_STAGE(PG8_SA(1, 1), a1 + hsA, voffA);
            PG8_WAIT_L(8); PG8_BAR; PG8_WAIT_L(0); PG8_MMA(0, 0, At, B0); PG8_BAR; PG8_SCHED;
            PG8_LDB(B1, 0, 1); PG8_STAGE(PG8_SB(0, 0), b2, voffB);
            PG8_BAR; PG8_WAIT_L(0); PG8_MMA(0, 1, At, B1); PG8_BAR;
            PG8_LDA(At, 0, 1); PG8_STAGE(PG8_SA(0, 0), a2, voffA);
            PG8_BAR; PG8_WAIT_L(0); PG8_MMA(1, 0, At, B0); PG8_BAR; PG8_SCHED;
            PG8_STAGE(PG8_SB(0, 1), b2 + hsB, voffB);
            PG8_WAIT_V(6); PG8_BAR; PG8_MMA(1, 1, At, B1); PG8_BAR;
            PG8_LDB(B0, 1, 0); PG8_SCHED; PG8_LDA(At, 1, 0); PG8_STAGE(PG8_SA(0, 1), a2 + hsA, voffA);
            PG8_WAIT_L(8); PG8_BAR; PG8_WAIT_L(0); PG8_MMA(0, 0, At, B0); PG8_BAR; PG8_SCHED;
            PG8_LDB(B1, 1, 1); PG8_STAGE(PG8_SB(1, 0), b3, voffB);
            PG8_BAR; PG8_WAIT_L(0); PG8_MMA(0, 1, At, B1); PG8_BAR;
            PG8_LDA(At, 1, 1); PG8_STAGE(PG8_SA(1, 0), a3, voffA);
            PG8_BAR; PG8_WAIT_L(0); PG8_MMA(1, 0, At, B0); PG8_BAR; PG8_SCHED;
            PG8_STAGE(PG8_SB(1, 1), b3 + hsB, voffB);
            PG8_WAIT_V(6); PG8_BAR; PG8_MMA(1, 1, At, B1); PG8_BAR;
            }
        }
        if constexpr (ALIGN_EPI) { if (wr == 0) PG8_BAR; }
        if constexpr (Epi::DEFER) {
            have_held = E.first_half_and_pack(acc, cur, wr, wc, fr, fq, held); hu = cur;
            if (!has_next) { if (have_held) { for (int q = 0; q < 2; ++q) E.store_held(held, hu, q, wr, wc, fr, fq); } S.done(cur); break; }
            S.done(cur);
        } else {
            E(acc, cur, wr, wc, fr, fq); S.done(cur);
            if (!has_next) break;
        }
#pragma unroll
        for (int a = 0; a < 2; ++a)
#pragma unroll
            for (int b = 0; b < 2; ++b)
#pragma unroll
                for (int m = 0; m < 4; ++m)
#pragma unroll
                    for (int n = 0; n < 2; ++n) acc[a][b][m][n] = (f32x4){0.f, 0.f, 0.f, 0.f};
        cur = nxt; cA = nA; cB = nB; ++ui;
        if constexpr (ALIGN_EPI) { if (wr == 1) PG8_BAR; }
    }
    PG8_WAIT_V(0);
    if constexpr (!ALIGN_EPI) { if (wr == 0) PG8_BAR; }
    PG8_BAR;
#undef PG8_SA
#undef PG8_SB
#undef PG8_STAGE
#undef PG8_LDA
#undef PG8_LDB
#undef PG8_MMA
#undef PG8_WAIT_V
#undef PG8_WAIT_L
#undef PG8_BAR
#undef PG8_SCHED
}
}
struct EpiProj {
    static constexpr bool PERM = true;
    static constexpr bool DEFER = true;
    bf16* proj; float* gates; const LAS float* rstd_tab; bf16* halo;
    __device__ __forceinline__ u32x4v pack8(const pg8::f32x4& a0, const pg8::f32x4& a1, float rs) const {
        const pg8::f32x4 v0 = a0 * rs, v1 = a1 * rs;
        u32x4v w; w.x = pg8::cvt_pk_bf16(v0[0], v0[1]); w.y = pg8::cvt_pk_bf16(v0[2], v0[3]); w.z = pg8::cvt_pk_bf16(v1[0], v1[1]); w.w = pg8::cvt_pk_bf16(v1[2], v1[3]); return w; }
    __device__ __forceinline__ bool first_half_and_pack(const pg8::f32x4 (&acc)[2][2][4][2], const pg8::Unit& u, int wr, int wc, int fr, int fq, pg8::u32x4 (&held)[4]) const {
        const int row0 = u.pm * 256 + wr * 64 + fr;
        if (u.pn < 30) {
#pragma unroll
            for (int ai = 0; ai < 2; ++ai)
#pragma unroll
                for (int m = 0; m < 4; ++m) {
                    const int row = row0 + ai * 128 + m * 16;
                    const float rs = rstd_tab[u.idx * 256 + (row & 255)];
#pragma unroll
                    for (int bj = 0; bj < 2; ++bj) { const u32x4v w = pack8(acc[ai][bj][m][0], acc[ai][bj][m][1], rs);
                        if (ai == 1 && m >= 2) held[(m - 2) * 2 + bj] = w;
                        else *(u32x4v*)(proj + (size_t)row * PP + u.pn * 256 + bj * 128 + wc * 32 + 8 * fq) = w;
                        if (u.pn >= 26 && (row & 511) >= 509)
                            *(u32x4v*)(halo + ((size_t)((row >> 9) * 3 + ((row & 511) - 509))) * 1024 + (u.pn - 26) * 256 + bj * 128 + wc * 32 + 8 * fq) = w; }
                }
            return true;
        }
        if (wc == 0) {
#pragma unroll
            for (int ai = 0; ai < 2; ++ai)
#pragma unroll
                for (int m = 0; m < 4; ++m) { const int row = row0 + ai * 128 + m * 16; const float rs = rstd_tab[u.idx * 256 + (row & 255)];
                    float* gp = gates + (size_t)row * 32 + 8 * fq;
                    *(pg8::f32x4*)(gp) = acc[ai][0][m][0] * rs; *(pg8::f32x4*)(gp + 4) = acc[ai][0][m][1] * rs; }
        }
        return false;
    }
    __device__ __forceinline__ void store_held(const pg8::u32x4 (&held)[4], const pg8::Unit& u, int q, int wr, int wc, int fr, int fq) const {
        bf16* base = proj + (size_t)(u.pm * 256 + wr * 64 + fr + 128) * PP + u.pn * 256 + wc * 32 + 8 * fq;
#pragma unroll
        for (int m = 2; m < 4; ++m) if (m - 2 == q) {
#pragma unroll
            for (int bj = 0; bj < 2; ++bj) *(u32x4v*)(base + (size_t)(m * 16) * PP + bj * 128) = held[(m - 2) * 2 + bj]; }
    }
};
struct EpiRes {
    static constexpr bool PERM = true;
    static constexpr bool DEFER = false;
    bf16* hb; float* ssq; bf16* h2; int last;
    __device__ __forceinline__ void operator()(const pg8::f32x4 (&acc)[2][2][4][2], const pg8::Unit& u, int wr, int wc, int fr, int fq) const {
        const int row0 = u.pm * 256 + wr * 64 + fr, col0 = u.pn * 256 + wc * 32 + 8 * fq;
        u32x4v res[2][4][2];
#pragma unroll
        for (int ai = 0; ai < 2; ++ai)
#pragma unroll
            for (int m = 0; m < 4; ++m)
#pragma unroll
                for (int bj = 0; bj < 2; ++bj) res[ai][m][bj] = *(const u32x4v*)(hb + (size_t)(row0 + ai * 128 + m * 16) * DM + col0 + bj * 128);
#pragma unroll
        for (int ai = 0; ai < 2; ++ai)
#pragma unroll
            for (int m = 0; m < 4; ++m) {
                const int row = row0 + ai * 128 + m * 16;
                float sq = 0.f;
#pragma unroll
                for (int bj = 0; bj < 2; ++bj) {
                    const int col = col0 + bj * 128;
                    const u32x4v rw = res[ai][m][bj];
                    const pg8::f32x4 r0 = (pg8::f32x4){__uint_as_float(rw.x << 16), __uint_as_float(rw.x & 0xffff0000u), __uint_as_float(rw.y << 16), __uint_as_float(rw.y & 0xffff0000u)};
                    const pg8::f32x4 r1 = (pg8::f32x4){__uint_as_float(rw.z << 16), __uint_as_float(rw.z & 0xffff0000u), __uint_as_float(rw.w << 16), __uint_as_float(rw.w & 0xffff0000u)};
                    const pg8::f32x4 v0 = acc[ai][bj][m][0] + r0, v1 = acc[ai][bj][m][1] + r1;
                    u32x4v w; w.x = pg8::cvt_pk_bf16(v0[0], v0[1]); w.y = pg8::cvt_pk_bf16(v0[2], v0[3]); w.z = pg8::cvt_pk_bf16(v1[0], v1[1]); w.w = pg8::cvt_pk_bf16(v1[2], v1[3]);
                    bf16* dst = last ? (bf16*)((char*)h2 + (size_t)row * (PP * 2)) + col : hb + (size_t)row * DM + col;
                    *(u32x4v*)dst = w;
                    sq += (v0[0] * v0[0] + v0[1] * v0[1]) + (v0[2] * v0[2] + v0[3] * v0[3]) + (v1[0] * v1[0] + v1[1] * v1[1]) + (v1[2] * v1[2] + v1[3] * v1[3]);
                }
                sq += __shfl_xor(sq, 16); sq += __shfl_xor(sq, 32);
                if (fq == 0) ssq[(size_t)(u.pn * 4 + wc) * NTOK + row] = sq;
            }
    }
};

constexpr int NIT_WIN = (DM / 64) * (NPAD / 32), NIT_WOUT = (DINNER / 64) * (DM / 32);
template <int NR>
__device__ __forceinline__ void rows_to_bf16_rstd(const float* x, bf16* hb, float* rstd, int m0, int mstride, int lane) {
    f32x4v v[NR][4];
#pragma unroll
    for (int q = 0; q < NR; ++q) { const f32x4v* xr = (const f32x4v*)(x + (size_t)(m0 + q * mstride) * DM) + lane;
#pragma unroll
        for (int j = 0; j < 4; ++j) v[q][j] = __builtin_nontemporal_load(xr + 64 * j); }
#pragma unroll
    for (int q = 0; q < NR; ++q) { float s = 0.f;
#pragma unroll
        for (int j = 0; j < 4; ++j) s += (v[q][j].x * v[q][j].x + v[q][j].y * v[q][j].y) + (v[q][j].z * v[q][j].z + v[q][j].w * v[q][j].w);
        s = wave_sum(s);
        if (lane == 0) rstd[m0 + q * mstride] = 1.0f / sqrtf(s * (1.0f / DM) + EPS);
        u32x2v* o8 = (u32x2v*)(hb + (size_t)(m0 + q * mstride) * DM) + lane;
#pragma unroll
        for (int j = 0; j < 4; ++j) { u32x2v w; w.x = cvt_pk2(v[q][j].x, v[q][j].y); w.y = cvt_pk2(v[q][j].z, v[q][j].w); o8[64 * j] = w; } }
}
template <bool WIN>
__device__ __forceinline__ void transpose_item(const float* W, int K, int Nsrc, int Ndst, bf16* WT, LAS float* scr, int item, int lane, const float* kscale) {
    const int nb_n = Ndst / 32, kb = item / nb_n, nb = item % nb_n, k0 = 64 * kb, n0 = 32 * nb;
    const int n4 = (lane & 7) * 4; const int src = WIN ? win_src_col(n0 + n4) : (n0 + n4);
#pragma unroll
    for (int i = 0; i < 8; ++i) { const int kk = 8 * i + (lane >> 3);
        f32x4v v = (f32x4v){0.f, 0.f, 0.f, 0.f}; if (src >= 0) { v = __builtin_nontemporal_load((const f32x4v*)(W + (size_t)(k0 + kk) * Nsrc + src)); if (WIN) v = v * kscale[k0 + kk]; }
        scr[kk * 33 + n4] = v.x; scr[kk * 33 + n4 + 1] = v.y; scr[kk * 33 + n4 + 2] = v.z; scr[kk * 33 + n4 + 3] = v.w; }
    asm volatile("s_waitcnt lgkmcnt(0)" ::: "memory");
    const int c = lane & 7;
#pragma unroll
    for (int j = 0; j < 4; ++j) { const int n = (lane >> 3) + 8 * j; const LAS float* s = scr + (8 * c) * 33 + n;
        u32x4v o; o.x = cvt_pk2(s[0 * 33], s[1 * 33]); o.y = cvt_pk2(s[2 * 33], s[3 * 33]); o.z = cvt_pk2(s[4 * 33], s[5 * 33]); o.w = cvt_pk2(s[6 * 33], s[7 * 33]);
        *(u32x4v*)(WT + (size_t)(n0 + n) * K + k0 + 8 * c) = o; }
    asm volatile("s_waitcnt lgkmcnt(0)" ::: "memory");
}
struct TItem { const float* W; bf16* WT; const float* kscale; int K, Nsrc, k0, n0, src; bool win; };
__device__ __forceinline__ TItem cvt_item(KP P, int l, int it, int lane) {
    const int n_in = (l + 1 < DEPTH) ? NIT_WIN : 0; TItem t;
    if (it < n_in) { t.W = P->w_in + (size_t)(l + 1) * DM * DPROJ; t.K = DM; t.Nsrc = DPROJ; t.WT = (bf16*)((unsigned char*)P->out + DO_WIN + (size_t)(l + 1) * DO_WIN_STRIDE); t.kscale = P->norm_w + (l + 1) * DM; t.win = true;
        const int nb_n = NPAD / 32; t.k0 = 64 * (it / nb_n); t.n0 = 32 * (it % nb_n); t.src = win_src_col(t.n0 + (lane & 7) * 4); }
    else { const int i2 = it - n_in; t.W = P->w_out + (size_t)l * DINNER * DM; t.K = DINNER; t.Nsrc = DM; t.WT = (bf16*)(P->ws + WS_WOUT) + (size_t)l * DM * DINNER; t.kscale = nullptr; t.win = false;
        const int nb_n = DM / 32; t.k0 = 64 * (i2 / nb_n); t.n0 = 32 * (i2 % nb_n); t.src = t.n0 + (lane & 7) * 4; }
    return t;
}
__device__ __forceinline__ void cvt_load(const TItem& t, int lane, f32x4v (&v)[8]) {
#pragma unroll
    for (int i = 0; i < 8; ++i) { const int kk = 8 * i + (lane >> 3);
        v[i] = (f32x4v){0.f, 0.f, 0.f, 0.f}; if (t.src >= 0) { v[i] = __builtin_nontemporal_load((const f32x4v*)(t.W + (size_t)(t.k0 + kk) * t.Nsrc + t.src)); if (t.win) v[i] = v[i] * t.kscale[t.k0 + kk]; } }
}
__device__ __forceinline__ void cvt_finish(const TItem& t, int lane, const f32x4v (&v)[8], LAS float* scr) {
    const int n4 = (lane & 7) * 4;
#pragma unroll
    for (int i = 0; i < 8; ++i) { const int kk = 8 * i + (lane >> 3);
        scr[kk * 33 + n4] = v[i].x; scr[kk * 33 + n4 + 1] = v[i].y; scr[kk * 33 + n4 + 2] = v[i].z; scr[kk * 33 + n4 + 3] = v[i].w; }
    asm volatile("s_waitcnt lgkmcnt(0)" ::: "memory");
    const int c = lane & 7;
#pragma unroll
    for (int j = 0; j < 4; ++j) { const int n = (lane >> 3) + 8 * j; const LAS float* sp = scr + (8 * c) * 33 + n;
        u32x4v o; o.x = cvt_pk2(sp[0 * 33], sp[1 * 33]); o.y = cvt_pk2(sp[2 * 33], sp[3 * 33]); o.z = cvt_pk2(sp[4 * 33], sp[5 * 33]); o.w = cvt_pk2(sp[6 * 33], sp[7 * 33]);
        *(u32x4v*)(t.WT + (size_t)(t.n0 + n) * t.K + t.k0 + 8 * c) = o; }
    asm volatile("s_waitcnt lgkmcnt(0)" ::: "memory");
}
__device__ __forceinline__ void phase_prologue(KP P, int bid, int nblk, LAS unsigned char* lds) {
    const int tid = opaque_tid(), lane = tid & 63, wave = tid >> 6;
    const int gw = bid * 8 + wave, ngw = nblk * 8;
    LAS float* scr = (LAS float*)(lds + wave * 16384);
    bf16* hb = (bf16*)((unsigned char*)P->out + DO_HB); float* rstd0 = (float*)(P->ws + WS_RSTD0);
    { int m = gw;
      for (; m + 7 * ngw < NTOK; m += 8 * ngw) rows_to_bf16_rstd<8>(P->x, hb, rstd0, m, ngw, lane);
      for (; m + 3 * ngw < NTOK; m += 4 * ngw) rows_to_bf16_rstd<4>(P->x, hb, rstd0, m, ngw, lane);
      for (; m < NTOK; m += ngw) rows_to_bf16_rstd<1>(P->x, hb, rstd0, m, 0, lane); }
    for (int it = gw; it < NIT_WIN; it += ngw)
        transpose_item<true>(P->w_in, DM, DPROJ, NPAD, (bf16*)((unsigned char*)P->out + DO_WIN), scr, it, lane, P->norm_w);
}
constexpr int CVT_BATCH = 1;
__device__ __forceinline__ void convert_weights_late(KP P, int l, int gw, int ngw, LAS unsigned char* lds) {
    const int tid = opaque_tid(), lane = tid & 63, wave = tid >> 6;
    LAS float* scr = (LAS float*)(lds + wave * 16384);
    const int n_in = (l + 1 < DEPTH) ? NIT_WIN : 0;
    for (int it = gw; it < n_in + NIT_WOUT; it += ngw) {
        if (it < n_in) transpose_item<true>(P->w_in + (size_t)(l + 1) * DM * DPROJ, DM, DPROJ, NPAD, (bf16*)((unsigned char*)P->out + DO_WIN + (size_t)(l + 1) * DO_WIN_STRIDE), scr, it, lane, P->norm_w + (l + 1) * DM);
        else transpose_item<false>(P->w_out + (size_t)l * DINNER * DM, DINNER, DM, DM, (bf16*)(P->ws + WS_WOUT) + (size_t)l * DM * DINNER, scr, it - n_in, lane, nullptr);
    }
}
__device__ __forceinline__ void convert_weights_queue(KP P, int l, LAS unsigned char* lds) {
    const int tid = opaque_tid(), lane = tid & 63, wave = tid >> 6;
    LAS float* scr = (LAS float*)(lds + wave * 16384);
    volatile LAS int* slot = (volatile LAS int*)(lds + 8 * 16384);
    const int ntot = ((l + 1 < DEPTH) ? NIT_WIN : 0) + NIT_WOUT;
    unsigned* ctr = (unsigned*)(P->ws + WS_CTL) + 64 + 32 * l;
    for (;;) {
        if (tid == 0) *slot = (int)__hip_atomic_fetch_add(ctr, 16u, __ATOMIC_RELAXED, __HIP_MEMORY_SCOPE_AGENT);
        __syncthreads();
        const int base = __builtin_amdgcn_readfirstlane(*slot);
        __syncthreads();
        if (base >= ntot) break;
        const int i0 = base + wave, i1 = base + 8 + wave;
        f32x4v va[8], vb[8]; TItem ta, tb;
        if (i0 < ntot) { ta = cvt_item(P, l, i0, lane); cvt_load(ta, lane, va); }
        if (i1 < ntot) { tb = cvt_item(P, l, i1, lane); cvt_load(tb, lane, vb); }
        if (i0 < ntot) cvt_finish(ta, lane, va, scr);
        if (i1 < ntot) cvt_finish(tb, lane, vb, scr);
    }
}
__device__ __forceinline__ void phase_gemm_in(KP P, int l, int bid, int nblk, LAS unsigned char* lds) {
    pg8::Gemm g{(const bf16*)((unsigned char*)P->out + DO_HB), (const bf16*)((unsigned char*)P->out + DO_WIN + (size_t)l * DO_WIN_STRIDE), NTOK, NPAD, DM, DM};
    pg8::StaticOrder S; S.init(NTOK, NPAD, nblk, bid);
    LAS float* rtab = (LAS float*)(lds + 131072);
    { const int tid = opaque_tid(); const float* rstd0 = (const float*)(P->ws + WS_RSTD0); const float* ssq = (const float*)(P->ws + WS_SSQ);
      const int nunit = min(((NTOK / 256) * (NPAD / 256) + nblk - 1) / nblk, 31);
      for (int e = tid; e < nunit * 256; e += 512) { pg8::Unit u; const int i = e >> 8;
          if (S.next(i, u)) { const int row = u.pm * 256 + (e & 255); float r;
              if (l == 0) r = rstd0[row];
              else { float sum = 0.f;
#pragma unroll
                  for (int p = 0; p < 16; ++p) sum += ssq[(size_t)p * NTOK + row];
                  r = 1.0f / sqrtf(sum * (1.0f / DM) + EPS); }
              rtab[e] = r; } }
      __syncthreads(); }
    EpiProj E{(bf16*)(P->ws + WS_PROJ), (float*)(P->ws + WS_GATES), rtab, (bf16*)(P->ws + WS_HALO)};
    pg8::gemm_phase<EpiProj, pg8::StaticOrder, true, true>(lds, g, S, E);
}
__device__ __forceinline__ void phase_gemm_out(KP P, int l, int bid, int nblk, LAS unsigned char* lds) {
    pg8::Gemm g{(const bf16*)(P->ws + WS_PROJ), (const bf16*)(P->ws + WS_WOUT) + (size_t)l * DM * DINNER, NTOK, DM, DINNER, PP};
    pg8::StaticOrder S; S.init(NTOK, DM, nblk, bid);
    EpiRes E{(bf16*)((unsigned char*)P->out + DO_HB), (float*)(P->ws + WS_SSQ), (bf16*)(P->ws + WS_PROJ + 4096), (l == DEPTH - 1) ? 1 : 0};
    pg8::gemm_phase<EpiRes, pg8::StaticOrder, false, true>(lds, g, S, E);
}
__device__ __forceinline__ void phase_final(KP P, int bid, int nblk) {
    const int tid = opaque_tid(), lane = tid & 63, wave = tid >> 6;
    const int gw = bid * 8 + wave, ngw = nblk * 8;
    const float* ssq = (const float*)(P->ws + WS_SSQ);
    f32x4v wv[4];
#pragma unroll
    for (int j = 0; j < 4; ++j) wv[j] = *((const f32x4v*)P->final_norm_w + 2 * lane + (j & 1) + 128 * (j >> 1));
    for (int m0 = gw; m0 < NTOK; m0 += 2 * ngw) {
        u32x4v ha[2], hb_[2]; float sp[2];
#pragma unroll
        for (int q = 0; q < 2; ++q) { const int m = m0 + q * ngw; const u32x4v* hr = (const u32x4v*)(P->ws + WS_PROJ + 4096 + (size_t)m * (PP * 2));
            ha[q] = __builtin_nontemporal_load(hr + lane); hb_[q] = __builtin_nontemporal_load(hr + 64 + lane); sp[q] = (lane < 16) ? ssq[(size_t)lane * NTOK + m] : 0.f; }
#pragma unroll
        for (int q = 0; q < 2; ++q) { const int m = m0 + q * ngw;
            const float rs = 1.0f / sqrtf(wave_sum(sp[q]) * (1.0f / DM) + EPS);
            f32x4v* o = (f32x4v*)(P->out + (size_t)m * DM);
            f32x4v v;
            v = (f32x4v){__uint_as_float(ha[q].x << 16), __uint_as_float(ha[q].x & 0xffff0000u), __uint_as_float(ha[q].y << 16), __uint_as_float(ha[q].y & 0xffff0000u)}; o[2 * lane] = v * rs * wv[0];
            v = (f32x4v){__uint_as_float(ha[q].z << 16), __uint_as_float(ha[q].z & 0xffff0000u), __uint_as_float(ha[q].w << 16), __uint_as_float(ha[q].w & 0xffff0000u)}; o[2 * lane + 1] = v * rs * wv[1];
            v = (f32x4v){__uint_as_float(hb_[q].x << 16), __uint_as_float(hb_[q].x & 0xffff0000u), __uint_as_float(hb_[q].y << 16), __uint_as_float(hb_[q].y & 0xffff0000u)}; o[128 + 2 * lane] = v * rs * wv[2];
            v = (f32x4v){__uint_as_float(hb_[q].z << 16), __uint_as_float(hb_[q].z & 0xffff0000u), __uint_as_float(hb_[q].w << 16), __uint_as_float(hb_[q].w & 0xffff0000u)}; o[128 + 2 * lane + 1] = v * rs * wv[3]; }
    }
}
namespace mx {
typedef short bf16x8 __attribute__((ext_vector_type(8)));
typedef float f32x4 __attribute__((ext_vector_type(4)));
constexpr int SEGL = 512, NSEG = SEQ / SEGL, CH = 64, NCH = SEGL / CH;
constexpr int L_QT = 0, L_KT = 17408, L_KTT = 34816, L_VT = 53248, L_PM = 73984, L_ST = 92416, L_VVT = 131584, L_VEC = 150016;
constexpr int V_TOT = 0, V_PRE = 4096, V_POST = 4608, V_MISC = 5120;
constexpr size_t ST_GLA = 0, ST_HGRN = 1048576, ST_ML = 3145728, ST_SSD = 5505024;
constexpr int DS_GLA = 0, DS_HGRN = 8192, DS_ML = 24576, DS_SSD = 25600;

__device__ __forceinline__ int opq(int v) { asm volatile("" : "+v"(v)); return v; }
#define MFMA16(a, b, c) __builtin_amdgcn_mfma_f32_16x16x32_bf16((a), (b), (c), 0, 0, 0)
__device__ __forceinline__ bf16x8 frag(LAS unsigned char* base, int row, int pitch, int ks, int qd) { return *(const LAS bf16x8*)(base + row * pitch + ks * 64 + qd * 16); }
__device__ __forceinline__ int sw64(int row, int byteoff) { return row * 128 + ((((byteoff >> 4) ^ ((row >> 1) & 7)) << 4) | (byteoff & 15)); }
__device__ __forceinline__ bf16x8 frag64(LAS unsigned char* base, int row, int ks, int qd) { return *(const LAS bf16x8*)(base + row * 128 + (((4 * ks + qd) ^ ((row >> 1) & 7)) << 4)); }
template <int PQ> __device__ __forceinline__ int offp(int row, int byteoff) { return PQ == 272 ? row * 272 + byteoff : sw64(row, byteoff); }
template <int PQ> __device__ __forceinline__ bf16x8 fragp(LAS unsigned char* base, int row, int ks, int qd) { return PQ == 272 ? frag(base, row, 272, ks, qd) : frag64(base, row, ks, qd); }
__device__ __forceinline__ unsigned cvtpk(float lo, float hi) { return cvt_pk2(lo, hi); }
__device__ __forceinline__ u32x2v pack4(f32x4 v) { u32x2v w; w.x = cvtpk(v[0], v[1]); w.y = cvtpk(v[2], v[3]); return w; }
__device__ __forceinline__ float lo2f(unsigned w) { return __uint_as_float(w << 16); }
__device__ __forceinline__ float hi2f(unsigned w) { return __uint_as_float(w & 0xffff0000u); }

__device__ __forceinline__ float fexp(float x) { return __builtin_amdgcn_exp2f(x * 1.4426950408889634f); }
__device__ __forceinline__ float flog(float x) { return __builtin_amdgcn_logf(x) * 0.6931471805599453f; }
__device__ __forceinline__ unsigned ldu(const bf16* p) { return __builtin_nontemporal_load((const unsigned*)p); }
__device__ __forceinline__ float frcp(float x) { return __builtin_amdgcn_rcpf(x); }
__device__ __forceinline__ float frsq(float x) { return __builtin_amdgcn_rsqf(x); }
__device__ __forceinline__ float fsigmoid(float x) { return frcp(1.f + fexp(-x)); }
__device__ __forceinline__ float fsilu(float x) { return x * frcp(1.f + fexp(-x)); }
__device__ __forceinline__ float flog1pexp(float nx) { return flog(1.f + fexp(nx)); }
__device__ __forceinline__ float flogsigmoid(float x) { return fminf(x, 0.f) - flog1pexp(-fabsf(x)); }
__device__ __forceinline__ float fsoftplus(float x) { return fmaxf(x, 0.f) + flog1pexp(-fabsf(x)); }

constexpr int FLAG_OFF = 8192, FLAG_SSD = 0, FLAG_ML = 64, FLAG_HG = 192, FLAG_GLA = 320;
__device__ __forceinline__ unsigned* flag_ptr(KP P, int fbase, int idx) { return (unsigned*)(P->ws + WS_CTL) + FLAG_OFF + (fbase + idx) * 16; }
__device__ __forceinline__ void st_wt(bf16* p, u32x2v v) { __hip_atomic_store((unsigned long long*)p, ((unsigned long long)v.y << 32) | v.x, __ATOMIC_RELAXED, __HIP_MEMORY_SCOPE_AGENT); }
__device__ __forceinline__ void st_wt_f(float* p, float v) { __hip_atomic_store(p, v, __ATOMIC_RELAXED, __HIP_MEMORY_SCOPE_AGENT); }
__device__ __forceinline__ void publish_item(unsigned* flag, unsigned epoch) {
    asm volatile("s_waitcnt vmcnt(0)" ::: "memory");
    __syncthreads();
    if (threadIdx.x == 0) __hip_atomic_store(flag, epoch, __ATOMIC_RELAXED, __HIP_MEMORY_SCOPE_AGENT);
}
__device__ __forceinline__ void wait_predecessors(unsigned* flag0, int s, unsigned epoch) {
    {
        if ((int)threadIdx.x < 64) {
            if ((int)threadIdx.x < s) { unsigned spins = 0;
                while (__hip_atomic_load(flag0 + threadIdx.x * 16, __ATOMIC_RELAXED, __HIP_MEMORY_SCOPE_AGENT) < epoch) { __builtin_amdgcn_s_sleep(2); if (++spins > (1u << 22)) break; } }
            __builtin_amdgcn_fence(__ATOMIC_ACQUIRE, "agent");
            asm volatile("s_waitcnt vmcnt(0)" ::: "memory");
        }
    }
    __syncthreads();
}

template <int TYPE, bool OUT, bool DRY = false>
__device__ __forceinline__ void pc_item(KP P, int l, int b, int h, int s, LAS unsigned char* lds) {
    if (!OUT && s == NSEG - 1) return;
    constexpr int DK = (TYPE == 0) ? 64 : 128, NDT = DK / 16, PQ = (DK == 128) ? 272 : 144, NKS = DK / 32;
    const int tid = opaque_tid(), lane = tid & 63, w = __builtin_amdgcn_readfirstlane(tid >> 6), r = lane & 15, qd = lane >> 4;
    const int cp = lane, g = w;
    constexpr int NTK = (TYPE == 0) ? 4 : 8;
    const int ck = (TYPE == 0) ? (lane & 31) : lane, th = (TYPE == 0) ? (lane >> 5) : 0;
    const bool kact = true;
    bf16* proj = (bf16*)(P->ws + WS_PROJ);
    LAS float* vtot = (LAS float*)(lds + L_VEC + V_TOT); LAS float* vpre = (LAS float*)(lds + L_VEC + V_PRE); LAS float* vpost = (LAS float*)(lds + L_VEC + V_POST);
    const int QCOL = (TYPE == 0) ? AQc(h) : CQc(h), KCOL = (TYPE == 0) ? AKc(h) : CFc(h), VCOL = (TYPE == 0) ? AVc(h) : CIc(h), ZCOL = ((TYPE == 0) ? ZA : ZC) + h * 128;
    const float qscale = (TYPE == 0) ? 0.125f : 0.08838834764831845f;
    const int idx = (b * 4 + h) * NSEG + s;
    bf16* stbase = (bf16*)((unsigned char*)P->out + DO_STATE) + ((TYPE == 0) ? ST_GLA : ST_HGRN);
    float* dsbase = (float*)(P->ws + WS_MISC) + ((TYPE == 0) ? DS_GLA : DS_HGRN);
    float lb0 = 0.f, lb1 = 0.f, gb0 = 0.f, gb1 = 0.f, gw0[16], gw1[16];
#pragma unroll
    for (int rr = 0; rr < 16; ++rr) { gw0[rr] = 0.f; gw1[rr] = 0.f; }
    if (kact) {
        if (TYPE == 2) {
#pragma unroll
            for (int c2 = 0; c2 < 2; ++c2) { const int ch = h * 128 + 2 * ck + c2;
                float mx_ = -1e30f; for (int i = 0; i < DEPTH; ++i) mx_ = fmaxf(mx_, P->hg_lb[i * 512 + ch]);
                float den = 0.f, num = 0.f; for (int i = 0; i < DEPTH; ++i) { const float e = fexp(P->hg_lb[i * 512 + ch] - mx_); den += e; if (i >= 1 && i <= l) num += e; }
                if (c2 == 0) lb0 = num / den; else lb1 = num / den; }
        } else {
#pragma unroll
            for (int rr = 0; rr < 16; ++rr) { gw0[rr] = P->gla_gate_w[((size_t)l * 16 + rr) * 256 + h * 64 + 2 * ck]; gw1[rr] = P->gla_gate_w[((size_t)l * 16 + rr) * 256 + h * 64 + 2 * ck + 1]; }
            gb0 = P->gla_gate_b[l * 256 + h * 64 + 2 * ck]; gb1 = P->gla_gate_b[l * 256 + h * 64 + 2 * ck + 1];
        }
    }
    unsigned rq[8], rk[8], rv[8]; f32x4 grv = (f32x4){0.f, 0.f, 0.f, 0.f};
#define PC_LOAD(cc) do { const size_t rw_ = (size_t)b * SEQ + (size_t)s * SEGL + (size_t)(cc) * CH + 8 * g; \
        _Pragma("unroll") for (int jj = 0; jj < 8; ++jj) rv[jj] = ldu(proj + (rw_ + jj) * PP + VCOL + 2 * cp); \
        _Pragma("unroll") for (int jj = 0; jj < NTK; ++jj) { const bf16* pr = proj + (rw_ + NTK * th + jj) * PP; \
            rk[jj] = ldu(pr + KCOL + 2 * ck); rq[jj] = OUT ? ldu(pr + QCOL + 2 * ck) : 0u; } \
        if (TYPE == 0) { if (lane < 32) grv = *(const f32x4*)((const float*)(P->ws + WS_GATES) + (rw_ + (lane >> 2)) * 32 + G_GR + (lane & 3) * 4); } } while (0)
    PC_LOAD(0);
    f32x4 S[NDT];
#pragma unroll
    for (int dt = 0; dt < NDT; ++dt) S[dt] = (f32x4){0.f, 0.f, 0.f, 0.f};
    if (OUT) {
        wait_predecessors(flag_ptr(P, (TYPE == 0) ? FLAG_GLA : FLAG_HG, idx - s), s, (unsigned)l + 1u);
        LAS float* vds = (LAS float*)(lds + L_QT);
        for (int i = tid; i < s * DK; i += 512) vds[i] = dsbase[(size_t)(idx - s) * DK + i];
        __syncthreads();
        for (int sp0 = 0; sp0 < s; sp0 += 4) {
            u32x2v raw[4][NDT];
#pragma unroll
            for (int u = 0; u < 4; ++u) { const int sp = (sp0 + u < s) ? sp0 + u : s - 1; const bf16* sb = stbase + (size_t)(idx - s + sp) * (DK * 128);
#pragma unroll
                for (int dt = 0; dt < NDT; ++dt) raw[u][dt] = *(const u32x2v*)(sb + ((size_t)(w * NDT + dt) * 64 + lane) * 4); }
#pragma unroll
            for (int u = 0; u < 4; ++u) if (sp0 + u < s) {
#pragma unroll
                for (int dt = 0; dt < NDT; ++dt) { const f32x4 d4 = *(const LAS f32x4*)(vds + (sp0 + u) * DK + 16 * dt + 4 * qd);
                    const f32x4 ds = (f32x4){lo2f(raw[u][dt].x), hi2f(raw[u][dt].x), lo2f(raw[u][dt].y), hi2f(raw[u][dt].y)}; S[dt] = S[dt] * d4 + ds; } }
        }
        __syncthreads();
    }
    float gsum0 = 0.f, gsum1 = 0.f;
    const int ei = tid >> 3, ecc = tid & 7;
    float nw[16];
#pragma unroll
    for (int k = 0; k < 16; ++k) nw[k] = OUT ? ((TYPE == 0) ? P->gla_norm_w : P->hg_norm_w)[l * 512 + h * 128 + 16 * ecc + k] : 0.f;

    constexpr int L_OB = L_VVT;
    float lg0[8], lg1[8], kk0[8], kk1[8];
#define PC_A1() do { \
        if (TYPE == 0) { if (lane < 32) *(LAS f32x4*)((LAS float*)(lds + L_VEC + V_MISC) + g * 128 + (lane >> 2) * 16 + (lane & 3) * 4) = grv; } \
        if (kact) { \
            if (TYPE == 2) { \
                _Pragma("unroll") for (int jj = 0; jj < 8; ++jj) { const float f0 = lo2f(rk[jj]), f1 = hi2f(rk[jj]); \
                    const float s0 = fsigmoid(f0), s1 = fsigmoid(f1); \
                    lg0[jj] = flog(fmaxf(lb0 + (1.f - lb0) * s0, 1e-30f)); lg1[jj] = flog(fmaxf(lb1 + (1.f - lb1) * s1, 1e-30f)); \
                    kk0[jj] = (1.f - lb0) * (1.f - s0); kk1[jj] = (1.f - lb1) * (1.f - s1); } \
            } else { \
                LAS float* vgr = (LAS float*)(lds + L_VEC + V_MISC) + g * 128; \
                _Pragma("unroll") for (int jj = 0; jj < NTK; ++jj) { const LAS f32x4* gr4 = (const LAS f32x4*)(vgr + (NTK * th + jj) * 16); float a0 = gb0, a1 = gb1; \
                    _Pragma("unroll") for (int r4 = 0; r4 < 4; ++r4) { const f32x4 x = gr4[r4]; \
                        _Pragma("unroll") for (int e = 0; e < 4; ++e) { a0 += x[e] * gw0[4 * r4 + e]; a1 += x[e] * gw1[4 * r4 + e]; } } \
                    lg0[jj] = flogsigmoid(a0) * (1.0f / 16.0f); lg1[jj] = flogsigmoid(a1) * (1.0f / 16.0f); \
                    kk0[jj] = lo2f(rk[jj]); kk1[jj] = hi2f(rk[jj]); } \
            } \
            _Pragma("unroll") for (int jj = 1; jj < NTK; ++jj) { lg0[jj] += lg0[jj - 1]; lg1[jj] += lg1[jj - 1]; } \
            if (TYPE == 0) { const float o0 = __shfl_xor(lg0[NTK - 1], 32), o1 = __shfl_xor(lg1[NTK - 1], 32);       \
                if (th) { _Pragma("unroll") for (int jj = 0; jj < NTK; ++jj) { lg0[jj] += o0; lg1[jj] += o1; } } \
                else { vtot[g * 128 + 2 * ck] = lg0[NTK - 1] + o0; vtot[g * 128 + 2 * ck + 1] = lg1[NTK - 1] + o1; } } \
            else { vtot[g * 128 + 2 * ck] = lg0[NTK - 1]; vtot[g * 128 + 2 * ck + 1] = lg1[NTK - 1]; } \
        } } while (0)
#define PC_A2(cc) do { \
        if (kact) { \
            float base0 = 0.f, base1 = 0.f, ref0 = 0.f, ref1 = 0.f, end0 = 0.f, end1 = 0.f; \
            _Pragma("unroll") for (int gg = 0; gg < 8; ++gg) { const float t0 = vtot[gg * 128 + 2 * ck], t1 = vtot[gg * 128 + 2 * ck + 1]; \
                if (gg < g) { base0 += t0; base1 += t1; } if (gg < 4) { ref0 += t0; ref1 += t1; } end0 += t0; end1 += t1; } \
            float kt0[8], kt1[8]; \
            _Pragma("unroll") for (int jj = 0; jj < NTK; ++jj) { const float G0 = base0 + lg0[jj], G1 = base1 + lg1[jj]; \
                kt0[jj] = kk0[jj] * fexp(fminf(ref0 - G0, 80.f)); kt1[jj] = kk1[jj] * fexp(fminf(ref1 - G1, 80.f)); \
                if (OUT) { *(LAS unsigned*)(lds + L_QT + offp<PQ>(8 * g + NTK * th + jj, 4 * ck)) = cvtpk(lo2f(rq[jj]) * qscale * fexp(fminf(G0 - ref0, 80.f)), hi2f(rq[jj]) * qscale * fexp(fminf(G1 - ref1, 80.f))); \
                           *(LAS unsigned*)(lds + L_KT + offp<PQ>(8 * g + NTK * th + jj, 4 * ck)) = cvtpk(kt0[jj], kt1[jj]); } } \
            if (TYPE == 0) { u32x2v t2; \
                t2.x = cvtpk(kt0[0], kt0[1]); t2.y = cvtpk(kt0[2], kt0[3]); *(LAS u32x2v*)(lds + L_KTT + sw64(2 * ck, 16 * g + 8 * th)) = t2; \
                t2.x = cvtpk(kt1[0], kt1[1]); t2.y = cvtpk(kt1[2], kt1[3]); *(LAS u32x2v*)(lds + L_KTT + sw64(2 * ck + 1, 16 * g + 8 * th)) = t2; \
            } else { u32x4v t; \
                t.x = cvtpk(kt0[0], kt0[1]); t.y = cvtpk(kt0[2], kt0[3]); t.z = cvtpk(kt0[4], kt0[5]); t.w = cvtpk(kt0[6], kt0[7]); *(LAS u32x4v*)(lds + L_KTT + (2 * ck) * 128 + ((g ^ (ck & 7)) << 4)) = t; \
                t.x = cvtpk(kt1[0], kt1[1]); t.y = cvtpk(kt1[2], kt1[3]); t.z = cvtpk(kt1[4], kt1[5]); t.w = cvtpk(kt1[6], kt1[7]); *(LAS u32x4v*)(lds + L_KTT + (2 * ck + 1) * 128 + ((g ^ (ck & 7)) << 4)) = t; } \
            if (g == 0 && th == 0) { vpre[2 * ck] = fexp(ref0); vpre[2 * ck + 1] = fexp(ref1); vpost[2 * ck] = fexp(end0 - ref0); vpost[2 * ck + 1] = fexp(end1 - ref1); gsum0 += end0; gsum1 += end1; } \
        } \
        { u32x4v t; \
          t.x = (rv[0] & 0xffffu) | (rv[1] << 16); t.y = (rv[2] & 0xffffu) | (rv[3] << 16); t.z = (rv[4] & 0xffffu) | (rv[5] << 16); t.w = (rv[6] & 0xffffu) | (rv[7] << 16); \
          *(LAS u32x4v*)(lds + L_VT + (2 * cp) * 128 + ((g ^ (cp & 7)) << 4)) = t; \
          t.x = (rv[0] >> 16) | (rv[1] & 0xffff0000u); t.y = (rv[2] >> 16) | (rv[3] & 0xffff0000u); t.z = (rv[4] >> 16) | (rv[5] & 0xffff0000u); t.w = (rv[6] >> 16) | (rv[7] & 0xffff0000u); \
          *(LAS u32x4v*)(lds + L_VT + (2 * cp + 1) * 128 + ((g ^ (cp & 7)) << 4)) = t; } \
        if ((cc) + 1 < NCH) PC_LOAD((cc) + 1); } while (0)
    PC_A1();
    __syncthreads();
    PC_A2(0);
    __syncthreads();
    for (int c = 0; c < NCH; ++c) {
        const size_t rowc = (size_t)b * SEQ + (size_t)s * SEGL + (size_t)c * CH;
        bf16* zp = proj + (rowc + ei) * PP + ZCOL + 16 * ecc;
        u32x4v za = (u32x4v){0u, 0u, 0u, 0u}, zb = za;
        if (OUT) { za = *(const u32x4v*)zp; zb = *(const u32x4v*)(zp + 8); }
#pragma unroll
        for (int dt = 0; dt < NDT; ++dt) { const f32x4 p4 = *(const LAS f32x4*)(vpre + 16 * dt + 4 * qd); S[dt] = S[dt] * p4;
            if (OUT) *(LAS u32x2v*)(lds + L_ST + offp<PQ>(16 * w + r, (16 * dt + 4 * qd) * 2)) = pack4(S[dt]); }
        if (OUT) {
            const int it = w & 3;
#pragma unroll
            for (int j2 = 0; j2 < 2; ++j2) { const int jt = 2 * (w >> 2) + j2; f32x4 acc = (f32x4){0.f, 0.f, 0.f, 0.f};
                if (jt <= it) {
#pragma unroll
                    for (int ks = 0; ks < NKS; ++ks) acc = MFMA16(fragp<PQ>(lds + L_KT, 16 * jt + r, ks, qd), fragp<PQ>(lds + L_QT, 16 * it + r, ks, qd), acc);
                    if (jt == it) {
#pragma unroll
                        for (int rg = 0; rg < 4; ++rg) if (4 * qd + rg > r) acc[rg] = 0.f; }
                }
                *(LAS u32x2v*)(lds + L_PM + sw64(16 * it + r, (16 * jt + 4 * qd) * 2)) = pack4(acc); }
            __syncthreads();
        }
        f32x4 o[4];
        if (OUT) {
#pragma unroll
            for (int it = 0; it < 4; ++it) { o[it] = (f32x4){0.f, 0.f, 0.f, 0.f};
#pragma unroll
                for (int ks = 0; ks < 2; ++ks) if (ks == 0 || it >= 2) o[it] = MFMA16(frag64(lds + L_VT, 16 * w + r, ks, qd), frag64(lds + L_PM, 16 * it + r, ks, qd), o[it]);
#pragma unroll
                for (int ks = 0; ks < NKS; ++ks) o[it] = MFMA16(fragp<PQ>(lds + L_ST, 16 * w + r, ks, qd), fragp<PQ>(lds + L_QT, 16 * it + r, ks, qd), o[it]); }
        }
#pragma unroll
        for (int dt = 0; dt < NDT; ++dt) {
#pragma unroll
            for (int ks = 0; ks < 2; ++ks) S[dt] = MFMA16(frag64(lds + L_KTT, 16 * dt + r, ks, qd), frag64(lds + L_VT, 16 * w + r, ks, qd), S[dt]);
            const f32x4 q4 = *(const LAS f32x4*)(vpost + 16 * dt + 4 * qd); S[dt] = S[dt] * q4; }
        if (c + 1 < NCH) PC_A1();
        if (OUT) {
#pragma unroll
            for (int it = 0; it < 4; ++it) *(LAS u32x2v*)(lds + L_OB + (16 * it + r) * 272 + (16 * w + 4 * qd) * 2) = pack4(o[it]);
        }
        __syncthreads();
        if (c + 1 < NCH) PC_A2(c + 1);
        if (OUT) {
            const u32x4v oa = *(const LAS u32x4v*)(lds + L_OB + ei * 272 + ecc * 32), ob = *(const LAS u32x4v*)(lds + L_OB + ei * 272 + ecc * 32 + 16);
            float ov[16] = {lo2f(oa.x), hi2f(oa.x), lo2f(oa.y), hi2f(oa.y), lo2f(oa.z), hi2f(oa.z), lo2f(oa.w), hi2f(oa.w), lo2f(ob.x), hi2f(ob.x), lo2f(ob.y), hi2f(ob.y), lo2f(ob.z), hi2f(ob.z), lo2f(ob.w), hi2f(ob.w)};
            float ss = 0.f;
#pragma unroll
            for (int k = 0; k < 16; ++k) ss += ov[k] * ov[k];
            ss += __shfl_xor(ss, 1); ss += __shfl_xor(ss, 2); ss += __shfl_xor(ss, 4);
            const float rs = frsq(ss * (1.0f / 128.0f) + EPS);
            const float zv[16] = {lo2f(za.x), hi2f(za.x), lo2f(za.y), hi2f(za.y), lo2f(za.z), hi2f(za.z), lo2f(za.w), hi2f(za.w), lo2f(zb.x), hi2f(zb.x), lo2f(zb.y), hi2f(zb.y), lo2f(zb.z), hi2f(zb.z), lo2f(zb.w), hi2f(zb.w)};
            float y[16];
#pragma unroll
            for (int k = 0; k < 16; ++k) y[k] = ov[k] * rs * nw[k] * fsilu(zv[k]);
            u32x4v ya, yb; ya.x = cvtpk(y[0], y[1]); ya.y = cvtpk(y[2], y[3]); ya.z = cvtpk(y[4], y[5]); ya.w = cvtpk(y[6], y[7]); yb.x = cvtpk(y[8], y[9]); yb.y = cvtpk(y[10], y[11]); yb.z = cvtpk(y[12], y[13]); yb.w = cvtpk(y[14], y[15]);
            if (DRY) { asm volatile("" :: "v"(ya.x), "v"(ya.y), "v"(ya.z), "v"(ya.w), "v"(yb.x), "v"(yb.y), "v"(yb.z), "v"(yb.w)); } else { *(u32x4v*)zp = ya; *(u32x4v*)(zp + 8) = yb; }
        }
        __syncthreads();
    }
    if (!OUT) {
        bf16* sb = stbase + (size_t)idx * (DK * 128);
#pragma unroll
        for (int dt = 0; dt < NDT; ++dt) st_wt(sb + ((size_t)(w * NDT + dt) * 64 + lane) * 4, pack4(S[dt]));
        if (g == 0 && th == 0) { st_wt_f(dsbase + (size_t)idx * DK + 2 * ck, fexp(gsum0)); st_wt_f(dsbase + (size_t)idx * DK + 2 * ck + 1, fexp(gsum1)); }
        publish_item(flag_ptr(P, (TYPE == 0) ? FLAG_GLA : FLAG_HG, idx), (unsigned)l + 1u);
    }
    __syncthreads();
#undef PC_LOAD
#undef PC_A1
#undef PC_A2
}

template <int TYPE>
__device__ __forceinline__ void pc_pass1(KP P, int l, int b, int h, int s, LAS unsigned char* lds) {
    if (s == NSEG - 1) return;
    constexpr int DK = (TYPE == 0) ? 64 : 128, NDT = DK / 16;
    const int tid = opaque_tid(), lane = tid & 63, w = __builtin_amdgcn_readfirstlane(tid >> 6), r = lane & 15, qd = lane >> 4;
    const int cp = lane, g = w;
    constexpr int NTK = (TYPE == 0) ? 4 : 8;
    const int ck = (TYPE == 0) ? (lane & 31) : lane, th = (TYPE == 0) ? (lane >> 5) : 0;
    bf16* proj = (bf16*)(P->ws + WS_PROJ);
    const int KCOL = (TYPE == 0) ? AKc(h) : CFc(h), VCOL = (TYPE == 0) ? AVc(h) : CIc(h);
    const int idx = (b * 4 + h) * NSEG + s;
    bf16* stbase = (bf16*)((unsigned char*)P->out + DO_STATE) + ((TYPE == 0) ? ST_GLA : ST_HGRN);
    float* dsbase = (float*)(P->ws + WS_MISC) + ((TYPE == 0) ? DS_GLA : DS_HGRN);
    float lb0 = 0.f, lb1 = 0.f, gb0 = 0.f, gb1 = 0.f, gw0[16], gw1[16];
#pragma unroll
    for (int rr = 0; rr < 16; ++rr) { gw0[rr] = 0.f; gw1[rr] = 0.f; }
    if (TYPE == 2) {
#pragma unroll
        for (int c2 = 0; c2 < 2; ++c2) { const int ch = h * 128 + 2 * ck + c2;
            float mx_ = -1e30f; for (int i = 0; i < DEPTH; ++i) mx_ = fmaxf(mx_, P->hg_lb[i * 512 + ch]);
            float den = 0.f, num = 0.f; for (int i = 0; i < DEPTH; ++i) { const float e = fexp(P->hg_lb[i * 512 + ch] - mx_); den += e; if (i >= 1 && i <= l) num += e; }
            if (c2 == 0) lb0 = num / den; else lb1 = num / den; }
    } else {
#pragma unroll
        for (int rr = 0; rr < 16; ++rr) { gw0[rr] = P->gla_gate_w[((size_t)l * 16 + rr) * 256 + h * 64 + 2 * ck]; gw1[rr] = P->gla_gate_w[((size_t)l * 16 + rr) * 256 + h * 64 + 2 * ck + 1]; }
        gb0 = P->gla_gate_b[l * 256 + h * 64 + 2 * ck]; gb1 = P->gla_gate_b[l * 256 + h * 64 + 2 * ck + 1];
    }
    f32x4 S[NDT];
#pragma unroll
    for (int dt = 0; dt < NDT; ++dt) S[dt] = (f32x4){0.f, 0.f, 0.f, 0.f};
    float gsum0 = 0.f, gsum1 = 0.f;
#define P1_KTT(par) ((par) ? L_ST : L_KTT)
#define P1_VT(par) ((par) ? L_ST + 16384 : L_VT)
#define P1_TOT(par) ((LAS float*)(lds + ((par) ? L_QT : L_VEC + V_TOT)))
#define P1_PRE(par) ((LAS float*)(lds + ((par) ? L_QT + 4096 : L_VEC + V_PRE)))
#define P1_POST(par) ((LAS float*)(lds + ((par) ? L_QT + 4608 : L_VEC + V_POST)))
    unsigned rk[8], rv[2][8]; f32x4 grv = (f32x4){0.f, 0.f, 0.f, 0.f};
    float lg0[8], lg1[8], kk0[8], kk1[8];
#define P1_LOAD(cc, par) do { const size_t rw_ = (size_t)b * SEQ + (size_t)s * SEGL + (size_t)(cc) * CH + 8 * g; \
        _Pragma("unroll") for (int jj = 0; jj < 8; ++jj) rv[par][jj] = ldu(proj + (rw_ + jj) * PP + VCOL + 2 * cp); \
        _Pragma("unroll") for (int jj = 0; jj < NTK; ++jj) rk[jj] = ldu(proj + (rw_ + NTK * th + jj) * PP + KCOL + 2 * ck); \
        if (TYPE == 0) { if (lane < 32) grv = *(const f32x4*)((const float*)(P->ws + WS_GATES) + (rw_ + (lane >> 2)) * 32 + G_GR + (lane & 3) * 4); } } while (0)
#define P1_A1(par) do { LAS float* vtot_ = P1_TOT(par); \
        if (TYPE == 0) { if (lane < 32) *(LAS f32x4*)((LAS float*)(lds + L_VEC + V_MISC) + g * 128 + (lane >> 2) * 16 + (lane & 3) * 4) = grv; } \
        if (TYPE == 2) { \
            _Pragma("unroll") for (int jj = 0; jj < 8; ++jj) { const float f0 = lo2f(rk[jj]), f1 = hi2f(rk[jj]); \
                const float s0 = fsigmoid(f0), s1 = fsigmoid(f1); \
                lg0[jj] = flog(fmaxf(lb0 + (1.f - lb0) * s0, 1e-30f)); lg1[jj] = flog(fmaxf(lb1 + (1.f - lb1) * s1, 1e-30f)); \
                kk0[jj] = (1.f - lb0) * (1.f - s0); kk1[jj] = (1.f - lb1) * (1.f - s1); } \
        } else { \
            LAS float* vgr = (LAS float*)(lds + L_VEC + V_MISC) + g * 128; \
            _Pragma("unroll") for (int jj = 0; jj < NTK; ++jj) { const LAS f32x4* gr4 = (const LAS f32x4*)(vgr + (NTK * th + jj) * 16); float a0 = gb0, a1 = gb1; \
                _Pragma("unroll") for (int r4 = 0; r4 < 4; ++r4) { const f32x4 x = gr4[r4]; \
                    _Pragma("unroll") for (int e = 0; e < 4; ++e) { a0 += x[e] * gw0[4 * r4 + e]; a1 += x[e] * gw1[4 * r4 + e]; } } \
                lg0[jj] = flogsigmoid(a0) * (1.0f / 16.0f); lg1[jj] = flogsigmoid(a1) * (1.0f / 16.0f); \
                kk0[jj] = lo2f(rk[jj]); kk1[jj] = hi2f(rk[jj]); } \
        } \
        _Pragma("unroll") for (int jj = 1; jj < NTK; ++jj) { lg0[jj] += lg0[jj - 1]; lg1[jj] += lg1[jj - 1]; } \
        if (TYPE == 0) { const float o0 = __shfl_xor(lg0[NTK - 1], 32), o1 = __shfl_xor(lg1[NTK - 1], 32); \
            if (th) { _Pragma("unroll") for (int jj = 0; jj < NTK; ++jj) { lg0[jj] += o0; lg1[jj] += o1; } } \
            else { vtot_[g * 128 + 2 * ck] = lg0[NTK - 1] + o0; vtot_[g * 128 + 2 * ck + 1] = lg1[NTK - 1] + o1; } } \
        else { vtot_[g * 128 + 2 * ck] = lg0[NTK - 1]; vtot_[g * 128 + 2 * ck + 1] = lg1[NTK - 1]; } } while (0)
#define P1_A2(par) do { const LAS float* vtot_ = P1_TOT(par); \
        float base0 = 0.f, base1 = 0.f, ref0 = 0.f, ref1 = 0.f, end0 = 0.f, end1 = 0.f; \
        _Pragma("unroll") for (int gg = 0; gg < 8; ++gg) { const float t0 = vtot_[gg * 128 + 2 * ck], t1 = vtot_[gg * 128 + 2 * ck + 1]; \
            if (gg < g) { base0 += t0; base1 += t1; } if (gg < 4) { ref0 += t0; ref1 += t1; } end0 += t0; end1 += t1; } \
        float kt0[8], kt1[8]; \
        _Pragma("unroll") for (int jj = 0; jj < NTK; ++jj) { const float G0 = base0 + lg0[jj], G1 = base1 + lg1[jj]; \
            kt0[jj] = kk0[jj] * fexp(fminf(ref0 - G0, 80.f)); kt1[jj] = kk1[jj] * fexp(fminf(ref1 - G1, 80.f)); } \
        if (TYPE == 0) { u32x2v t2; \
            t2.x = cvtpk(kt0[0], kt0[1]); t2.y = cvtpk(kt0[2], kt0[3]); *(LAS u32x2v*)(lds + P1_KTT(par) + sw64(2 * ck, 16 * g + 8 * th)) = t2; \
            t2.x = cvtpk(kt1[0], kt1[1]); t2.y = cvtpk(kt1[2], kt1[3]); *(LAS u32x2v*)(lds + P1_KTT(par) + sw64(2 * ck + 1, 16 * g + 8 * th)) = t2; \
        } else { u32x4v t; \
            t.x = cvtpk(kt0[0], kt0[1]); t.y = cvtpk(kt0[2], kt0[3]); t.z = cvtpk(kt0[4], kt0[5]); t.w = cvtpk(kt0[6], kt0[7]); *(LAS u32x4v*)(lds + P1_KTT(par) + (2 * ck) * 128 + ((g ^ (ck & 7)) << 4)) = t; \
            t.x = cvtpk(kt1[0], kt1[1]); t.y = cvtpk(kt1[2], kt1[3]); t.z = cvtpk(kt1[4], kt1[5]); t.w = cvtpk(kt1[6], kt1[7]); *(LAS u32x4v*)(lds + P1_KTT(par) + (2 * ck + 1) * 128 + ((g ^ (ck & 7)) << 4)) = t; } \
        if (g == 0 && th == 0) { LAS float* vpre_ = P1_PRE(par); LAS float* vpost_ = P1_POST(par); \
            vpre_[2 * ck] = fexp(ref0); vpre_[2 * ck + 1] = fexp(ref1); vpost_[2 * ck] = fexp(end0 - ref0); vpost_[2 * ck + 1] = fexp(end1 - ref1); gsum0 += end0; gsum1 += end1; } \
        { u32x4v t; \
          t.x = (rv[par][0] & 0xffffu) | (rv[par][1] << 16); t.y = (rv[par][2] & 0xffffu) | (rv[par][3] << 16); t.z = (rv[par][4] & 0xffffu) | (rv[par][5] << 16); t.w = (rv[par][6] & 0xffffu) | (rv[par][7] << 16); \
          *(LAS u32x4v*)(lds + P1_VT(par) + (2 * cp) * 128 + ((g ^ (cp & 7)) << 4)) = t; \
          t.x = (rv[par][0] >> 16) | (rv[par][1] & 0xffff0000u); t.y = (rv[par][2] >> 16) | (rv[par][3] & 0xffff0000u); t.z = (rv[par][4] >> 16) | (rv[par][5] & 0xffff0000u); t.w = (rv[par][6] >> 16) | (rv[par][7] & 0xffff0000u); \
          *(LAS u32x4v*)(lds + P1_VT(par) + (2 * cp + 1) * 128 + ((g ^ (cp & 7)) << 4)) = t; } } while (0)
#define P1_E(par) do { const LAS float* vpre_ = P1_PRE(par); const LAS float* vpost_ = P1_POST(par); \
        _Pragma("unroll") for (int dt = 0; dt < NDT; ++dt) { const f32x4 p4 = *(const LAS f32x4*)(vpre_ + 16 * dt + 4 * qd); S[dt] = S[dt] * p4; } \
        _Pragma("unroll") for (int dt = 0; dt < NDT; ++dt) { \
            _Pragma("unroll") for (int ks = 0; ks < 2; ++ks) S[dt] = MFMA16(frag64(lds + P1_KTT(par), 16 * dt + r, ks, qd), frag64(lds + P1_VT(par), 16 * w + r, ks, qd), S[dt]); \
            const f32x4 q4 = *(const LAS f32x4*)(vpost_ + 16 * dt + 4 * qd); S[dt] = S[dt] * q4; } } while (0)
    P1_LOAD(0, 0);
    P1_A1(0);
    P1_LOAD(1, 1);
    __syncthreads();
    P1_A2(0);
    P1_A1(1);
    P1_LOAD(2, 0);
    __syncthreads();
    for (int c = 0; c < NCH; c += 2) {
        P1_E(0);
        P1_A2(1);
        if (c + 2 < NCH) P1_A1(0);
        if (c + 3 < NCH) P1_LOAD(c + 3, 1);
        __syncthreads();
        P1_E(1);
        if (c + 2 < NCH) P1_A2(0);
        if (c + 3 < NCH) P1_A1(1);
        if (c + 4 < NCH) P1_LOAD(c + 4, 0);
        __syncthreads();
    }
    {
        bf16* sb = stbase + (size_t)idx * (DK * 128);
#pragma unroll
        for (int dt = 0; dt < NDT; ++dt) st_wt(sb + ((size_t)(w * NDT + dt) * 64 + lane) * 4, pack4(S[dt]));
        if (g == 0 && th == 0) { st_wt_f(dsbase + (size_t)idx * DK + 2 * ck, fexp(gsum0)); st_wt_f(dsbase + (size_t)idx * DK + 2 * ck + 1, fexp(gsum1)); }
        publish_item(flag_ptr(P, (TYPE == 0) ? FLAG_GLA : FLAG_HG, idx), (unsigned)l + 1u);
    }
    __syncthreads();
#undef P1_KTT
#undef P1_VT
#undef P1_TOT
#undef P1_PRE
#undef P1_POST
#undef P1_LOAD
#undef P1_A1
#undef P1_A2
#undef P1_E
}

template <bool OUT, bool DRY = false>
__device__ __forceinline__ void ml_item(KP P, int l, int b, int h, int s, LAS unsigned char* lds) {
    if (!OUT && s == NSEG - 1) return;
    constexpr int PQ = 272;
    const int tid = opaque_tid(), lane = tid & 63, w = __builtin_amdgcn_readfirstlane(tid >> 6), r = lane & 15, qd = lane >> 4;
    const int cp = lane, g = w;
    bf16* proj = (bf16*)(P->ws + WS_PROJ); const float* gts = (const float*)(P->ws + WS_GATES);
    LAS float* vg = (LAS float*)(lds + L_VEC + V_TOT);
    LAS float* vemr = (LAS float*)(lds + L_VEC + V_MISC);
    LAS float* vden = vemr + 64;
    const int idx = (b * 4 + h) * NSEG + s;
    bf16* stbase = (bf16*)((unsigned char*)P->out + DO_STATE) + ST_ML;
    float* dsbase = (float*)(P->ws + WS_MISC) + DS_ML;
    float wq[4][2], wk[4][2], bq[2], bk[2];
#pragma unroll
    for (int c2 = 0; c2 < 2; ++c2) { const int ch = h * 128 + 2 * cp + c2;
#pragma unroll
        for (int kk = 0; kk < 4; ++kk) { wq[kk][c2] = P->ml_conv_w[((size_t)l * 4 + kk) * 1024 + ch]; wk[kk][c2] = P->ml_conv_w[((size_t)l * 4 + kk) * 1024 + 512 + ch]; }
        bq[c2] = P->ml_conv_b[l * 1024 + ch]; bk[c2] = P->ml_conv_b[l * 1024 + 512 + ch]; }
    const float ib = P->ml_i_b[l * 4 + h], fb = P->ml_f_b[l * 4 + h];
    unsigned rq[11], rk[11], rv[8]; float gpre = 0.f;
#define ML_LOAD(cc) do { const size_t rw_ = (size_t)b * SEQ + (size_t)s * SEGL + (size_t)(cc) * CH + 8 * g; const int ts_ = s * SEGL + (cc) * CH + 8 * g; \
        _Pragma("unroll") for (int jj = 0; jj < 11; ++jj) { const bool ok = (ts_ + jj - 3) >= 0; const bf16* pr = proj + (rw_ + jj - 3) * PP; \
            rk[jj] = ok ? ldu(pr + BKc(h) + 2 * cp) : 0u; rq[jj] = (ok && OUT) ? ldu(pr + BQc(h) + 2 * cp) : 0u; } \
        _Pragma("unroll") for (int jj = 0; jj < 8; ++jj) rv[jj] = ldu(proj + (rw_ + jj) * PP + BVc(h) + 2 * cp); \
        if (lane < 16) gpre = gts[(rw_ + (lane >> 1)) * 32 + ((lane & 1) ? G_BF : G_BI) + h]; } while (0)
    ML_LOAD(0);
    f32x4 S[8], Sx = (f32x4){0.f, 0.f, 0.f, 0.f};
#pragma unroll
    for (int dt = 0; dt < 8; ++dt) S[dt] = (f32x4){0.f, 0.f, 0.f, 0.f};
    float m = 0.f, bsum = 0.f;
    if (OUT) {
        wait_predecessors(flag_ptr(P, FLAG_ML, idx - s), s, (unsigned)l + 1u);
        LAS float* vds = (LAS float*)(lds + L_QT);
        for (int i = tid; i < s * 4; i += 512) vds[i] = dsbase[(size_t)(idx - s) * 4 + i];
        __syncthreads();
        for (int sp0 = 0; sp0 < s; sp0 += 4) {
            u32x2v raw[4][9];
#pragma unroll
            for (int u = 0; u < 4; ++u) { const int sp = (sp0 + u < s) ? sp0 + u : s - 1; const bf16* sb = stbase + (size_t)(idx - s + sp) * 18432;
#pragma unroll
                for (int dt = 0; dt < 9; ++dt) raw[u][dt] = *(const u32x2v*)(sb + ((size_t)(w * 9 + dt) * 64 + lane) * 4); }
#pragma unroll
            for (int u = 0; u < 4; ++u) if (sp0 + u < s) {
                const float ml_ = vds[(sp0 + u) * 4], bs = vds[(sp0 + u) * 4 + 1];
                const float mn = fmaxf(bs + m, ml_), f1 = fexp(bs + m - mn), f2 = fexp(ml_ - mn); m = mn;
#pragma unroll
                for (int dt = 0; dt < 9; ++dt) { const f32x4 ds = (f32x4){lo2f(raw[u][dt].x), hi2f(raw[u][dt].x), lo2f(raw[u][dt].y), hi2f(raw[u][dt].y)};
                    if (dt < 8) S[dt] = S[dt] * f1 + ds * f2; else Sx = Sx * f1 + ds * f2; } }
        }
        __syncthreads();
    }
    if (tid < 128) { const int rr = tid >> 3, ck = tid & 7; const unsigned one2 = (rr == 0) ? 0x3f803f80u : 0u; u32x4v t; t.x = one2; t.y = one2; t.z = one2; t.w = one2; *(LAS u32x4v*)(lds + L_VT + (128 + rr) * 128 + 16 * ck) = t; }
    const int ei = tid >> 3, ecc = tid & 7;
    float nw[16];
#pragma unroll
    for (int k = 0; k < 16; ++k) nw[k] = OUT ? P->ml_norm_w[l * 512 + h * 128 + 16 * ecc + k] : 0.f;

    for (int c = 0; c < NCH; ++c) {
        const size_t rowc = (size_t)b * SEQ + (size_t)s * SEGL + (size_t)c * CH;
        float ig[8], bl[8];
        const float gval = (lane & 1) ? flogsigmoid(gpre + fb) : gpre + ib;
#pragma unroll
        for (int jj = 0; jj < 8; ++jj) { ig[jj] = __int_as_float(__builtin_amdgcn_readlane(__float_as_int(gval), 2 * jj)); bl[jj] = __int_as_float(__builtin_amdgcn_readlane(__float_as_int(gval), 2 * jj + 1)); }
#pragma unroll
        for (int jj = 1; jj < 8; ++jj) bl[jj] += bl[jj - 1];
        float lpm[8];
        lpm[0] = ig[0] - bl[0];
#pragma unroll
        for (int jj = 1; jj < 8; ++jj) lpm[jj] = fmaxf(lpm[jj - 1], ig[jj] - bl[jj]);
        if (lane == 0) { vg[g] = bl[7]; vg[8 + g] = lpm[7]; }
        __syncthreads();
        float base = 0.f, cmprev = -1e30f, blast = 0.f, M = m;
#pragma unroll
        for (int gg = 0; gg < 8; ++gg) { const float t = vg[gg], lm = vg[8 + gg]; const float ag = lm - blast;
            if (gg < g) cmprev = fmaxf(cmprev, ag); M = fmaxf(M, ag); if (gg < g) base += t; blast += t; }
        float kt0[8], kt1[8];
#pragma unroll
        for (int jj = 0; jj < 8; ++jj) {
            const float bj = base + bl[jj]; const float cmj = fmaxf(cmprev, lpm[jj] - base); const float mu = fmaxf(cmj, m);
            const float ek = fexp(ig[jj] - bj - M), eq = fexp(M - mu);
            float yk0 = bk[0], yk1 = bk[1], yq0 = bq[0], yq1 = bq[1];
#pragma unroll
            for (int kk = 0; kk < 4; ++kk) { yk0 += wk[kk][0] * lo2f(rk[jj + kk]); yk1 += wk[kk][1] * hi2f(rk[jj + kk]); yq0 += wq[kk][0] * lo2f(rq[jj + kk]); yq1 += wq[kk][1] * hi2f(rq[jj + kk]); }
            kt0[jj] = fsilu(yk0) * 0.08838834764831845f * ek; kt1[jj] = fsilu(yk1) * 0.08838834764831845f * ek;
            if (OUT) { *(LAS unsigned*)(lds + L_QT + (8 * g + jj) * PQ + 4 * cp) = cvtpk(fsilu(yq0) * eq, fsilu(yq1) * eq);
                       *(LAS unsigned*)(lds + L_KT + (8 * g + jj) * PQ + 4 * cp) = cvtpk(kt0[jj], kt1[jj]);
                       if (lane == 0) vemr[8 * g + jj] = fexp(-bj - mu); } }
        { u32x4v t;
          t.x = cvtpk(kt0[0], kt0[1]); t.y = cvtpk(kt0[2], kt0[3]); t.z = cvtpk(kt0[4], kt0[5]); t.w = cvtpk(kt0[6], kt0[7]); *(LAS u32x4v*)(lds + L_KTT + (2 * cp) * 128 + ((g ^ (cp & 7)) << 4)) = t;
          t.x = cvtpk(kt1[0], kt1[1]); t.y = cvtpk(kt1[2], kt1[3]); t.z = cvtpk(kt1[4], kt1[5]); t.w = cvtpk(kt1[6], kt1[7]); *(LAS u32x4v*)(lds + L_KTT + (2 * cp + 1) * 128 + ((g ^ (cp & 7)) << 4)) = t;
          t.x = (rv[0] & 0xffffu) | (rv[1] << 16); t.y = (rv[2] & 0xffffu) | (rv[3] << 16); t.z = (rv[4] & 0xffffu) | (rv[5] << 16); t.w = (rv[6] & 0xffffu) | (rv[7] << 16);
          *(LAS u32x4v*)(lds + L_VT + (2 * cp) * 128 + ((g ^ (cp & 7)) << 4)) = t;
          t.x = (rv[0] >> 16) | (rv[1] & 0xffff0000u); t.y = (rv[2] >> 16) | (rv[3] & 0xffff0000u); t.z = (rv[4] >> 16) | (rv[5] & 0xffff0000u); t.w = (rv[6] >> 16) | (rv[7] & 0xffff0000u);
          *(LAS u32x4v*)(lds + L_VT + (2 * cp + 1) * 128 + ((g ^ (cp & 7)) << 4)) = t; }
        const float pre = fexp(m - M);
        m = blast + M; bsum += blast;
        if (c + 1 < NCH) ML_LOAD(c + 1);
        __syncthreads();
        bf16* zp = proj + (rowc + ei) * PP + ZB + h * 128 + 16 * ecc; const bf16* gp = proj + (rowc + ei) * PP + BOc(h) + 16 * ecc;
        u32x4v za = (u32x4v){0u, 0u, 0u, 0u}, zb = za, ga = za, gb_ = za;
        if (OUT) { za = *(const u32x4v*)zp; zb = *(const u32x4v*)(zp + 8); ga = *(const u32x4v*)gp; gb_ = *(const u32x4v*)(gp + 8); }
#pragma unroll
        for (int dt = 0; dt < 8; ++dt) { S[dt] = S[dt] * pre; if (OUT) *(LAS u32x2v*)(lds + L_ST + (16 * w + r) * PQ + (16 * dt + 4 * qd) * 2) = pack4(S[dt]); }
        Sx = Sx * pre; if (OUT) *(LAS u32x2v*)(lds + L_ST + (128 + r) * PQ + (16 * w + 4 * qd) * 2) = pack4(Sx);
        if (OUT) {
            const int it = w & 3;
#pragma unroll
            for (int j2 = 0; j2 < 2; ++j2) { const int jt = 2 * (w >> 2) + j2; f32x4 acc = (f32x4){0.f, 0.f, 0.f, 0.f};
                if (jt <= it) {
#pragma unroll
                    for (int ks = 0; ks < 4; ++ks) acc = MFMA16(frag(lds + L_KT, 16 * jt + r, PQ, ks, qd), frag(lds + L_QT, 16 * it + r, PQ, ks, qd), acc);
                    if (jt == it) {
#pragma unroll
                        for (int rg = 0; rg < 4; ++rg) if (4 * qd + rg > r) acc[rg] = 0.f; }
                }
                *(LAS u32x2v*)(lds + L_PM + sw64(16 * it + r, (16 * jt + 4 * qd) * 2)) = pack4(acc); }
            __syncthreads();
        }
        f32x4 o[4], ox = (f32x4){0.f, 0.f, 0.f, 0.f};
        if (OUT) {
#pragma unroll
            for (int it = 0; it < 4; ++it) { o[it] = (f32x4){0.f, 0.f, 0.f, 0.f};
#pragma unroll
                for (int ks = 0; ks < 2; ++ks) if (ks == 0 || it >= 2) o[it] = MFMA16(frag64(lds + L_VT, 16 * w + r, ks, qd), frag64(lds + L_PM, 16 * it + r, ks, qd), o[it]);
#pragma unroll
                for (int ks = 0; ks < 4; ++ks) o[it] = MFMA16(frag(lds + L_ST, 16 * w + r, PQ, ks, qd), frag(lds + L_QT, 16 * it + r, PQ, ks, qd), o[it]); }
            const int itx = w & 3;
#pragma unroll
            for (int ks = 0; ks < 2; ++ks) ox = MFMA16(frag64(lds + L_VT, 128 + r, ks, qd), frag64(lds + L_PM, 16 * itx + r, ks, qd), ox);
#pragma unroll
            for (int ks = 0; ks < 4; ++ks) ox = MFMA16(frag(lds + L_ST, 128 + r, PQ, ks, qd), frag(lds + L_QT, 16 * itx + r, PQ, ks, qd), ox);
            if (w < 4 && qd == 0) vden[16 * itx + r] = ox[0];
        }
#pragma unroll
        for (int dt = 0; dt < 8; ++dt)
#pragma unroll
            for (int ks = 0; ks < 2; ++ks) S[dt] = MFMA16(frag64(lds + L_KTT, 16 * dt + r, ks, qd), frag64(lds + L_VT, 16 * w + r, ks, qd), S[dt]);
#pragma unroll
        for (int ks = 0; ks < 2; ++ks) Sx = MFMA16(frag64(lds + L_KTT, 16 * w + r, ks, qd), frag64(lds + L_VT, 128 + r, ks, qd), Sx);
        if (OUT) {
#pragma unroll
            for (int it = 0; it < 4; ++it) *(LAS u32x2v*)(lds + L_KT + (16 * it + r) * 272 + (16 * w + 4 * qd) * 2) = pack4(o[it]);
            __syncthreads();
            const u32x4v oa = *(const LAS u32x4v*)(lds + L_KT + ei * 272 + ecc * 32), ob = *(const LAS u32x4v*)(lds + L_KT + ei * 272 + ecc * 32 + 16);
            float ov[16] = {lo2f(oa.x), hi2f(oa.x), lo2f(oa.y), hi2f(oa.y), lo2f(oa.z), hi2f(oa.z), lo2f(oa.w), hi2f(oa.w), lo2f(ob.x), hi2f(ob.x), lo2f(ob.y), hi2f(ob.y), lo2f(ob.z), hi2f(ob.z), lo2f(ob.w), hi2f(ob.w)};
            const float dinv = frcp(fmaxf(fabsf(vden[ei]), vemr[ei]));
            const float zv[16] = {lo2f(za.x), hi2f(za.x), lo2f(za.y), hi2f(za.y), lo2f(za.z), hi2f(za.z), lo2f(za.w), hi2f(za.w), lo2f(zb.x), hi2f(zb.x), lo2f(zb.y), hi2f(zb.y), lo2f(zb.z), hi2f(zb.z), lo2f(zb.w), hi2f(zb.w)};
            const float gv[16] = {lo2f(ga.x), hi2f(ga.x), lo2f(ga.y), hi2f(ga.y), lo2f(ga.z), hi2f(ga.z), lo2f(ga.w), hi2f(ga.w), lo2f(gb_.x), hi2f(gb_.x), lo2f(gb_.y), hi2f(gb_.y), lo2f(gb_.z), hi2f(gb_.z), lo2f(gb_.w), hi2f(gb_.w)};
            float ss = 0.f;
#pragma unroll
            for (int k = 0; k < 16; ++k) { ov[k] = ov[k] * dinv * fsigmoid(gv[k]); ss += ov[k] * ov[k]; }
            ss += __shfl_xor(ss, 1); ss += __shfl_xor(ss, 2); ss += __shfl_xor(ss, 4);
            const float rs = frsq(ss * (1.0f / 128.0f) + EPS);
            float y[16];
#pragma unroll
            for (int k = 0; k < 16; ++k) y[k] = ov[k] * rs * nw[k] * fsilu(zv[k]);
            u32x4v ya, yb; ya.x = cvtpk(y[0], y[1]); ya.y = cvtpk(y[2], y[3]); ya.z = cvtpk(y[4], y[5]); ya.w = cvtpk(y[6], y[7]); yb.x = cvtpk(y[8], y[9]); yb.y = cvtpk(y[10], y[11]); yb.z = cvtpk(y[12], y[13]); yb.w = cvtpk(y[14], y[15]);
            if (DRY) { asm volatile("" :: "v"(ya.x), "v"(ya.y), "v"(ya.z), "v"(ya.w), "v"(yb.x), "v"(yb.y), "v"(yb.z), "v"(yb.w)); } else { *(u32x4v*)zp = ya; *(u32x4v*)(zp + 8) = yb; }
        }
    }
    if (!OUT) {
        bf16* sb = stbase + (size_t)idx * 18432;
#pragma unroll
        for (int dt = 0; dt < 8; ++dt) st_wt(sb + ((size_t)(w * 9 + dt) * 64 + lane) * 4, pack4(S[dt]));
        st_wt(sb + ((size_t)(w * 9 + 8) * 64 + lane) * 4, pack4(Sx));
        if (tid == 0) { st_wt_f(dsbase + (size_t)idx * 4, m); st_wt_f(dsbase + (size_t)idx * 4 + 1, bsum); }
        publish_item(flag_ptr(P, FLAG_ML, idx), (unsigned)l + 1u);
    }
    __syncthreads();
#undef ML_LOAD
}

template <bool OUT, bool DRY = false>
__device__ __forceinline__ void ssd_item(KP P, int l, int b, int gq, int s, LAS unsigned char* lds) {
    constexpr int PQ = 272;
    const int tid = opaque_tid(), lane = tid & 63, w = __builtin_amdgcn_readfirstlane(tid >> 6);
    const int g = w, hsub = lane >> 5;
    bf16* proj = (bf16*)(P->ws + WS_PROJ); const float* gts = (const float*)(P->ws + WS_GATES);
    LAS float* vg = (LAS float*)(lds + L_VEC + V_TOT);
    LAS float* vaend = vg + 32;
    LAS float* vacs = (LAS float*)(lds + L_VEC + 256);
    LAS float* veacs = vacs + 256;
    LAS float* vdti = veacs + 256;
    LAS float* vcw = (LAS float*)(lds + L_VEC + 3328);
    const int idx = (b * 2 + gq) * NSEG + s;
    bf16* stbase = (bf16*)((unsigned char*)P->out + DO_STATE) + ST_SSD;
    float* dsbase = (float*)(P->ws + WS_MISC) + DS_SSD;
    { const int cp = lane; (void)cp; const int ch = tid;
      const int src = (ch < 128) ? 512 + gq * 128 + ch : (ch < 256) ? 768 + gq * 128 + (ch - 128) : gq * 256 + (ch - 256);
#pragma unroll
      for (int kk = 0; kk < 4; ++kk) vcw[ch * 5 + kk] = P->ssd_conv_w[((size_t)l * 4 + kk) * 1024 + src];
      vcw[ch * 5 + 4] = P->ssd_conv_b[l * 1024 + src]; }
    const int qd0 = lane >> 4, r0 = lane & 15; (void)qd0; (void)r0;
    float dtb[2], An[2], iAn[2];
#pragma unroll
    for (int k = 0; k < 2; ++k) { const int hh = gq * 4 + 2 * k + hsub; dtb[k] = P->ssd_dt_bias[l * 8 + hh]; An[k] = -fexp(P->ssd_A_log[l * 8 + hh]); iAn[k] = 1.0f / An[k]; }
    const float dtb_l = P->ssd_dt_bias[l * 8 + gq * 4 + (lane & 3)], An_l = -fexp(P->ssd_A_log[l * 8 + gq * 4 + (lane & 3)]);
    const int hw0 = (w >> 2), hw1 = 2 + (w >> 2);
    const float Dh[2][2] = {{P->ssd_D[l * 8 + gq * 4 + 0], P->ssd_D[l * 8 + gq * 4 + 1]}, {P->ssd_D[l * 8 + gq * 4 + 2], P->ssd_D[l * 8 + gq * 4 + 3]}};
    f32x4 S[2][8];
#pragma unroll
    for (int R = 0; R < 2; ++R)
#pragma unroll
        for (int dt = 0; dt < 8; ++dt) S[R][dt] = (f32x4){0.f, 0.f, 0.f, 0.f};
    if (OUT) {
        wait_predecessors(flag_ptr(P, FLAG_SSD, idx - s), s, (unsigned)l + 1u);
        LAS float* vds = (LAS float*)(lds + L_QT);
        for (int i = tid; i < s * 4; i += 512) vds[i] = dsbase[(size_t)(idx - s) * 4 + i];
        __syncthreads();
        for (int sp0 = 0; sp0 < s; sp0 += 2) {
            u32x2v raw[2][16];
#pragma unroll
            for (int u = 0; u < 2; ++u) { const int sp = (sp0 + u < s) ? sp0 + u : s - 1; const bf16* sb = stbase + (size_t)(idx - s + sp) * 32768;
#pragma unroll
                for (int t = 0; t < 16; ++t) raw[u][t] = *(const u32x2v*)(sb + ((size_t)(w * 16 + t) * 64 + lane) * 4); }
#pragma unroll
            for (int u = 0; u < 2; ++u) if (sp0 + u < s) {
                const float f0 = fexp(vds[(sp0 + u) * 4 + hw0]), f1 = fexp(vds[(sp0 + u) * 4 + hw1]);
#pragma unroll
                for (int R = 0; R < 2; ++R)
#pragma unroll
                    for (int dt = 0; dt < 8; ++dt) { const u32x2v rw = raw[u][R * 8 + dt];
                        const f32x4 ds = (f32x4){lo2f(rw.x), hi2f(rw.x), lo2f(rw.y), hi2f(rw.y)}; S[R][dt] = S[R][dt] * (R == 0 ? f0 : f1) + ds; } }
        }
        __syncthreads();
    }
    float asum[2] = {0.f, 0.f};

    unsigned rC[11], rB[11], rx[2][11]; float gdt = 0.f;
    const bf16* halo = (const bf16*)(P->ws + WS_HALO);
    LAS unsigned* hxch = (LAS unsigned*)(lds + L_ST);
#define SSD_LOAD(cc) do { const int cl_ = opq(lane); const size_t rw_ = (size_t)b * SEQ + (size_t)s * SEGL + (size_t)(cc) * CH + 8 * g; \
        if (OUT) { \
            _Pragma("unroll") for (int jj = 0; jj < 8; ++jj) { const bf16* pr = proj + (rw_ + jj) * PP; \
                rB[jj] = ldu(pr + DBc(gq) + 2 * cl_); rC[jj] = ldu(pr + DCc(gq) + 2 * cl_); \
                rx[0][jj] = ldu(pr + DXc(gq) + 2 * cl_); rx[1][jj] = ldu(pr + DXc(gq) + 128 + 2 * cl_); } \
        } else { \
            _Pragma("unroll") for (int jj = 0; jj < 11; ++jj) { \
                if (jj < 3 && g == 0) {       \
                    if ((cc) == 0) { const bool ok = s > 0; const bf16* hr = halo + ((size_t)((b * NSEG + s - 1) * 3 + jj)) * 1024; \
                        rB[jj] = ok ? ldu(hr + (DBc(gq) - DSSD) + 2 * cl_) : 0u; rC[jj] = ok ? ldu(hr + (DCc(gq) - DSSD) + 2 * cl_) : 0u; \
                        rx[0][jj] = ok ? ldu(hr + (DXc(gq) - DSSD) + 2 * cl_) : 0u; rx[1][jj] = ok ? ldu(hr + (DXc(gq) - DSSD) + 128 + 2 * cl_) : 0u; } \
                } else { const bf16* pr = proj + (rw_ + jj - 3) * PP; \
                    rB[jj] = ldu(pr + DBc(gq) + 2 * cl_); rC[jj] = ldu(pr + DCc(gq) + 2 * cl_); \
                    rx[0][jj] = ldu(pr + DXc(gq) + 2 * cl_); rx[1][jj] = ldu(pr + DXc(gq) + 128 + 2 * cl_); } } \
        } \
        if (cl_ < 32) gdt = gts[(rw_ + (cl_ >> 2)) * 32 + G_DT + gq * 4 + (cl_ & 3)]; } while (0)
    SSD_LOAD(0);
    for (int c = 0; c < NCH; ++c) {
        const size_t rowc = (size_t)b * SEQ + (size_t)s * SEGL + (size_t)c * CH;
        const int cp = opq(lane);
        LAS float* vsl = vacs + (cp >> 5) * 64 + 8 * g;
        const float a_l = fsoftplus(gdt + dtb_l) * An_l;
        float al[2][8];
#pragma unroll
        for (int k = 0; k < 2; ++k) {
#pragma unroll
            for (int jj = 0; jj < 8; ++jj) { const float pa = __int_as_float(__builtin_amdgcn_readlane(__float_as_int(a_l), 4 * jj + 2 * k)), pb = __int_as_float(__builtin_amdgcn_readlane(__float_as_int(a_l), 4 * jj + 2 * k + 1));
                al[k][jj] = hsub ? pb : pa; }
#pragma unroll
            for (int jj = 1; jj < 8; ++jj) al[k][jj] += al[k][jj - 1];
            if ((lane & 31) == 0) vg[(2 * k + hsub) * 8 + g] = al[k][7];
        }
        __syncthreads();
        float base[2] = {0.f, 0.f}, aend[2] = {0.f, 0.f};
#pragma unroll
        for (int k = 0; k < 2; ++k)
#pragma unroll
            for (int gg = 0; gg < 8; ++gg) { const float t = vg[(2 * k + hsub) * 8 + gg]; if (gg < g) base[k] += t; aend[k] += t; }
#define SSD_PUT_T(region, src) do { u32x4v t_; \
          t_.x = (src[0] & 0xffffu) | (src[1] << 16); t_.y = (src[2] & 0xffffu) | (src[3] << 16); t_.z = (src[4] & 0xffffu) | (src[5] << 16); t_.w = (src[6] & 0xffffu) | (src[7] << 16); \
          *(LAS u32x4v*)(lds + (region) + (2 * cp) * 128 + ((g ^ (cp & 7)) << 4)) = t_; \
          t_.x = (src[0] >> 16) | (src[1] & 0xffff0000u); t_.y = (src[2] >> 16) | (src[3] & 0xffff0000u); t_.z = (src[4] >> 16) | (src[5] & 0xffff0000u); t_.w = (src[6] >> 16) | (src[7] & 0xffff0000u); \
          *(LAS u32x4v*)(lds + (region) + (2 * cp + 1) * 128 + ((g ^ (cp & 7)) << 4)) = t_; } while (0)
        unsigned x1a[8], x1s[8];
        unsigned Bp[8], Cp[8], x0p[8];
        if (OUT) {
#pragma unroll
            for (int jj = 0; jj < 8; ++jj) { *(LAS unsigned*)(lds + L_KT + (8 * g + jj) * PQ + 4 * cp) = rB[jj]; *(LAS unsigned*)(lds + L_QT + (8 * g + jj) * PQ + 4 * cp) = rC[jj]; }
            SSD_PUT_T(L_KTT, rB);
            { unsigned x0s[8];
#pragma unroll
              for (int jj = 0; jj < 8; ++jj) { const float a0 = base[0] + al[0][jj]; const float dtj = (al[0][jj] - (jj ? al[0][jj - 1] : 0.f)) * iAn[0], e0 = fexp(aend[0] - a0);
                  x0s[jj] = cvtpk(lo2f(rx[0][jj]) * e0, hi2f(rx[0][jj]) * e0);
                  if ((cp & 31) == 0) { vsl[jj] = a0; vsl[256 + jj] = fexp(a0); vsl[512 + jj] = frcp(dtj); } }
              SSD_PUT_T(L_VVT, x0s); SSD_PUT_T(L_VT, rx[0]); }
#pragma unroll
            for (int jj = 0; jj < 8; ++jj) { const float a1 = base[1] + al[1][jj]; const float dtj = (al[1][jj] - (jj ? al[1][jj - 1] : 0.f)) * iAn[1];
                x1a[jj] = rx[1][jj];
                if ((cp & 31) == 0) { vsl[128 + jj] = a1; vsl[128 + 256 + jj] = fexp(a1); vsl[128 + 512 + jj] = frcp(dtj); } }
        } else {
            LAS unsigned* hw_ = hxch + (c & 1) * 768; LAS unsigned* hr_ = hxch + ((c + 1) & 1) * 768;
            if (g == 7) {
#pragma unroll
                for (int jj = 0; jj < 3; ++jj) { hw_[(0 * 3 + jj) * 64 + cp] = rB[8 + jj]; hw_[(1 * 3 + jj) * 64 + cp] = rC[8 + jj]; hw_[(2 * 3 + jj) * 64 + cp] = rx[0][8 + jj]; hw_[(3 * 3 + jj) * 64 + cp] = rx[1][8 + jj]; } }
            if (g == 0 && c > 0) {
#pragma unroll
                for (int jj = 0; jj < 3; ++jj) { rB[jj] = hr_[(0 * 3 + jj) * 64 + cp]; rC[jj] = hr_[(1 * 3 + jj) * 64 + cp]; rx[0][jj] = hr_[(2 * 3 + jj) * 64 + cp]; rx[1][jj] = hr_[(3 * 3 + jj) * 64 + cp]; } }
#define SSD_TAPS(chan) float w0_[5], w1_[5]; _Pragma("unroll") for (int kk = 0; kk < 5; ++kk) { w0_[kk] = vcw[(chan) * 5 + kk]; w1_[kk] = vcw[((chan) + 1) * 5 + kk]; }
#define SSD_CONV(raw, jj, y0, y1) float y0 = w0_[4], y1 = w1_[4]; _Pragma("unroll") for (int kk = 0; kk < 4; ++kk) { y0 += w0_[kk] * lo2f(raw[jj + kk]); y1 += w1_[kk] * hi2f(raw[jj + kk]); }
            { SSD_TAPS(2 * cp)
#pragma unroll
              for (int jj = 0; jj < 8; ++jj) { SSD_CONV(rB, jj, y0, y1) Bp[jj] = cvtpk(fsilu(y0), fsilu(y1)); }
              SSD_PUT_T(L_KTT, Bp); }
            { SSD_TAPS(128 + 2 * cp)
#pragma unroll
              for (int jj = 0; jj < 8; ++jj) { SSD_CONV(rC, jj, y0, y1) Cp[jj] = cvtpk(fsilu(y0), fsilu(y1)); } }
            { SSD_TAPS(256 + 2 * cp)
              unsigned x0s[8];
#pragma unroll
              for (int jj = 0; jj < 8; ++jj) { SSD_CONV(rx[0], jj, y0, y1) const float a0 = base[0] + al[0][jj]; const float dtj = (al[0][jj] - (jj ? al[0][jj - 1] : 0.f)) * iAn[0], e0 = fexp(aend[0] - a0);
                  x0p[jj] = cvtpk(fsilu(y0) * dtj, fsilu(y1) * dtj); x0s[jj] = cvtpk(lo2f(x0p[jj]) * e0, hi2f(x0p[jj]) * e0); }
              SSD_PUT_T(L_VVT, x0s); }
            { SSD_TAPS(256 + 128 + 2 * cp)
#pragma unroll
              for (int jj = 0; jj < 8; ++jj) { SSD_CONV(rx[1], jj, y0, y1) const float a1 = base[1] + al[1][jj]; const float dtj = (al[1][jj] - (jj ? al[1][jj - 1] : 0.f)) * iAn[1], e1 = fexp(aend[1] - a1);
                  x1a[jj] = cvtpk(fsilu(y0) * dtj, fsilu(y1) * dtj); x1s[jj] = cvtpk(lo2f(x1a[jj]) * e1, hi2f(x1a[jj]) * e1); } }
#undef SSD_TAPS
#undef SSD_CONV
        }
        if (g == 0 && (lane & 31) == 0) { vaend[hsub] = fexp(aend[0]); vaend[2 + hsub] = fexp(aend[1]); }
        asum[0] += aend[0]; asum[1] += aend[1];
        if (!OUT) SSD_PUT_T(L_VT, x1s);
        if (c + 1 < NCH) SSD_LOAD(c + 1);
        __syncthreads();
        const int lc = opq(lane), r = lc & 15, qd = lc >> 4;
        if (!OUT) {
#pragma unroll
            for (int jj = 0; jj < 8; ++jj) { bf16* pr = proj + (rowc + 8 * g + jj) * PP;
                *(unsigned*)(pr + DBc(gq) + 2 * cp) = Bp[jj]; *(unsigned*)(pr + DCc(gq) + 2 * cp) = Cp[jj];
                *(unsigned*)(pr + DXc(gq) + 2 * cp) = x0p[jj]; *(unsigned*)(pr + DXc(gq) + 128 + 2 * cp) = x1a[jj]; }
            const float fe0 = vaend[hw0], fe1 = vaend[hw1];
#pragma unroll
            for (int dt = 0; dt < 8; ++dt) { S[0][dt] = S[0][dt] * fe0; S[1][dt] = S[1][dt] * fe1;
#pragma unroll
                for (int ks = 0; ks < 2; ++ks) { const bf16x8 a = frag64(lds + L_KTT, 16 * dt + r, ks, qd);
                    S[0][dt] = MFMA16(a, frag64(lds + L_VVT, 16 * w + r, ks, qd), S[0][dt]); S[1][dt] = MFMA16(a, frag64(lds + L_VT, 16 * w + r, ks, qd), S[1][dt]); } }
        } else {
            const int it = w & 3;
            f32x4 cb[2];
#pragma unroll
            for (int j2 = 0; j2 < 2; ++j2) { const int jt = 2 * (w >> 2) + j2; cb[j2] = (f32x4){0.f, 0.f, 0.f, 0.f};
                if (jt <= it) {
#pragma unroll
                    for (int ks = 0; ks < 4; ++ks) cb[j2] = MFMA16(frag(lds + L_KT, 16 * jt + r, PQ, ks, qd), frag(lds + L_QT, 16 * it + r, PQ, ks, qd), cb[j2]); } }
            unsigned uA[8]; float ssq = 0.f;
#pragma unroll
            for (int R = 0; R < 2; ++R) {
#pragma unroll
                for (int hs = 0; hs < 2; ++hs) { const int hd = 2 * R + hs; const float ai = vacs[hd * 64 + 16 * it + r]; const float dgi = Dh[R][hs] * vdti[hd * 64 + 16 * it + r];
#pragma unroll
                    for (int j2 = 0; j2 < 2; ++j2) { const int jt = 2 * (w >> 2) + j2; f32x4 pv = (f32x4){0.f, 0.f, 0.f, 0.f};
                        if (jt <= it) { const f32x4 aj = *(const LAS f32x4*)(vacs + hd * 64 + 16 * jt + 4 * qd);
#pragma unroll
                            for (int rg = 0; rg < 4; ++rg) { float v = cb[j2][rg] * fexp(fminf(ai - aj[rg], 0.f));
                                if (jt == it) { if (4 * qd + rg > r) v = 0.f; else if (4 * qd + rg == r) v += dgi; }
                                pv[rg] = v; } }
                        *(LAS u32x2v*)(lds + L_PM + hs * 9216 + sw64(16 * it + r, (16 * jt + 4 * qd) * 2)) = pack4(pv); } }
#pragma unroll
                for (int dt = 0; dt < 8; ++dt) *(LAS u32x2v*)(lds + L_ST + (16 * w + r) * PQ + (16 * dt + 4 * qd) * 2) = pack4(S[R][dt]);
                if (R == 1) {
#pragma unroll
                    for (int jj = 0; jj < 8; ++jj) { const float e1 = fexp(aend[1] - vsl[128 + jj]); x1s[jj] = cvtpk(lo2f(x1a[jj]) * e1, hi2f(x1a[jj]) * e1); }
                    SSD_PUT_T(L_VVT, x1s); SSD_PUT_T(L_VT, x1a); }
                __syncthreads();
                const int le_ = opq(lane), r = le_ & 15, qd = le_ >> 4;
                const int hd = 2 * R + (w >> 2);
                const int te = opq(tid), ei = te >> 3, ecc = te & 7;
                bf16* zp = proj + (rowc + ei) * PP + ZD + gq * 256 + R * 128 + 16 * ecc;
                const u32x4v za = *(const u32x4v*)zp, zb = *(const u32x4v*)(zp + 8);
                f32x4 o[4];
#pragma unroll
                for (int it2 = 0; it2 < 4; ++it2) { f32x4 o1 = (f32x4){0.f, 0.f, 0.f, 0.f}, o2 = (f32x4){0.f, 0.f, 0.f, 0.f};
#pragma unroll
                    for (int ks = 0; ks < 2; ++ks) if (ks == 0 || it2 >= 2) o1 = MFMA16(frag64(lds + L_VT, 16 * w + r, ks, qd), frag64(lds + L_PM + (w >> 2) * 9216, 16 * it2 + r, ks, qd), o1);
#pragma unroll
                    for (int ks = 0; ks < 4; ++ks) o2 = MFMA16(frag(lds + L_ST, 16 * w + r, PQ, ks, qd), frag(lds + L_QT, 16 * it2 + r, PQ, ks, qd), o2);
                    const float ea = veacs[hd * 64 + 16 * it2 + r]; o[it2] = o1 + o2 * ea; }
                const float fe = vaend[hd];
#pragma unroll
                for (int dt = 0; dt < 8; ++dt) { S[R][dt] = S[R][dt] * fe;
#pragma unroll
                    for (int ks = 0; ks < 2; ++ks) S[R][dt] = MFMA16(frag64(lds + L_KTT, 16 * dt + r, ks, qd), frag64(lds + L_VVT, 16 * w + r, ks, qd), S[R][dt]); }
#pragma unroll
                for (int it2 = 0; it2 < 4; ++it2) *(LAS u32x2v*)(lds + L_KT + (16 * it2 + r) * 272 + (16 * w + 4 * qd) * 2) = pack4(o[it2]);
                __syncthreads();
                const u32x4v oa = *(const LAS u32x4v*)(lds + L_KT + ei * 272 + ecc * 32), ob = *(const LAS u32x4v*)(lds + L_KT + ei * 272 + ecc * 32 + 16);
                const float ov[16] = {lo2f(oa.x), hi2f(oa.x), lo2f(oa.y), hi2f(oa.y), lo2f(oa.z), hi2f(oa.z), lo2f(oa.w), hi2f(oa.w), lo2f(ob.x), hi2f(ob.x), lo2f(ob.y), hi2f(ob.y), lo2f(ob.z), hi2f(ob.z), lo2f(ob.w), hi2f(ob.w)};
                const float zv[16] = {lo2f(za.x), hi2f(za.x), lo2f(za.y), hi2f(za.y), lo2f(za.z), hi2f(za.z), lo2f(za.w), hi2f(za.w), lo2f(zb.x), hi2f(zb.x), lo2f(zb.y), hi2f(zb.y), lo2f(zb.z), hi2f(zb.z), lo2f(zb.w), hi2f(zb.w)};
                if (R == 0) {
#pragma unroll
                    for (int k = 0; k < 8; ++k) { const float u0 = ov[2 * k] * fsilu(zv[2 * k]), u1 = ov[2 * k + 1] * fsilu(zv[2 * k + 1]); uA[k] = cvtpk(u0, u1); ssq += lo2f(uA[k]) * lo2f(uA[k]) + hi2f(uA[k]) * hi2f(uA[k]); }
                } else {
                    float uB[16];
#pragma unroll
                    for (int k = 0; k < 16; ++k) { uB[k] = ov[k] * fsilu(zv[k]); ssq += uB[k] * uB[k]; }
                    ssq += __shfl_xor(ssq, 1); ssq += __shfl_xor(ssq, 2); ssq += __shfl_xor(ssq, 4);
                    const float rs = frsq(ssq * (1.0f / 256.0f) + EPS);
                    const float* nwp = P->ssd_norm_w + l * 512 + gq * 256 + 16 * ecc;
                    u32x4v ya, yb;
                    ya.x = cvtpk(lo2f(uA[0]) * rs * nwp[0], hi2f(uA[0]) * rs * nwp[1]); ya.y = cvtpk(lo2f(uA[1]) * rs * nwp[2], hi2f(uA[1]) * rs * nwp[3]); ya.z = cvtpk(lo2f(uA[2]) * rs * nwp[4], hi2f(uA[2]) * rs * nwp[5]); ya.w = cvtpk(lo2f(uA[3]) * rs * nwp[6], hi2f(uA[3]) * rs * nwp[7]);
                    yb.x = cvtpk(lo2f(uA[4]) * rs * nwp[8], hi2f(uA[4]) * rs * nwp[9]); yb.y = cvtpk(lo2f(uA[5]) * rs * nwp[10], hi2f(uA[5]) * rs * nwp[11]); yb.z = cvtpk(lo2f(uA[6]) * rs * nwp[12], hi2f(uA[6]) * rs * nwp[13]); yb.w = cvtpk(lo2f(uA[7]) * rs * nwp[14], hi2f(uA[7]) * rs * nwp[15]);
                    if (DRY) { asm volatile("" :: "v"(ya.x), "v"(ya.y), "v"(ya.z), "v"(ya.w), "v"(yb.x), "v"(yb.y), "v"(yb.z), "v"(yb.w)); } else { *(u32x4v*)(zp - 128) = ya; *(u32x4v*)(zp - 128 + 8) = yb; }
                    nwp += 128;
                    ya.x = cvtpk(uB[0] * rs * nwp[0], uB[1] * rs * nwp[1]); ya.y = cvtpk(uB[2] * rs * nwp[2], uB[3] * rs * nwp[3]); ya.z = cvtpk(uB[4] * rs * nwp[4], uB[5] * rs * nwp[5]); ya.w = cvtpk(uB[6] * rs * nwp[6], uB[7] * rs * nwp[7]);
                    yb.x = cvtpk(uB[8] * rs * nwp[8], uB[9] * rs * nwp[9]); yb.y = cvtpk(uB[10] * rs * nwp[10], uB[11] * rs * nwp[11]); yb.z = cvtpk(uB[12] * rs * nwp[12], uB[13] * rs * nwp[13]); yb.w = cvtpk(uB[14] * rs * nwp[14], uB[15] * rs * nwp[15]);
                    if (DRY) { asm volatile("" :: "v"(ya.x), "v"(ya.y), "v"(ya.z), "v"(ya.w), "v"(yb.x), "v"(yb.y), "v"(yb.z), "v"(yb.w)); } else { *(u32x4v*)zp = ya; *(u32x4v*)(zp + 8) = yb; }
                }
            }
        }
    }
    if (!OUT) {
        bf16* sb = stbase + (size_t)idx * 32768;
#pragma unroll
        for (int R = 0; R < 2; ++R)
#pragma unroll
            for (int dt = 0; dt < 8; ++dt) st_wt(sb + ((size_t)(w * 16 + R * 8 + dt) * 64 + lane) * 4, pack4(S[R][dt]));
        if (g == 0 && (lane & 31) == 0) { st_wt_f(dsbase + (size_t)idx * 4 + hsub, asum[0]); st_wt_f(dsbase + (size_t)idx * 4 + 2 + hsub, asum[1]); }
        publish_item(flag_ptr(P, FLAG_SSD, idx), (unsigned)l + 1u);
    }
    __syncthreads();
#undef SSD_PUT_T
#undef SSD_LOAD
}
}
#define GAS __attribute__((address_space(1)))
typedef GAS unsigned gu32;
#define XB_TMO      128
#define XB_XCNT(j)  (256  + 64 * (j))
#define XB_XSUB(j)  (1280 + 64 * (j))
#define XB_XGEN(j)  (2304 + 64 * (j))
#define XB_TOP      3328
#define XB_TOPGEN   3392
#define XCD_BAR_WORDS 3456
#define XB_SPIN_CAP (1u << 18)

__device__ __forceinline__ unsigned xb_ld(unsigned* p)              { return __hip_atomic_load(p, __ATOMIC_RELAXED, __HIP_MEMORY_SCOPE_AGENT); }
__device__ __forceinline__ unsigned xb_add(unsigned* p, unsigned v) { return __hip_atomic_fetch_add(p, v, __ATOMIC_RELAXED, __HIP_MEMORY_SCOPE_AGENT); }
__device__ __forceinline__ unsigned xb_xcc_id() { return (unsigned)__builtin_amdgcn_s_getreg((3 << 11) | 20) & 0xFu; }
#define XB_SPIN(cond, bar) do { unsigned _sp = 0; while (cond) { __builtin_amdgcn_s_sleep(1); \
    if ((++_sp & 255u) == 0u) { if (xb_ld(&(bar)[XB_TMO])) break; if (_sp > XB_SPIN_CAP) { atomicAdd(&(bar)[XB_TMO], 1u); break; } } } } while (0)

struct XcdBarrier {
    unsigned* bar; unsigned x;
    volatile LAS unsigned* st;
};

__device__ __forceinline__ XcdBarrier xcd_barrier_post(unsigned* bar, volatile LAS unsigned* st) {
    XcdBarrier b; b.bar = bar; b.x = xb_xcc_id(); b.st = st;
    if (threadIdx.x == 0) (void)xb_add(&bar[XB_XCNT(b.x)], 1u);
    return b;
}
__device__ __forceinline__ void xcd_barrier_complete(unsigned* bar, unsigned x, unsigned& nloc, unsigned& nx) {
    const unsigned G = gridDim.x * gridDim.y * gridDim.z;
    unsigned sum, cnt, mine, sp = 0u;
    for (;;) {
        sum = 0u; cnt = 0u; mine = 0u;
#pragma unroll
        for (unsigned j = 0; j < 16; ++j) { const unsigned c = xb_ld(&bar[XB_XCNT(j)]); sum += c; cnt += (c > 0u) ? 1u : 0u; mine = (j == x) ? c : mine; }
        if (sum == G) break;
        __builtin_amdgcn_s_sleep(1);
        if ((++sp & 255u) == 0u) { if (xb_ld(&bar[XB_TMO])) break; if (sp > XB_SPIN_CAP) { atomicAdd(&bar[XB_TMO], 1u); break; } }
    }
    nloc = mine > 0u ? mine : 1u; nx = cnt > 0u ? cnt : 1u;
}

__device__ __forceinline__ void xcd_barrier(const XcdBarrier& b) {
    asm volatile("s_waitcnt vmcnt(0)" ::: "memory");
    __syncthreads();
    if (threadIdx.x == 0) {
        unsigned* bar = b.bar;
        __builtin_amdgcn_s_waitcnt(0);
        unsigned nloc = b.st[0], nx = b.st[1];
        if (nloc == 0u) { xcd_barrier_complete(bar, b.x, nloc, nx); b.st[0] = nloc; b.st[1] = nx; }
        const unsigned old = xb_add(&bar[XB_XSUB(b.x)], 1u);
        const unsigned gen = old / nloc;
        if (old + 1u == (gen + 1u) * nloc) {
            __builtin_amdgcn_fence(__ATOMIC_RELEASE, "agent");
            asm volatile("s_waitcnt vmcnt(0)" ::: "memory");
            const unsigned og = xb_add(&bar[XB_TOP], 1u);
            const unsigned tg = og / nx;
            if (og + 1u == (tg + 1u) * nx) xb_add(&bar[XB_TOPGEN], 1u);
            else XB_SPIN(xb_ld(&bar[XB_TOPGEN]) == tg, bar);
            __builtin_amdgcn_fence(__ATOMIC_ACQUIRE, "agent");
            xb_add(&bar[XB_XGEN(b.x)], 1u);
            asm volatile("s_waitcnt vmcnt(0)" ::: "memory");
        } else {
            XB_SPIN(xb_ld(&bar[XB_XGEN(b.x)]) == gen, bar);
            __builtin_amdgcn_fence(__ATOMIC_ACQUIRE, "agent");
            asm volatile("s_waitcnt vmcnt(0)" ::: "memory");
        }
    }
    __syncthreads();
}
constexpr int LDS_BYTES = 163840;
constexpr int LDS_BARST = 163832;
constexpr int CTL_BYTES = 65536;
template <bool OUT>
__device__ __forceinline__ void engine_items(KP P, int l, int bid, int nblk, LAS unsigned char* lds) {
    if (nblk == 256) {
        if (bid < 64) { const int s = bid & 15, bg = bid >> 4; mx::ssd_item<OUT>(P, l, bg >> 1, bg & 1, s, lds); }
        else if (bid < 192) { const int ii = bid - 64, s = ii & 15, bh = ii >> 4;
            mx::ml_item<OUT>(P, l, bh >> 2, bh & 3, s, lds); if (OUT) mx::pc_item<0, true>(P, l, bh >> 2, bh & 3, 15 - s, lds); else mx::pc_pass1<0>(P, l, bh >> 2, bh & 3, 15 - s, lds); }
        else { const int ii = bid - 192, sh = ii & 7, bh = ii >> 3;
            if (OUT) { mx::pc_item<2, true>(P, l, bh >> 2, bh & 3, sh, lds); mx::pc_item<2, true>(P, l, bh >> 2, bh & 3, 15 - sh, lds); }
            else { mx::pc_pass1<2>(P, l, bh >> 2, bh & 3, sh, lds); mx::pc_pass1<2>(P, l, bh >> 2, bh & 3, 15 - sh, lds); } }
    } else {
        for (int ii = bid; ii < 448; ii += nblk) {
            if (ii < 64) { const int s = ii & 15, bg = ii >> 4; mx::ssd_item<OUT>(P, l, bg >> 1, bg & 1, s, lds); }
            else if (ii < 192) { const int i2 = ii - 64, s = i2 & 15, bh = i2 >> 4; mx::ml_item<OUT>(P, l, bh >> 2, bh & 3, s, lds); }
            else if (ii < 320) { const int i2 = ii - 192, s = i2 & 15, bh = i2 >> 4; mx::pc_item<2, OUT>(P, l, bh >> 2, bh & 3, s, lds); }
            else { const int i2 = ii - 320, s = i2 & 15, bh = i2 >> 4; mx::pc_item<0, OUT>(P, l, bh >> 2, bh & 3, s, lds); }
        }
    }
}
__global__ void __launch_bounds__(512, 2) fwd_mega(Params Pval) {
    extern __shared__ __attribute__((aligned(16))) unsigned char lds_raw[]; LAS unsigned char* lds = (LAS unsigned char*)lds_raw;
    (void)Pval; KP P = (KP)__builtin_amdgcn_kernarg_segment_ptr();
#define LAUNDER() asm volatile("" : "+s"(P))
    const int bid = blockIdx.x, nblk = gridDim.x;
    if (threadIdx.x < 2) ((LAS unsigned*)(lds + LDS_BARST))[threadIdx.x] = 0u;
    __syncthreads();
    LAUNDER();
    XcdBarrier bar = xcd_barrier_post((unsigned*)(P->ws + WS_CTL) + 1024, (volatile LAS unsigned*)(lds + LDS_BARST));
    LAUNDER(); phase_prologue(P, bid, nblk, lds);
    xcd_barrier(bar);
#define LAYER_BODY(l) do { \
        LAUNDER(); phase_gemm_in(P, l, bid, nblk, lds); \
        xcd_barrier(bar); \
        LAUNDER(); engine_items<false>(P, l, bid, nblk, lds); \
        LAUNDER(); engine_items<true>(P, l, bid, nblk, lds); \
        LAUNDER(); convert_weights_queue(P, l, lds); \
        xcd_barrier(bar); \
        LAUNDER(); phase_gemm_out(P, l, bid, nblk, lds); \
        xcd_barrier(bar); } while (0)
    LAYER_BODY(0);
    LAYER_BODY(1);
    static_assert(DEPTH == 2, "layer bodies are written out");
    LAUNDER(); phase_final(P, bid, nblk);
}

extern "C" void kernel_launch(void* const* d_in, const int* in_sizes, int n_in, void* d_out, int out_size, void* d_ws, size_t ws_size, hipStream_t stream) {
    static int grid_blocks = 0;
    if (!grid_blocks) {
        if (n_in != 21 || out_size != NTOK * DM || ws_size < WS_END) { fprintf(stderr, "kernel_launch: unexpected shapes (n_in %d out %d ws %zu)\n", n_in, out_size, ws_size); grid_blocks = -1; return; }
        if (hipFuncSetAttribute((const void*)fwd_mega, hipFuncAttributeMaxDynamicSharedMemorySize, LDS_BYTES) != hipSuccess) { fprintf(stderr, "hipFuncSetAttribute failed\n"); grid_blocks = -1; return; }
        int dev = 0, cus = 0, per_cu = 0;
        (void)hipGetDevice(&dev); (void)hipDeviceGetAttribute(&cus, hipDeviceAttributeMultiprocessorCount, dev);
        (void)hipOccupancyMaxActiveBlocksPerMultiprocessor(&per_cu, (const void*)fwd_mega, 512, LDS_BYTES);
        if (per_cu < 1) { fprintf(stderr, "kernel_launch: occupancy query says %d blocks per CU\n", per_cu); grid_blocks = -1; return; }
        grid_blocks = cus;
    }
    if (grid_blocks < 0) return;
    (void)hipMemsetAsync((unsigned char*)d_ws + WS_CTL, 0, CTL_BYTES, stream);
    Params P{};
    const float** pp = (const float**)&P;
    for (int i = 0; i < 21; ++i) pp[i] = (const float*)d_in[i];
    P.out = (float*)d_out; P.ws = (unsigned char*)d_ws;
    void* args[] = {&P};
    hipError_t e = hipLaunchCooperativeKernel((const void*)fwd_mega, dim3(grid_blocks), dim3(512), args, LDS_BYTES, stream);
    if (e != hipSuccess) fprintf(stderr, "cooperative launch failed: %s (grid %d)\n", hipGetErrorString(e), grid_blocks);
}
```
